# Optimizing an MI355X kernel written in HIP

```python
import jax, jax.numpy as jnp
from jax import lax
import numpy as np

D_MODEL = 1024
BATCH = 4
SEQ = 8192
DEPTH = 1

PLE_DIM = 256
ML_HEADS = 4
ML_DQK = 128
ML_DV = 256
ML_CONV = 4
ML_CHUNK = 64
SW_Q_HEADS = 16
SW_KV_HEADS = 4
SW_HEAD_DIM = 64
SW_WINDOW = 128
D_FF = 4 * D_MODEL
EPS = 1e-6

ML_QK_W = ML_HEADS * ML_DQK
ML_V_W = ML_HEADS * ML_DV
SW_Q_W = SW_Q_HEADS * SW_HEAD_DIM
SW_KV_W = SW_KV_HEADS * SW_HEAD_DIM
SPLIT_SIZES = (2 * ML_QK_W, ML_V_W, ML_V_W, 2 * ML_HEADS, SW_Q_W, SW_KV_W, SW_KV_W, D_MODEL, D_MODEL)
N_IN = sum(SPLIT_SIZES)

kernel_name = "hybrid_mlstm_swa_sink_parallel_block"


def rmsnorm(x, g):
    xf = x.astype(jnp.float32)
    xf = xf * lax.rsqrt(jnp.mean(xf * xf, axis=-1, keepdims=True) + EPS)
    return xf.astype(x.dtype) * g.astype(x.dtype)


def causal_depthwise_conv(x, w):
    c = x.shape[-1]
    return lax.conv_general_dilated(
        x, w.astype(x.dtype)[:, None, :], window_strides=(1,), padding=((ML_CONV - 1, 0),),
        dimension_numbers=("NWC", "WIO", "NWC"), feature_group_count=c)


def mlstm_chunkwise(q, k, v, ig, lf):
    B, S = q.shape[:2]
    L = ML_CHUNK
    nc = S // L

    def to_chunks(t):
        t = t.astype(jnp.float32).reshape((B, nc, L) + t.shape[2:])
        return jnp.moveaxis(jnp.moveaxis(t, 1, 0), 3, 2)

    xs = (to_chunks(q), to_chunks(k), to_chunks(v), to_chunks(ig), to_chunks(lf))
    causal = jnp.tril(jnp.ones((L, L), dtype=bool))

    def step(carry, chunk):
        C, n, m = carry
        qc, kc, vc, ic, fc = chunk
        b = jnp.cumsum(fc, axis=-1)
        log_d = jnp.where(causal, b[..., :, None] - b[..., None, :] + ic[..., None, :], -jnp.inf)
        inter = b + m[..., None]
        m_t = jnp.maximum(inter, jnp.max(log_d, axis=-1))
        scores = jnp.einsum("bhtk,bhsk->bhts", qc, kc) * jnp.exp(log_d - m_t[..., None])
        w_inter = jnp.exp(inter - m_t)
        num = (w_inter[..., None] * jnp.einsum("bhvk,bhtk->bhtv", C, qc)
               + jnp.einsum("bhts,bhsv->bhtv", scores, vc))
        den = w_inter * jnp.einsum("bhk,bhtk->bht", n, qc) + jnp.sum(scores, axis=-1)
        h = num / jnp.maximum(jnp.abs(den), jnp.exp(-m_t))[..., None]
        b_last = b[..., -1]
        log_w = b_last[..., None] - b + ic
        m_new = jnp.maximum(b_last + m, jnp.max(log_w, axis=-1))
        w = jnp.exp(log_w - m_new[..., None])
        decay = jnp.exp(b_last + m - m_new)
        C_new = decay[..., None, None] * C + jnp.einsum("bhs,bhsv,bhsk->bhvk", w, vc, kc)
        n_new = decay[..., None] * n + jnp.einsum("bhs,bhsk->bhk", w, kc)
        return (C_new, n_new, m_new), h

    H, dk, dv = q.shape[2], q.shape[3], v.shape[3]
    init = (jnp.zeros((B, H, dv, dk), jnp.float32), jnp.zeros((B, H, dk), jnp.float32),
            jnp.zeros((B, H), jnp.float32))
    _, h = lax.scan(step, init, xs)
    h = jnp.moveaxis(jnp.moveaxis(h, 2, 3), 0, 1)
    return h.reshape(B, S, H, dv)


def swa_with_sinks(q, k, v, sinks):
    B, S = q.shape[:2]
    W = SW_WINDOW
    nb = S // W
    G = SW_Q_HEADS // SW_KV_HEADS
    qb = q.reshape(B, nb, W, SW_KV_HEADS, G, SW_HEAD_DIM)

    def band(t):
        tb = t.reshape(B, nb, W, SW_KV_HEADS, SW_HEAD_DIM)
        prev = jnp.pad(tb, ((0, 0), (1, 0), (0, 0), (0, 0), (0, 0)))[:, :-1]
        return jnp.concatenate([prev, tb], axis=2)

    kb, vb = band(k), band(v)
    logits = jnp.einsum("bnqhgd,bnkhd->bnhgqk", qb, kb).astype(jnp.float32) * (SW_HEAD_DIM ** -0.5)
    qi = jnp.arange(W)[:, None]
    ki = jnp.arange(2 * W)[None, :]
    diff = qi + W - ki
    band_mask = (diff >= 0) & (diff < W)
    valid = band_mask[None] & ((jnp.arange(nb)[:, None, None] > 0) | (ki >= W)[None])
    logits = jnp.where(valid[None, :, None, None], logits, -jnp.inf)
    sink = sinks.astype(jnp.float32).reshape(SW_KV_HEADS, G)[None, None, :, :, None, None]
    m = jnp.maximum(jnp.max(logits, axis=-1, keepdims=True), sink)
    pexp = jnp.exp(logits - m)
    probs = pexp / (jnp.sum(pexp, axis=-1, keepdims=True) + jnp.exp(sink - m))
    out = jnp.einsum("bnhgqk,bnkhd->bnqhgd", probs.astype(v.dtype), vb)
    return out.reshape(B, S, SW_Q_W)


def setup_inputs(seed: int = 0) -> dict:
    key = jax.random.key(seed)
    ks = jax.random.split(key, 20)
    f32 = jnp.float32
    nrm = lambda k, shape, s: jax.random.normal(k, shape, f32) * s
    gain = lambda k, shape: 1.0 + 0.05 * jax.random.normal(k, shape, f32)
    b_if = jnp.concatenate([
        0.1 * jax.random.normal(ks[3], (DEPTH, ML_HEADS), f32),
        3.0 + 0.5 * jax.random.normal(ks[4], (DEPTH, ML_HEADS), f32),
    ], axis=-1)
    return {
        "x": jax.random.normal(ks[0], (BATCH, SEQ, D_MODEL), f32),
        "p": jax.random.normal(ks[1], (DEPTH, BATCH, SEQ, PLE_DIM), f32),
        "norm_mix_g": gain(ks[2], (DEPTH, D_MODEL)),
        "w_in": nrm(ks[5], (DEPTH, D_MODEL, N_IN), D_MODEL ** -0.5),
        "conv_qk": nrm(ks[6], (DEPTH, ML_CONV, 2 * ML_QK_W), ML_CONV ** -0.5),
        "b_if": b_if,
        "mlstm_norm_g": gain(ks[7], (DEPTH, ML_V_W)),
        "sinks": nrm(ks[8], (DEPTH, SW_Q_HEADS), 0.5),
        "w_branch_a": nrm(ks[9], (DEPTH, ML_V_W, D_MODEL), ML_V_W ** -0.5),
        "w_branch_b": nrm(ks[10], (DEPTH, SW_Q_W, D_MODEL), SW_Q_W ** -0.5),
        "w_out": nrm(ks[11], (DEPTH, D_MODEL, D_MODEL), D_MODEL ** -0.5),
        "norm_mlp_g": gain(ks[12], (DEPTH, D_MODEL)),
        "w_up": nrm(ks[13], (DEPTH, D_MODEL, D_FF), D_MODEL ** -0.5),
        "w_down": nrm(ks[14], (DEPTH, D_FF, D_MODEL), D_FF ** -0.5),
        "norm_ple_g": gain(ks[15], (DEPTH, D_MODEL)),
        "w_ple_gate": nrm(ks[16], (DEPTH, D_MODEL, D_MODEL), D_MODEL ** -0.5),
        "w_ple_proj": nrm(ks[17], (DEPTH, PLE_DIM, D_MODEL), PLE_DIM ** -0.5),
        "final_norm_g": gain(ks[18], (D_MODEL,)),
    }


def reference(x, p, norm_mix_g, w_in, conv_qk, b_if, mlstm_norm_g, sinks, w_branch_a, w_branch_b,
              w_out, norm_mlp_g, w_up, w_down, norm_ple_g, w_ple_gate, w_ple_proj, final_norm_g):
    B, S, _ = x.shape
    split_idx = [int(v) for v in np.cumsum(SPLIT_SIZES)[:-1]]
    for i in range(DEPTH):
        h = rmsnorm(x, norm_mix_g[i])
        proj = h @ w_in[i]
        qk_ml, v_ml, o_ml, if_pre, q_sw, k_sw, v_sw, g_a, g_b = jnp.split(proj, split_idx, axis=-1)

        qk_ml = jax.nn.silu(causal_depthwise_conv(qk_ml, conv_qk[i]))
        q_ml, k_ml = jnp.split(qk_ml, 2, axis=-1)
        q_ml = q_ml.reshape(B, S, ML_HEADS, ML_DQK) * (ML_DQK ** -0.5)
        k_ml = k_ml.reshape(B, S, ML_HEADS, ML_DQK)
        gates = (if_pre + b_if[i].astype(if_pre.dtype)).astype(jnp.float32)
        ig = gates[..., :ML_HEADS]
        lf = jax.nn.log_sigmoid(gates[..., ML_HEADS:])
        h_ml = mlstm_chunkwise(q_ml, k_ml, v_ml.reshape(B, S, ML_HEADS, ML_DV), ig, lf)
        h_ml = h_ml * lax.rsqrt(jnp.mean(h_ml * h_ml, axis=-1, keepdims=True) + EPS)
        h_ml = h_ml.reshape(B, S, ML_V_W).astype(x.dtype) * mlstm_norm_g[i].astype(x.dtype)
        y_a = jax.nn.sigmoid(o_ml) * h_ml

        y_b = swa_with_sinks(q_sw.reshape(B, S, SW_Q_HEADS, SW_HEAD_DIM),
                             k_sw.reshape(B, S, SW_KV_HEADS, SW_HEAD_DIM),
                             v_sw.reshape(B, S, SW_KV_HEADS, SW_HEAD_DIM), sinks[i])

        merged = jax.nn.sigmoid(g_a) * (y_a @ w_branch_a[i]) + jax.nn.sigmoid(g_b) * (y_b @ w_branch_b[i])
        x = x + merged @ w_out[i]

        u = rmsnorm(x, norm_mlp_g[i]) @ w_up[i]
        x = x + jnp.square(jax.nn.relu(u)) @ w_down[i]

        gate = jax.nn.sigmoid(rmsnorm(x, norm_ple_g[i]) @ w_ple_gate[i])
        x = x + gate * (p[i].astype(x.dtype) @ w_ple_proj[i])
    return rmsnorm(x, final_norm_g)
```

```cpp
#define MK_N_LAUNCHES 11
#include <hip/hip_runtime.h>
#include <hip/hip_cooperative_groups.h>
#include <cstdio>
#include <cstdint>
namespace cg = cooperative_groups;
namespace pg8 {
#define PG8_LAS __attribute__((address_space(3)))
typedef unsigned short bf16_t;
typedef short bf16x8 __attribute__((ext_vector_type(8)));
typedef float f32x4 __attribute__((ext_vector_type(4)));
typedef unsigned u32x4 __attribute__((ext_vector_type(4)));
constexpr int BM = 256, BK = 64, HALF = 128, HTB = HALF * BK * 2  , STAGE_BYTES = 8 * HTB, NXCD = 8, WGM = 8;

__host__ __device__ __forceinline__ int lds_byte(int r, int c) { const int st = (r >> 4) * 2 + (c >> 5), rr = r & 15, cc = c & 31, ob = rr * 64 + cc * 2; return st * 1024 + (ob ^ (((ob >> 9) & 1) << 5)); }
__host__ __device__ __forceinline__ void stage_rc(int b, int& R, int& C) { const int st = b / 1024, sb = b % 1024, swz = sb ^ (((sb >> 9) & 1) << 5); R = (st >> 1) * 16 + swz / 64; C = (st & 1) * 32 + (swz % 64) / 2; }
__host__ __device__ __forceinline__ int perm32(int rho) { const int n = rho >> 4, i = rho & 15; return 8 * (i >> 2) + 4 * n + (i & 3); }

struct Unit { int pm, pn; };
struct Gemm { const bf16_t* A; const bf16_t* Bt; int M, N, K; };

struct StaticOrder {
    int nM, nN, nwg, G, c;
    __host__ __device__ void init(int M, int N, int G_, int c_) { nM = M / BM; nN = N / BM; nwg = nM * nN; G = G_; c = c_; }
    __host__ __device__ bool next(int i, Unit& u) const {
        const long L = (long)i * G + c; if (L >= nwg) return false;
        int wgid = (int)L; { const int q = nwg / NXCD, r = nwg % NXCD, xcd = wgid % NXCD, off = wgid / NXCD; wgid = (xcd < r ? xcd * (q + 1) : r * (q + 1) + (xcd - r) * q) + off; }
        const int nig = WGM * nN, gid = wgid / nig, fm = gid * WGM, gsz = (nM - fm) < WGM ? (nM - fm) : WGM;
        u.pm = fm + ((wgid % nig) % gsz); u.pn = (wgid % nig) / gsz; return true;
    }
    __device__ __forceinline__ void a_ready(const Unit&) const {}
    __device__ __forceinline__ void done(const Unit&) const {}
};
__device__ __forceinline__ unsigned cvt_pk_bf16(float lo, float hi) { unsigned r; asm volatile("v_cvt_pk_bf16_f32 %0, %1, %2" : "=v"(r) : "v"(lo), "v"(hi)); return r; }
template <class Epi, class Sched, bool ALIGN_EPI = false, bool SP2 = false>
__device__ __forceinline__ void gemm_phase(PG8_LAS unsigned char* lds, const Gemm g, const Sched& S, const Epi& E, const int wid) {
    int lane; asm volatile("v_mbcnt_lo_u32_b32 %0, -1, 0\n\tv_mbcnt_hi_u32_b32 %0, -1, %0" : "=v"(lane));
    const int tid = wid * 64 + lane, wr = wid >> 2, wc = wid & 3, fr = lane & 15, fq = lane >> 4;
    const int K = g.K, nt = K / BK;
    unsigned voffA[2], voffB[2];
#pragma unroll
    for (int i = 0; i < 2; ++i) { int R, C; stage_rc(tid * 16 + i * 8192, R, C); const int Rb = Epi::PERM ? ((R & ~31) + perm32(R & 31)) : R;
        voffA[i] = (unsigned)(R * K + C) * 2u; voffB[i] = (unsigned)(Rb * K + C) * 2u; }
    const size_t kstep = (size_t)(BK * 2);
    const size_t hstep = (size_t)HALF * K * 2;
    const size_t tstep = 2 * hstep;
    const unsigned ldsw = (unsigned)wid * 1024u;
    const int aoff = lds_byte(wr * 64 + fr, fq * 8), boff = lds_byte(wc * 32 + fr, fq * 8);
#define PG8_SA(b, h) (((b) * 2 + (h)) * HTB)
#define PG8_SB(b, h) ((4 + (b) * 2 + (h)) * HTB)
#define PG8_STAGE(bufoff, gbase, voff) do { _Pragma("unroll") for (int _i = 0; _i < 2; ++_i) \
        __builtin_amdgcn_global_load_lds((const unsigned*)((const char*)(gbase) + (voff)[_i]), (PG8_LAS unsigned*)(lds + (bufoff) + ldsw + _i * 8192), 16, 0, 0); } while (0)
#define PG8_LDA(dst, b, h) do { _Pragma("unroll") for (int m = 0; m < 4; ++m) _Pragma("unroll") for (int k = 0; k < 2; ++k) dst[m][k] = *(const PG8_LAS bf16x8*)(lds + PG8_SA(b, h) + aoff + m * 2048 + k * 1024); } while (0)
#define PG8_LDB(dst, b, h) do { _Pragma("unroll") for (int n = 0; n < 2; ++n) _Pragma("unroll") for (int k = 0; k < 2; ++k) dst[n][k] = *(const PG8_LAS bf16x8*)(lds + PG8_SB(b, h) + boff + n * 2048 + k * 1024); } while (0)
#define PG8_MMA(ai, bj, At, Bt) do { __builtin_amdgcn_s_setprio(1); _Pragma("unroll") for (int m = 0; m < 4; ++m) _Pragma("unroll") for (int n = 0; n < 2; ++n) _Pragma("unroll") for (int k = 0; k < 2; ++k) \
        acc[ai][bj][m][n] = __builtin_amdgcn_mfma_f32_16x16x32_bf16(Bt[n][k], At[m][k], acc[ai][bj][m][n], 0, 0, 0); __builtin_amdgcn_s_setprio(0); } while (0)
#define PG8_WAIT_V(n) asm volatile("s_waitcnt vmcnt(" #n ")" ::: "memory")
#define PG8_WAIT_L(n) asm volatile("s_waitcnt lgkmcnt(" #n ")" ::: "memory")
#define PG8_BAR __builtin_amdgcn_s_barrier()
#define PG8_SCHED __builtin_amdgcn_sched_barrier(0)
    Unit cur, nxt; int ui = 0;
    if (!S.next(0, cur)) return;
    f32x4 acc[2][2][4][2];
#pragma unroll
    for (int a = 0; a < 2; ++a)
#pragma unroll
        for (int b = 0; b < 2; ++b)
#pragma unroll
            for (int m = 0; m < 4; ++m)
#pragma unroll
                for (int n = 0; n < 2; ++n) acc[a][b][m][n] = (f32x4){0.f, 0.f, 0.f, 0.f};
    bf16x8 At[4][2], B0[2][2], B1[2][2];
    const char* cA = (const char*)g.A + (size_t)cur.pm * tstep; const char* cB = (const char*)g.Bt + (size_t)cur.pn * tstep;
    S.a_ready(cur);
    if constexpr (SP2) {
        PG8_STAGE(PG8_SB(0, 0), cB, voffB); PG8_STAGE(PG8_SB(0, 1), cB + hstep, voffB); PG8_STAGE(PG8_SA(0, 0), cA, voffA); PG8_STAGE(PG8_SA(0, 1), cA + hstep, voffA);
        if (wr == 1) PG8_BAR;
        PG8_WAIT_V(2); PG8_BAR;
        PG8_STAGE(PG8_SB(1, 0), cB + kstep, voffB); PG8_STAGE(PG8_SA(1, 0), cA + kstep, voffA); PG8_STAGE(PG8_SB(1, 1), cB + hstep + kstep, voffB);
        PG8_WAIT_V(6); PG8_BAR;
    } else {
        PG8_STAGE(PG8_SB(0, 0), cB, voffB); PG8_STAGE(PG8_SA(0, 0), cA, voffA); PG8_STAGE(PG8_SB(0, 1), cB + hstep, voffB); PG8_STAGE(PG8_SA(0, 1), cA + hstep, voffA);
        if (wr == 1) PG8_BAR;
        PG8_WAIT_V(4); PG8_BAR;
        PG8_STAGE(PG8_SB(1, 0), cB + kstep, voffB); PG8_STAGE(PG8_SA(1, 0), cA + kstep, voffA); PG8_STAGE(PG8_SB(1, 1), cB + hstep + kstep, voffB);
        PG8_WAIT_V(6); PG8_BAR;
    }
    for (;;) {
        const bool has_next = S.next(ui + 1, nxt);
        const char* nA = has_next ? (const char*)g.A + (size_t)nxt.pm * tstep : cA; const char* nB = has_next ? (const char*)g.Bt + (size_t)nxt.pn * tstep : cB;
        for (int t = 0; t < nt; t += 2) {
            const bool last = (t == nt - 2);
            const char* a1 = cA + (size_t)(t + 1) * kstep;
            const char* a2 = last ? nA : cA + (size_t)(t + 2) * kstep; const char* b2 = last ? nB : cB + (size_t)(t + 2) * kstep;
            const char* a3 = a2 + kstep; const char* b3 = b2 + kstep;
            if (last && has_next) S.a_ready(nxt);
            if constexpr (SP2) {
            PG8_LDB(B0, 0, 0); PG8_LDB(B1, 0, 1); PG8_SCHED; PG8_LDA(At, 0, 0); PG8_STAGE(PG8_SA(1, 1), a1 + hstep, voffA);
            PG8_WAIT_V(8); PG8_WAIT_L(0); PG8_BAR; PG8_MMA(0, 0, At, B0); PG8_MMA(0, 1, At, B1); PG8_BAR; PG8_SCHED;
            PG8_LDA(At, 0, 1); PG8_STAGE(PG8_SB(0, 0), b2, voffB); PG8_STAGE(PG8_SB(0, 1), b2 + hstep, voffB); PG8_STAGE(PG8_SA(0, 0), a2, voffA);
            PG8_WAIT_V(8); PG8_WAIT_L(0); PG8_BAR; PG8_MMA(1, 0, At, B0); PG8_MMA(1, 1, At, B1); PG8_BAR; PG8_SCHED;
            PG8_LDB(B0, 1, 0); PG8_LDB(B1, 1, 1); PG8_SCHED; PG8_LDA(At, 1, 0); PG8_STAGE(PG8_SA(0, 1), a2 + hstep, voffA);
            PG8_WAIT_V(8); PG8_WAIT_L(0); PG8_BAR; PG8_MMA(0, 0, At, B0); PG8_MMA(0, 1, At, B1); PG8_BAR; PG8_SCHED;
            PG8_LDA(At, 1, 1); PG8_STAGE(PG8_SB(1, 0), b3, voffB); PG8_STAGE(PG8_SB(1, 1), b3 + hstep, voffB); PG8_STAGE(PG8_SA(1, 0), a3, voffA);
            PG8_WAIT_V(8); PG8_WAIT_L(0); PG8_BAR; PG8_MMA(1, 0, At, B0); PG8_MMA(1, 1, At, B1); PG8_BAR; PG8_SCHED;
            } else {
            PG8_LDB(B0, 0, 0); PG8_SCHED; PG8_LDA(At, 0, 0); PG8_STAGE(PG8_SA(1, 1), a1 + hstep, voffA);
            PG8_WAIT_L(8); PG8_BAR; PG8_WAIT_L(0); PG8_MMA(0, 0, At, B0); PG8_BAR; PG8_SCHED;
            PG8_LDB(B1, 0, 1); PG8_STAGE(PG8_SB(0, 0), b2, voffB);
            PG8_BAR; PG8_WAIT_L(0); PG8_MMA(0, 1, At, B1); PG8_BAR;
            PG8_LDA(At, 0, 1); PG8_STAGE(PG8_SA(0, 0), a2, voffA);
            PG8_BAR; PG8_WAIT_L(0); PG8_MMA(1, 0, At, B0); PG8_BAR; PG8_SCHED;
            PG8_STAGE(PG8_SB(0, 1), b2 + hstep, voffB);
            PG8_WAIT_V(6); PG8_BAR; PG8_MMA(1, 1, At, B1); PG8_BAR;
            PG8_LDB(B0, 1, 0); PG8_SCHED; PG8_LDA(At, 1, 0); PG8_STAGE(PG8_SA(0, 1), a2 + hstep, voffA);
            PG8_WAIT_L(8); PG8_BAR; PG8_WAIT_L(0); PG8_MMA(0, 0, At, B0); PG8_BAR; PG8_SCHED;
            PG8_LDB(B1, 1, 1); PG8_STAGE(PG8_SB(1, 0), b3, voffB);
            PG8_BAR; PG8_WAIT_L(0); PG8_MMA(0, 1, At, B1); PG8_BAR;
            PG8_LDA(At, 1, 1); PG8_STAGE(PG8_SA(1, 0), a3, voffA);
            PG8_BAR; PG8_WAIT_L(0); PG8_MMA(1, 0, At, B0); PG8_BAR; PG8_SCHED;
            PG8_STAGE(PG8_SB(1, 1), b3 + hstep, voffB);
            PG8_WAIT_V(6); PG8_BAR; PG8_MMA(1, 1, At, B1); PG8_BAR;
            }
        }
        if constexpr (ALIGN_EPI) { if (wr == 0) PG8_BAR; }
        if constexpr (!Epi::AFTER_DRAIN) { E(acc, cur, wr, wc, fr, fq); S.done(cur); }
        if (!has_next) break;
#pragma unroll
        for (int a = 0; a < 2; ++a)
#pragma unroll
            for (int b = 0; b < 2; ++b)
#pragma unroll
                for (int m = 0; m < 4; ++m)
#pragma unroll
                    for (int n = 0; n < 2; ++n) acc[a][b][m][n] = (f32x4){0.f, 0.f, 0.f, 0.f};
        cur = nxt; cA = nA; cB = nB; ++ui;
        if constexpr (ALIGN_EPI) { if (wr == 1) PG8_BAR; }
    }
    PG8_WAIT_V(0);
    if constexpr (!ALIGN_EPI) { if (wr == 0) PG8_BAR; }
    PG8_BAR;
    if constexpr (Epi::AFTER_DRAIN) { E.fused(acc, cur, wr, wc, fr, fq, lds, wid, lane); S.done(cur); }
#undef PG8_SA
#undef PG8_SB
#undef PG8_STAGE
#undef PG8_LDA
#undef PG8_LDB
#undef PG8_MMA
#undef PG8_WAIT_V
#undef PG8_WAIT_L
#undef PG8_BAR
#undef PG8_SCHED
}
}

#ifndef MK_N_LAUNCHES
#define MK_N_LAUNCHES 1
#endif
constexpr int NB = 4, SEQ = 8192, T = NB * SEQ, D = 1024, NIN = 6664, NP1 = 6656, FF = 4096, PLE = 256;
constexpr int NCH = SEQ / 64;
constexpr int CROWS = 272;
constexpr float EPS = 1e-6f;
constexpr int NPHASE = 11;
typedef pg8::bf16_t bf16_t;
typedef pg8::bf16x8 bf16x8;
typedef pg8::f32x4 f32x4;
typedef pg8::u32x4 u32x4;
typedef unsigned u32x2 __attribute__((ext_vector_type(2)));
#define LAS __attribute__((address_space(3)))

constexpr size_t MiB = 1u << 20;
constexpr size_t O_WIN = 0, O_WA = 13 * MiB, O_WB = 15 * MiB, O_WOUT = 17 * MiB, O_WG = 19 * MiB, O_WUP = 21 * MiB, O_WDN = 29 * MiB, O_WP = 37 * MiB;
constexpr size_t O_GWH = 37 * MiB + 512 * 1024, O_CBL = O_GWH + 256 * 1024, O_CMW = O_CBL + 8192, O_CAMAX = O_CMW + 8192, O_CM = O_CAMAX + 8192, O_CTR = O_CM + 8192, O_BAR = O_CTR + 256;
constexpr size_t O_QK = 40 * MiB, O_VML = 104 * MiB, O_VSW = 168 * MiB, O_KSW = 184 * MiB, O_OML = 200 * MiB, O_QSW = 264 * MiB, O_GA = 328 * MiB, O_GB = 392 * MiB;
constexpr size_t O_KT = 456 * MiB, O_VTSW = 488 * MiB, O_SSQ1 = 504 * MiB, O_SSQ2 = 506 * MiB, O_SSQ3 = 508 * MiB;
constexpr size_t O_GIG = 510 * MiB, O_GLF = O_GIG + 512 * 1024, O_GBC = 511 * MiB, O_GL = O_GBC + 512 * 1024;
constexpr size_t O_CST = 40 * MiB;
constexpr size_t O_MERGED = 40 * MiB, O_X1B = 104 * MiB, O_ACT = 200 * MiB, O_X2B = 40 * MiB, O_PB = 456 * MiB, O_PP = 104 * MiB;
constexpr size_t WS_NEED = 512 * MiB;
constexpr size_t OO_H = 0, OO_QKP = 0, OO_VT = 64 * MiB;
constexpr int LDS_BYTES = 147456;

__device__ __forceinline__ int lane_id() { int l; asm volatile("v_mbcnt_lo_u32_b32 %0, -1, 0\n\tv_mbcnt_hi_u32_b32 %0, -1, %0" : "=v"(l)); return l; }
__device__ __forceinline__ unsigned pk2(float lo, float hi) { return pg8::cvt_pk_bf16(lo, hi); }
__device__ __forceinline__ float bflo(unsigned w) { return __builtin_bit_cast(float, w << 16); }
__device__ __forceinline__ float bfhi(unsigned w) { return __builtin_bit_cast(float, w & 0xffff0000u); }
__device__ __forceinline__ float sigm(float x) { return __builtin_amdgcn_rcpf(1.f + __expf(-x)); }
__device__ __forceinline__ float wave_sum(float v) {
#pragma unroll
    for (int o = 1; o < 64; o <<= 1) v += __shfl_xor(v, o);
    return v;
}
__device__ __forceinline__ float wave_max(float v) {
#pragma unroll
    for (int o = 1; o < 64; o <<= 1) v = fmaxf(v, __shfl_xor(v, o));
    return v;
}
__device__ __forceinline__ bf16x8 ld8(const bf16_t* p) { return *(const bf16x8*)p; }
__device__ __forceinline__ f32x4 mfma16(bf16x8 a, bf16x8 b, f32x4 c) { return __builtin_amdgcn_mfma_f32_16x16x32_bf16(a, b, c, 0, 0, 0); }
__device__ __forceinline__ bf16x8 scale8(bf16x8 v, float s) {
    u32x4 u = __builtin_bit_cast(u32x4, v), o;
    o.x = pk2(bflo(u.x) * s, bfhi(u.x) * s); o.y = pk2(bflo(u.y) * s, bfhi(u.y) * s); o.z = pk2(bflo(u.z) * s, bfhi(u.z) * s); o.w = pk2(bflo(u.w) * s, bfhi(u.w) * s);
    return __builtin_bit_cast(bf16x8, o);
}
__device__ __forceinline__ float rdlane(float v, int l) { return __builtin_bit_cast(float, __builtin_amdgcn_readlane(__builtin_bit_cast(int, v), l)); }

#define EPI_LOOP_BEGIN const int row0 = u.pm * 256 + wr * 64 + fr, col0 = u.pn * 256 + wc * 32 + 8 * fq; \
    _Pragma("unroll") for (int ai = 0; ai < 2; ++ai) _Pragma("unroll") for (int m = 0; m < 4; ++m) { const int row = row0 + ai * 128 + m * 16;
#define EPI_LOOP_END }
typedef pg8::Unit Unit;

struct EpiSeg {
    static constexpr bool PERM = true, AFTER_DRAIN = false;
    unsigned char* ws;
    __device__ __forceinline__ void operator()(const f32x4 (&acc)[2][2][4][2], const Unit& u, int wr, int wc, int fr, int fq) const {
        const int pn = u.pn; size_t off; int ldc, ct;
        if (pn < 4) { off = O_QK; ldc = 1024; ct = pn; } else if (pn < 8) { off = O_VML; ldc = 1024; ct = pn - 4; } else if (pn < 12) { off = O_OML; ldc = 1024; ct = pn - 8; }
        else if (pn < 16) { off = O_QSW; ldc = 1024; ct = pn - 12; } else if (pn < 17) { off = O_KSW; ldc = 256; ct = 0; } else if (pn < 18) { off = O_VSW; ldc = 256; ct = 0; }
        else if (pn < 22) { off = O_GA; ldc = 1024; ct = pn - 18; } else { off = O_GB; ldc = 1024; ct = pn - 22; }
        bf16_t* base = (bf16_t*)(ws + off) + ct * 256 + wc * 32 + 8 * fq;
        const int row0 = u.pm * 256 + wr * 64 + fr;
#pragma unroll
        for (int ai = 0; ai < 2; ++ai)
#pragma unroll
            for (int m = 0; m < 4; ++m) { bf16_t* rowp = base + (size_t)(row0 + ai * 128 + m * 16) * ldc;
#pragma unroll
                for (int bj = 0; bj < 2; ++bj) { const f32x4 v0 = acc[ai][bj][m][0], v1 = acc[ai][bj][m][1]; u32x4 w;
                    w.x = pk2(v0[0], v0[1]); w.y = pk2(v0[2], v0[3]); w.z = pk2(v1[0], v1[1]); w.w = pk2(v1[2], v1[3]); *(u32x4*)(rowp + bj * 128) = w; } }
    }
};
struct EpiPlain {
    static constexpr bool PERM = true, AFTER_DRAIN = false;
    bf16_t* O; int ldc;
    __device__ __forceinline__ void operator()(const f32x4 (&acc)[2][2][4][2], const Unit& u, int wr, int wc, int fr, int fq) const {
        EPI_LOOP_BEGIN
#pragma unroll
            for (int bj = 0; bj < 2; ++bj) { const f32x4 v0 = acc[ai][bj][m][0], v1 = acc[ai][bj][m][1]; u32x4 w;
                w.x = pk2(v0[0], v0[1]); w.y = pk2(v0[2], v0[3]); w.z = pk2(v1[0], v1[1]); w.w = pk2(v1[2], v1[3]); *(u32x4*)(O + (size_t)row * ldc + col0 + bj * 128) = w; }
        EPI_LOOP_END
    }
};
struct EpiGateA {
    static constexpr bool PERM = true, AFTER_DRAIN = false;
    const bf16_t* G; float* M1;
    __device__ __forceinline__ void operator()(const f32x4 (&acc)[2][2][4][2], const Unit& u, int wr, int wc, int fr, int fq) const {
        EPI_LOOP_BEGIN
#pragma unroll
            for (int bj = 0; bj < 2; ++bj) { const size_t idx = (size_t)row * D + col0 + bj * 128; const u32x4 g = *(const u32x4*)(G + idx);
                const f32x4 v0 = acc[ai][bj][m][0], v1 = acc[ai][bj][m][1]; f32x4 o0, o1;
                o0[0] = sigm(bflo(g.x)) * v0[0]; o0[1] = sigm(bfhi(g.x)) * v0[1]; o0[2] = sigm(bflo(g.y)) * v0[2]; o0[3] = sigm(bfhi(g.y)) * v0[3];
                o1[0] = sigm(bflo(g.z)) * v1[0]; o1[1] = sigm(bfhi(g.z)) * v1[1]; o1[2] = sigm(bflo(g.w)) * v1[2]; o1[3] = sigm(bfhi(g.w)) * v1[3];
                *(f32x4*)(M1 + idx) = o0; *(f32x4*)(M1 + idx + 4) = o1; }
        EPI_LOOP_END
    }
};
struct EpiGateB {
    static constexpr bool PERM = true, AFTER_DRAIN = false;
    const bf16_t* G; const float* M1; bf16_t* O;
    __device__ __forceinline__ void operator()(const f32x4 (&acc)[2][2][4][2], const Unit& u, int wr, int wc, int fr, int fq) const {
        EPI_LOOP_BEGIN
#pragma unroll
            for (int bj = 0; bj < 2; ++bj) { const size_t idx = (size_t)row * D + col0 + bj * 128; const u32x4 g = *(const u32x4*)(G + idx);
                const f32x4 a0 = *(const f32x4*)(M1 + idx), a1 = *(const f32x4*)(M1 + idx + 4);
                const f32x4 v0 = acc[ai][bj][m][0], v1 = acc[ai][bj][m][1]; u32x4 w;
                w.x = pk2(a0[0] + sigm(bflo(g.x)) * v0[0], a0[1] + sigm(bfhi(g.x)) * v0[1]); w.y = pk2(a0[2] + sigm(bflo(g.y)) * v0[2], a0[3] + sigm(bfhi(g.y)) * v0[3]);
                w.z = pk2(a1[0] + sigm(bflo(g.z)) * v1[0], a1[1] + sigm(bfhi(g.z)) * v1[1]); w.w = pk2(a1[2] + sigm(bflo(g.w)) * v1[2], a1[3] + sigm(bfhi(g.w)) * v1[3]);
                *(u32x4*)(O + idx) = w; }
        EPI_LOOP_END
    }
};
struct EpiRes {
    static constexpr bool PERM = true, AFTER_DRAIN = false;
    const float* XI; float* XO; bf16_t* XB; float* SSQ;
    __device__ __forceinline__ void operator()(const f32x4 (&acc)[2][2][4][2], const Unit& u, int wr, int wc, int fr, int fq) const {
        EPI_LOOP_BEGIN
            float ss = 0.f;
#pragma unroll
            for (int bj = 0; bj < 2; ++bj) { const size_t idx = (size_t)row * D + col0 + bj * 128;
                const f32x4 o0 = *(const f32x4*)(XI + idx) + acc[ai][bj][m][0], o1 = *(const f32x4*)(XI + idx + 4) + acc[ai][bj][m][1];
                *(f32x4*)(XO + idx) = o0; *(f32x4*)(XO + idx + 4) = o1;
                u32x4 w; w.x = pk2(o0[0], o0[1]); w.y = pk2(o0[2], o0[3]); w.z = pk2(o1[0], o1[1]); w.w = pk2(o1[2], o1[3]); *(u32x4*)(XB + idx) = w;
                ss += (o0[0] * o0[0] + o0[1] * o0[1]) + (o0[2] * o0[2] + o0[3] * o0[3]) + (o1[0] * o1[0] + o1[1] * o1[1]) + (o1[2] * o1[2] + o1[3] * o1[3]); }
            ss += __shfl_xor(ss, 16); ss += __shfl_xor(ss, 32);
            if (fq == 0) SSQ[(size_t)row * 16 + u.pn * 4 + wc] = ss;
        EPI_LOOP_END
    }
};
__device__ __forceinline__ float row_rstd(const float* SSQ, int row) {
    const f32x4* p = (const f32x4*)(SSQ + (size_t)row * 16); const f32x4 a = p[0], b = p[1], c = p[2], d = p[3];
    const float s = ((a[0] + a[1]) + (a[2] + a[3])) + ((b[0] + b[1]) + (b[2] + b[3])) + ((c[0] + c[1]) + (c[2] + c[3])) + ((d[0] + d[1]) + (d[2] + d[3]));
    return rsqrtf(s * (1.f / D) + EPS);
}
struct EpiUp {
    static constexpr bool PERM = true, AFTER_DRAIN = false;
    const float* SSQ; bf16_t* O;
    __device__ __forceinline__ void operator()(const f32x4 (&acc)[2][2][4][2], const Unit& u, int wr, int wc, int fr, int fq) const {
        EPI_LOOP_BEGIN
            const float rs = row_rstd(SSQ, row);
#pragma unroll
            for (int bj = 0; bj < 2; ++bj) { f32x4 v0 = acc[ai][bj][m][0] * rs, v1 = acc[ai][bj][m][1] * rs;
#pragma unroll
                for (int e = 0; e < 4; ++e) { const float a = fmaxf(v0[e], 0.f), b = fmaxf(v1[e], 0.f); v0[e] = a * a; v1[e] = b * b; }
                u32x4 w; w.x = pk2(v0[0], v0[1]); w.y = pk2(v0[2], v0[3]); w.z = pk2(v1[0], v1[1]); w.w = pk2(v1[2], v1[3]); *(u32x4*)(O + (size_t)row * FF + col0 + bj * 128) = w; }
        EPI_LOOP_END
    }
};
struct EpiPle {
    static constexpr bool PERM = true, AFTER_DRAIN = false;
    const float* SSQI; const bf16_t* PP; float* X; float* SSQO;
    __device__ __forceinline__ void operator()(const f32x4 (&acc)[2][2][4][2], const Unit& u, int wr, int wc, int fr, int fq) const {
        EPI_LOOP_BEGIN
            const float rs = row_rstd(SSQI, row); float ss = 0.f;
#pragma unroll
            for (int bj = 0; bj < 2; ++bj) { const size_t idx = (size_t)row * D + col0 + bj * 128; const u32x4 p = *(const u32x4*)(PP + idx);
                const f32x4 v0 = acc[ai][bj][m][0] * rs, v1 = acc[ai][bj][m][1] * rs; f32x4 o0 = *(const f32x4*)(X + idx), o1 = *(const f32x4*)(X + idx + 4);
                o0[0] += sigm(v0[0]) * bflo(p.x); o0[1] += sigm(v0[1]) * bfhi(p.x); o0[2] += sigm(v0[2]) * bflo(p.y); o0[3] += sigm(v0[3]) * bfhi(p.y);
                o1[0] += sigm(v1[0]) * bflo(p.z); o1[1] += sigm(v1[1]) * bfhi(p.z); o1[2] += sigm(v1[2]) * bflo(p.w); o1[3] += sigm(v1[3]) * bfhi(p.w);
                *(f32x4*)(X + idx) = o0; *(f32x4*)(X + idx + 4) = o1;
                ss += (o0[0] * o0[0] + o0[1] * o0[1]) + (o0[2] * o0[2] + o0[3] * o0[3]) + (o1[0] * o1[0] + o1[1] * o1[1]) + (o1[2] * o1[2] + o1[3] * o1[3]); }
            ss += __shfl_xor(ss, 16); ss += __shfl_xor(ss, 32);
            if (fq == 0) SSQO[(size_t)row * 16 + u.pn * 4 + wc] = ss;
        EPI_LOOP_END
    }
};

template <class Epi> __device__ __forceinline__ void run_gemm(LAS unsigned char* lds, int wave, const bf16_t* A, const bf16_t* Bt, int M, int N, int K, const Epi& E) {
    pg8::Gemm g{A, Bt, M, N, K}; pg8::StaticOrder S; S.init(M, N, (int)gridDim.x, (int)blockIdx.x);
    pg8::gemm_phase<Epi, pg8::StaticOrder, true, true>(lds, g, S, E, wave);
}

__device__ __forceinline__ void p0_transpose_item(const float* W, int ldw, int K, int nblk, bf16_t* WT, const float* ksc, LAS float* scr, int item, int lane) {
    const int kb = item / nblk, nb = item % nblk, k0 = 64 * kb, n0 = 32 * nb;
#pragma unroll 8
    for (int i = 0; i < 32; ++i) { const int kk = 2 * i + (lane >> 5); float v = W[(size_t)(k0 + kk) * ldw + n0 + (lane & 31)]; if (ksc) v *= ksc[k0 + kk]; scr[kk * 33 + (lane & 31)] = v; }
    asm volatile("s_waitcnt lgkmcnt(0)" ::: "memory");
    const int c = lane & 7;
#pragma unroll
    for (int j = 0; j < 4; ++j) { const int n = (lane >> 3) + 8 * j; const LAS float* s = scr + (8 * c) * 33 + n;
        u32x4 o; o.x = pk2(s[0 * 33], s[1 * 33]); o.y = pk2(s[2 * 33], s[3 * 33]); o.z = pk2(s[4 * 33], s[5 * 33]); o.w = pk2(s[6 * 33], s[7 * 33]);
        *(u32x4*)(WT + (size_t)(n0 + n) * K + k0 + 8 * c) = o; }
    asm volatile("s_waitcnt lgkmcnt(0)" ::: "memory");
}
__device__ __forceinline__ float logsigmoid(float z) { return fminf(z, 0.f) - log1pf(__expf(-fabsf(z))); }

struct Args { const float* in[18]; float* out; unsigned char* ws; int ph_lo, ph_hi; };

__device__ __forceinline__ void phase0(const Args& a, LAS unsigned char* lds, int wave) {
    const int lane = lane_id();
    unsigned char* ws = a.ws;
    LAS float* scr = (LAS float*)(lds + wave * 16384);
    const int gw = blockIdx.x * 8 + wave, NGW = gridDim.x * 8;
    if (blockIdx.x == 0 && wave == 0 && lane == 0) *(unsigned*)(ws + O_CTR) = 0u;
    constexpr int I_IN1 = 16 * 96, I_IN2 = 16 * 112, I_SQ = 16 * 32, I_UP = 16 * 128, I_DN = 64 * 32, I_P = 4 * 32;
    constexpr int NITEMS = I_IN1 + I_IN2 + 4 * I_SQ + I_UP + I_DN + I_P;
    const float* w_in = a.in[3];
    for (int it = gw; it < NITEMS; it += NGW) {
        int r = it;
        if (r < I_IN1) { p0_transpose_item(w_in, NIN, D, 96, (bf16_t*)(ws + O_WIN), nullptr, scr, r, lane); continue; } r -= I_IN1;
        if (r < I_IN2) { p0_transpose_item(w_in + 3080, NIN, D, 112, (bf16_t*)(ws + O_WIN) + (size_t)3072 * D, nullptr, scr, r, lane); continue; } r -= I_IN2;
        if (r < I_SQ) { p0_transpose_item(a.in[8], D, D, 32, (bf16_t*)(ws + O_WA), nullptr, scr, r, lane); continue; } r -= I_SQ;
        if (r < I_SQ) { p0_transpose_item(a.in[9], D, D, 32, (bf16_t*)(ws + O_WB), nullptr, scr, r, lane); continue; } r -= I_SQ;
        if (r < I_SQ) { p0_transpose_item(a.in[10], D, D, 32, (bf16_t*)(ws + O_WOUT), nullptr, scr, r, lane); continue; } r -= I_SQ;
        if (r < I_SQ) { p0_transpose_item(a.in[15], D, D, 32, (bf16_t*)(ws + O_WG), a.in[14], scr, r, lane); continue; } r -= I_SQ;
        if (r < I_UP) { p0_transpose_item(a.in[12], FF, D, 128, (bf16_t*)(ws + O_WUP), a.in[11], scr, r, lane); continue; } r -= I_UP;
        if (r < I_DN) { p0_transpose_item(a.in[13], D, FF, 32, (bf16_t*)(ws + O_WDN), nullptr, scr, r, lane); continue; } r -= I_DN;
        p0_transpose_item(a.in[16], D, PLE, 32, (bf16_t*)(ws + O_WP), nullptr, scr, r, lane);
    }
    const float* x = a.in[0]; const float* g = a.in[2]; const float* bif = a.in[5];
    bf16_t* H = (bf16_t*)((unsigned char*)a.out + OO_H);
    float* gig = (float*)(ws + O_GIG); float* glf = (float*)(ws + O_GLF);
    for (int row = gw; row < T; row += NGW) {
        const f32x4* xr = (const f32x4*)(x + (size_t)row * D) + lane; const f32x4* gr = (const f32x4*)g + lane;
        f32x4 v[4]; float s = 0.f;
#pragma unroll
        for (int j = 0; j < 4; ++j) { v[j] = xr[64 * j]; s += (v[j][0] * v[j][0] + v[j][1] * v[j][1]) + (v[j][2] * v[j][2] + v[j][3] * v[j][3]); }
        const float rstd = rsqrtf(wave_sum(s) * (1.f / D) + EPS);
        float g8[8];
#pragma unroll
        for (int e = 0; e < 8; ++e) g8[e] = 0.f;
        u32x2* o8 = (u32x2*)(H + (size_t)row * D) + lane;
#pragma unroll
        for (int j = 0; j < 4; ++j) { const f32x4 hv = v[j] * rstd * gr[64 * j]; u32x2 o; o.x = pk2(hv[0], hv[1]); o.y = pk2(hv[2], hv[3]); o8[64 * j] = o;
#pragma unroll
            for (int e = 0; e < 4; ++e) { const int k = 4 * lane + 256 * j + e; const f32x4* wr = (const f32x4*)(w_in + (size_t)k * NIN + 3072); const f32x4 w0 = wr[0], w1 = wr[1];
                g8[0] += hv[e] * w0[0]; g8[1] += hv[e] * w0[1]; g8[2] += hv[e] * w0[2]; g8[3] += hv[e] * w0[3]; g8[4] += hv[e] * w1[0]; g8[5] += hv[e] * w1[1]; g8[6] += hv[e] * w1[2]; g8[7] += hv[e] * w1[3]; } }
#pragma unroll
        for (int e = 0; e < 8; ++e) g8[e] = wave_sum(g8[e]);
        if (lane == 0) { const int b = row / SEQ, s_ = row % SEQ;
#pragma unroll
            for (int hh = 0; hh < 4; ++hh) { gig[(size_t)(b * 4 + hh) * SEQ + s_] = g8[hh] + bif[hh]; glf[(size_t)(b * 4 + hh) * SEQ + s_] = logsigmoid(g8[4 + hh] + bif[4 + hh]); } }
    }
}

__device__ __forceinline__ void gate_chunk(float lf, float ig, int lane, float& b, float& av, float& amax, float& pm) {
    float v = lf;
#pragma unroll
    for (int o = 1; o < 64; o <<= 1) { const float t = __shfl_up(v, o); if (lane >= o) v += t; }
    b = v; av = ig - v; float q = av;
#pragma unroll
    for (int o = 1; o < 64; o <<= 1) { const float t = __shfl_up(q, o); if (lane >= o) q = fmaxf(q, t); }
    pm = q; amax = wave_max(av);
}
__device__ __forceinline__ void phase2(const Args& a, LAS unsigned char* lds, int wave) {
    const int lane = lane_id();
    unsigned char* ws = a.ws;
    LAS unsigned* tile = (LAS unsigned*)(lds + wave * 16384);
    LAS unsigned short* tile16 = (LAS unsigned short*)tile;
    const int gw = blockIdx.x * 8 + wave, NGW = gridDim.x * 8;
    const bf16_t* QK = (const bf16_t*)(ws + O_QK); const bf16_t* VML = (const bf16_t*)(ws + O_VML); const bf16_t* VSW = (const bf16_t*)(ws + O_VSW);
    bf16_t* QKP = (bf16_t*)((unsigned char*)a.out + OO_QKP); bf16_t* VT = (bf16_t*)((unsigned char*)a.out + OO_VT);
    bf16_t* KT = (bf16_t*)(ws + O_KT); bf16_t* VTSW = (bf16_t*)(ws + O_VTSW);
    const float* gig = (const float*)(ws + O_GIG); const float* glf = (const float*)(ws + O_GLF);
    const float* cw = a.in[4];
    const int rsub = lane >> 3, cg8 = lane & 7;
    constexpr int N_QK = 512 * 16, N_VML = 512 * 16, N_VSW = 512 * 4, N_TILE = N_QK + N_VML + N_VSW, N_ALL = N_TILE + 16 * NCH;
    for (int it = gw; it < N_ALL; it += NGW) {
        if (it >= N_TILE) {
            const int q = it - N_TILE, bh = q / NCH, c = q % NCH; const size_t gi = (size_t)bh * SEQ + c * 64 + lane;
            float b, av, amax, pm; gate_chunk(glf[gi], gig[gi], lane, b, av, amax, pm);
            ((float*)(ws + O_GBC))[gi] = b; ((float*)(ws + O_GL))[gi] = b + pm;
            ((bf16_t*)(ws + O_GWH))[gi] = (bf16_t)(pk2(__expf(av - amax), 0.f) & 0xffffu);
            const float bl = rdlane(b, 63);
            if (lane == 0) { ((float*)(ws + O_CBL))[q] = bl; ((float*)(ws + O_CMW))[q] = bl + amax; ((float*)(ws + O_CAMAX))[q] = amax; }
            continue;
        }
        int kind, tt, ct;
        if (it < N_QK) { kind = 0; tt = it >> 4; ct = it & 15; } else if (it < N_QK + N_VML) { kind = 1; tt = (it - N_QK) >> 4; ct = (it - N_QK) & 15; } else { kind = 2; tt = (it - N_QK - N_VML) >> 2; ct = (it - N_QK - N_VML) & 3; }
        const int t0 = tt * 64, c0 = ct * 64, bb = t0 / SEQ, s0 = t0 % SEQ, c = c0 + 8 * cg8;
        if (kind == 0) {
            float w[4][8];
#pragma unroll
            for (int j = 0; j < 4; ++j) { const f32x4 w0 = *(const f32x4*)(cw + j * 1024 + c), w1 = *(const f32x4*)(cw + j * 1024 + c + 4);
                w[j][0] = w0[0]; w[j][1] = w0[1]; w[j][2] = w0[2]; w[j][3] = w0[3]; w[j][4] = w1[0]; w[j][5] = w1[1]; w[j][6] = w1[2]; w[j][7] = w1[3]; }
            const float qs = (c < 512) ? 0.08838834764831845f : 1.f;
#pragma unroll 2
            for (int i = 0; i < 8; ++i) { const int r = 8 * i + rsub, t = t0 + r, sp = s0 + r;
                float acc8[8];
#pragma unroll
                for (int e = 0; e < 8; ++e) acc8[e] = 0.f;
#pragma unroll
                for (int j = 0; j < 4; ++j) { if (sp - 3 + j >= 0) { const u32x4 xv = *(const u32x4*)(QK + (size_t)(t - 3 + j) * 1024 + c);
                        acc8[0] += w[j][0] * bflo(xv.x); acc8[1] += w[j][1] * bfhi(xv.x); acc8[2] += w[j][2] * bflo(xv.y); acc8[3] += w[j][3] * bfhi(xv.y);
                        acc8[4] += w[j][4] * bflo(xv.z); acc8[5] += w[j][5] * bfhi(xv.z); acc8[6] += w[j][6] * bflo(xv.w); acc8[7] += w[j][7] * bfhi(xv.w); } }
#pragma unroll
                for (int e = 0; e < 8; ++e) acc8[e] = acc8[e] * sigm(acc8[e]) * qs;
                u32x4 o; o.x = pk2(acc8[0], acc8[1]); o.y = pk2(acc8[2], acc8[3]); o.z = pk2(acc8[4], acc8[5]); o.w = pk2(acc8[6], acc8[7]);
                *(u32x4*)(QKP + (size_t)t * 1024 + c) = o;
                if (c0 >= 512) { LAS unsigned* tp = tile + r * 33 + 4 * cg8; tp[0] = o.x; tp[1] = o.y; tp[2] = o.z; tp[3] = o.w; } }
            if (c0 < 512) continue;
        } else {
            float wh = 1.f;
            if (kind == 1) { const int bh = bb * 4 + (c0 >> 8); const size_t gi = (size_t)bh * SEQ + s0 + lane; float b, av, amax, pm; gate_chunk(glf[gi], gig[gi], lane, b, av, amax, pm); wh = __expf(av - amax); }
            const bf16_t* src = (kind == 1) ? VML : VSW; const int ld = (kind == 1) ? 1024 : 256;
#pragma unroll 2
            for (int i = 0; i < 8; ++i) { const int r = 8 * i + rsub; u32x4 o = *(const u32x4*)(src + (size_t)(t0 + r) * ld + c);
                const float sc = __shfl(wh, r);
                if (kind == 1) { o.x = pk2(bflo(o.x) * sc, bfhi(o.x) * sc); o.y = pk2(bflo(o.y) * sc, bfhi(o.y) * sc); o.z = pk2(bflo(o.z) * sc, bfhi(o.z) * sc); o.w = pk2(bflo(o.w) * sc, bfhi(o.w) * sc); }
                LAS unsigned* tp = tile + r * 33 + 4 * cg8; tp[0] = o.x; tp[1] = o.y; tp[2] = o.z; tp[3] = o.w; }
        }
        asm volatile("s_waitcnt lgkmcnt(0)" ::: "memory");
        bf16_t* dst; int C, cb;
        if (kind == 0) { dst = KT; C = 512; cb = c0 - 512; } else if (kind == 1) { dst = VT; C = 1024; cb = c0; } else { dst = VTSW; C = 256; cb = c0; }
#pragma unroll 2
        for (int i = 0; i < 8; ++i) { const int ch = 8 * i + (lane >> 3), tg = lane & 7; const LAS unsigned short* sp = tile16 + (8 * tg) * 66 + ch;
            u32x4 o; o.x = (unsigned)sp[0] | ((unsigned)sp[66] << 16); o.y = (unsigned)sp[2 * 66] | ((unsigned)sp[3 * 66] << 16); o.z = (unsigned)sp[4 * 66] | ((unsigned)sp[5 * 66] << 16); o.w = (unsigned)sp[6 * 66] | ((unsigned)sp[7 * 66] << 16);
            *(u32x4*)(dst + ((size_t)bb * C + cb + ch) * SEQ + s0 + 8 * tg) = o; }
        asm volatile("s_waitcnt lgkmcnt(0)" ::: "memory");
    }
}

__device__ __forceinline__ void scan_unit(const Args& a, int u, int lane) {
    unsigned char* ws = a.ws;
    const int dq = u & 3, sl = (u >> 2) % 17, bh = u / 68, fr = lane & 15, fq = lane >> 4;
    const bf16_t* KT = (const bf16_t*)(ws + O_KT); const bf16_t* VT = (const bf16_t*)((unsigned char*)a.out + OO_VT); const bf16_t* GWH = (const bf16_t*)(ws + O_GWH);
    const bf16_t* pa = KT + (size_t)(bh * 128 + 32 * dq + fr) * SEQ + 8 * fq;
    const bf16_t* pb = (sl < 16) ? VT + (size_t)(bh * 256 + 16 * sl + fr) * SEQ + 8 * fq : GWH + (size_t)bh * SEQ + 8 * fq;
    bf16_t* pst = (bf16_t*)(ws + O_CST) + ((size_t)(bh * NCH) * CROWS + 16 * sl + fr) * 128 + 32 * dq + 4 * fq;
    const float* cbl = (const float*)(ws + O_CBL) + bh * NCH; const float* cmw = (const float*)(ws + O_CMW) + bh * NCH; float* cm = (float*)(ws + O_CM) + bh * NCH;
    const float bl0 = cbl[lane], bl1 = cbl[64 + lane], mw0 = cmw[lane], mw1 = cmw[64 + lane];
    const bool wr_m = (sl == 0 && dq == 0 && lane == 0);
    constexpr int PF = 4;
    bf16x8 ra[PF][4], rb[PF][2];
#define SC_LOAD(slot, cc) do { ra[slot][0] = ld8(pa + (cc) * 64); ra[slot][1] = ld8(pa + (cc) * 64 + 32); ra[slot][2] = ld8(pa + 16 * SEQ + (cc) * 64); ra[slot][3] = ld8(pa + 16 * SEQ + (cc) * 64 + 32); \
        rb[slot][0] = ld8(pb + (cc) * 64); rb[slot][1] = ld8(pb + (cc) * 64 + 32); } while (0)
#pragma unroll
    for (int p = 0; p < PF; ++p) SC_LOAD(p, p);
    f32x4 acc0 = {0.f, 0.f, 0.f, 0.f}, acc1 = {0.f, 0.f, 0.f, 0.f}; float mst = 0.f;
    for (int c0 = 0; c0 < NCH; c0 += PF) {
#pragma unroll
        for (int p = 0; p < PF; ++p) { const int c = c0 + p;
            bf16_t* st = pst + (size_t)c * (CROWS * 128);
            u32x2 s0; s0.x = pk2(acc0[0], acc0[1]); s0.y = pk2(acc0[2], acc0[3]); *(u32x2*)st = s0;
            u32x2 s1; s1.x = pk2(acc1[0], acc1[1]); s1.y = pk2(acc1[2], acc1[3]); *(u32x2*)(st + 16) = s1;
            const float bl = (c < 64) ? rdlane(bl0, c & 63) : rdlane(bl1, c & 63), mw = (c < 64) ? rdlane(mw0, c & 63) : rdlane(mw1, c & 63);
            if (wr_m) cm[c] = mst;
            const float mn = fmaxf(bl + mst, mw), decay = __expf(bl + mst - mn), eta = __expf(mw - mn);
            const f32x4 z = {0.f, 0.f, 0.f, 0.f};
            f32x4 t0 = mfma16(ra[p][0], rb[p][0], z); t0 = mfma16(ra[p][1], rb[p][1], t0);
            f32x4 t1 = mfma16(ra[p][2], rb[p][0], z); t1 = mfma16(ra[p][3], rb[p][1], t1);
            acc0 = acc0 * decay + t0 * eta; acc1 = acc1 * decay + t1 * eta; mst = mn;
            if (c + PF < NCH) SC_LOAD(p, c + PF);
        }
    }
#undef SC_LOAD
}

__device__ __forceinline__ void swa_unit(const Args& a, int wu, int lane) {
    unsigned char* ws = a.ws;
    const int g16 = wu & 511, hq = (wu >> 9) & 15, b = wu >> 13, kvh = hq >> 2, fr = lane & 15, fq = lane >> 4;
    bf16_t* QSW = (bf16_t*)(ws + O_QSW); const bf16_t* KSW = (const bf16_t*)(ws + O_KSW); const bf16_t* VTSW = (const bf16_t*)(ws + O_VTSW);
    const int t0 = 16 * g16, tq = t0 + fr, kb = t0 - 144;
    const bf16_t* qp = QSW + (size_t)(b * SEQ + tq) * 1024 + hq * 64 + 8 * fq;
    const bf16x8 qf0 = ld8(qp), qf1 = ld8(qp + 32);
    const float sink = a.in[7][hq];
    f32x4 st[10];
    const int krow = 8 * (fr >> 2) + (fr & 3);
#pragma unroll
    for (int tau = 0; tau < 10; ++tau) { const int i = tau >> 1, e = tau & 1; int kp = kb + 32 * i + krow + 4 * e; kp = kp < 0 ? 0 : kp;
        const bf16_t* kq = KSW + (size_t)(b * SEQ + kp) * 256 + kvh * 64 + 8 * fq;
        f32x4 s = {0.f, 0.f, 0.f, 0.f}; s = mfma16(ld8(kq), qf0, s); s = mfma16(ld8(kq + 32), qf1, s); st[tau] = s; }
    float mx = -1e30f;
#pragma unroll
    for (int tau = 0; tau < 10; ++tau) { const int i = tau >> 1, e = tau & 1;
#pragma unroll
        for (int r = 0; r < 4; ++r) { const int kp = kb + 32 * i + 8 * fq + 4 * e + r, df = tq - kp; const bool ok = (kp >= 0) && (df >= 0) && (df < 128);
            const float l = ok ? st[tau][r] * 0.125f : -1e30f; st[tau][r] = l; mx = fmaxf(mx, l); } }
    mx = fmaxf(mx, __shfl_xor(mx, 16)); mx = fmaxf(mx, __shfl_xor(mx, 32)); mx = fmaxf(mx, sink);
    float sum = 0.f;
#pragma unroll
    for (int tau = 0; tau < 10; ++tau)
#pragma unroll
        for (int r = 0; r < 4; ++r) { const float p = __expf(st[tau][r] - mx); st[tau][r] = p; sum += p; }
    sum += __shfl_xor(sum, 16); sum += __shfl_xor(sum, 32);
    const float inv = 1.f / (sum + __expf(sink - mx));
    bf16x8 pf[5];
#pragma unroll
    for (int i = 0; i < 5; ++i) { u32x4 w; w.x = pk2(st[2 * i][0], st[2 * i][1]); w.y = pk2(st[2 * i][2], st[2 * i][3]); w.z = pk2(st[2 * i + 1][0], st[2 * i + 1][1]); w.w = pk2(st[2 * i + 1][2], st[2 * i + 1][3]); pf[i] = __builtin_bit_cast(bf16x8, w); }
    f32x4 o[4];
#pragma unroll
    for (int mt = 0; mt < 4; ++mt) { const int hd = 16 * (fr >> 2) + 4 * mt + (fr & 3); const bf16_t* vp = VTSW + (size_t)((b * 4 + kvh) * 64 + hd) * SEQ;
        f32x4 s = {0.f, 0.f, 0.f, 0.f};
#pragma unroll
        for (int i = 0; i < 5; ++i) { int sp = kb + 32 * i + 8 * fq; sp = sp < 0 ? 0 : sp; s = mfma16(ld8(vp + sp), pf[i], s); }
        o[mt] = s * inv; }
    u32x4 w0, w1; w0.x = pk2(o[0][0], o[0][1]); w0.y = pk2(o[0][2], o[0][3]); w0.z = pk2(o[1][0], o[1][1]); w0.w = pk2(o[1][2], o[1][3]);
    w1.x = pk2(o[2][0], o[2][1]); w1.y = pk2(o[2][2], o[2][3]); w1.z = pk2(o[3][0], o[3][1]); w1.w = pk2(o[3][2], o[3][3]);
    bf16_t* op = QSW + (size_t)(b * SEQ + tq) * 1024 + hq * 64 + 16 * fq;
    *(u32x4*)op = w0; *(u32x4*)(op + 8) = w1;
}
__device__ __forceinline__ void phase3(const Args& a, int wave) {
    const int lane = lane_id();
    const int gwm = wave * (int)gridDim.x + (int)blockIdx.x;
    if (gwm < 16 * 17 * 4) scan_unit(a, gwm, lane);
    unsigned* ctr = (unsigned*)(a.ws + O_CTR);
    for (;;) {
        unsigned wu = 0; if (lane == 0) wu = atomicAdd(ctr, 1u);
        wu = (unsigned)__builtin_amdgcn_readfirstlane((int)wu);
        if (wu >= (unsigned)(NB * 16 * 512)) break;
        swa_unit(a, (int)wu, lane);
    }
}

__device__ __forceinline__ void phase4(const Args& a, LAS unsigned char* lds, int wave) {
    const int lane = lane_id();
    unsigned char* ws = a.ws;
    { const f32x4* p = (const f32x4*)a.in[1]; u32x2* pbo = (u32x2*)(ws + O_PB); const int n = T * PLE / 4;
        for (int i = blockIdx.x * 512 + wave * 64 + lane; i < n; i += gridDim.x * 512) { const f32x4 v = p[i]; u32x2 o; o.x = pk2(v[0], v[1]); o.y = pk2(v[2], v[3]); pbo[i] = o; } }
    const bf16_t* QKP = (const bf16_t*)((unsigned char*)a.out + OO_QKP); const bf16_t* VT = (const bf16_t*)((unsigned char*)a.out + OO_VT);
    const bf16_t* CST = (const bf16_t*)(ws + O_CST); const bf16_t* GWH = (const bf16_t*)(ws + O_GWH); bf16_t* OML = (bf16_t*)(ws + O_OML);
    const float* gbc = (const float*)(ws + O_GBC); const float* gL = (const float*)(ws + O_GL); const float* cm = (const float*)(ws + O_CM); const float* camax = (const float*)(ws + O_CAMAX);
    const float* gn = a.in[6];
    LAS bf16_t* Pt = (LAS bf16_t*)lds;
    LAS float* red = (LAS float*)(lds + 16384);
    const int fr = lane & 15, fq = lane >> 4, w = wave;
    for (int un = blockIdx.x; un < 16 * NCH; un += gridDim.x) {
        const int bh = un / NCH, c = un % NCH, bb = bh >> 2, h = bh & 3; const size_t tok0 = (size_t)bb * SEQ + c * 64;
        const float m_c = cm[un], amax = camax[un];
        float F[4], wi[4], en[4];
#pragma unroll
        for (int tt = 0; tt < 4; ++tt) { const size_t gi = (size_t)bh * SEQ + c * 64 + 16 * tt + fr; const float bt = gbc[gi], mt = fmaxf(bt + m_c, gL[gi]);
            F[tt] = __expf(bt - mt + amax); wi[tt] = __expf(bt + m_c - mt); en[tt] = __expf(-mt); }
        { const int st = w >> 1; const bf16_t* kp = QKP + (tok0 + 16 * st + fr) * 1024 + 512 + h * 128 + 8 * fq;
            bf16x8 kf[4];
#pragma unroll
            for (int ks = 0; ks < 4; ++ks) kf[ks] = ld8(kp + 32 * ks);
#pragma unroll
            for (int j = 0; j < 2; ++j) { const int tt = 2 * (w & 1) + j; const bf16_t* qp = QKP + (tok0 + 16 * tt + fr) * 1024 + h * 128 + 8 * fq;
                f32x4 s = {0.f, 0.f, 0.f, 0.f};
#pragma unroll
                for (int ks = 0; ks < 4; ++ks) s = mfma16(kf[ks], ld8(qp + 32 * ks), s);
                const int t = 16 * tt + fr, sb = 16 * st + 4 * fq; const float f = (j == 0) ? F[2 * (w & 1)] : F[2 * (w & 1) + 1];
                float p0 = (sb + 0 <= t) ? s[0] * f : 0.f, p1 = (sb + 1 <= t) ? s[1] * f : 0.f, p2 = (sb + 2 <= t) ? s[2] * f : 0.f, p3 = (sb + 3 <= t) ? s[3] * f : 0.f;
                u32x2 o; o.x = pk2(p0, p1); o.y = pk2(p2, p3); *(LAS u32x2*)(Pt + t * 72 + sb) = o; } }
        bf16x8 qt[4][4];
#pragma unroll
        for (int tt = 0; tt < 4; ++tt) { const bf16_t* qp = QKP + (tok0 + 16 * tt + fr) * 1024 + h * 128 + 8 * fq;
#pragma unroll
            for (int ks = 0; ks < 4; ++ks) qt[tt][ks] = scale8(ld8(qp + 32 * ks), wi[tt]); }
        __syncthreads();
        f32x4 acc[3][4];
#pragma unroll
        for (int e = 0; e < 3; ++e) { const int dvr = 32 * w + 8 * (fr >> 2) + 4 * e + (fr & 3); const int crow = (e < 2) ? dvr : 256 + fr;
            const bf16_t* cp = CST + ((size_t)un * CROWS + crow) * 128 + 8 * fq;
            const bf16_t* vp = (e < 2) ? VT + (size_t)(bh * 256 + dvr) * SEQ + c * 64 + 8 * fq : GWH + (size_t)bh * SEQ + c * 64 + 8 * fq;
            bf16x8 ca[4], va[2];
#pragma unroll
            for (int ks = 0; ks < 4; ++ks) ca[ks] = ld8(cp + 32 * ks);
            va[0] = ld8(vp); va[1] = ld8(vp + 32);
#pragma unroll
            for (int tt = 0; tt < 4; ++tt) { f32x4 s = {0.f, 0.f, 0.f, 0.f};
#pragma unroll
                for (int ks = 0; ks < 4; ++ks) s = mfma16(ca[ks], qt[tt][ks], s);
#pragma unroll
                for (int k2 = 0; k2 < 2; ++k2) s = mfma16(va[k2], *(const LAS bf16x8*)(Pt + (16 * tt + fr) * 72 + 32 * k2 + 8 * fq), s);
                acc[e][tt] = s; } }
        float rs[4];
#pragma unroll
        for (int tt = 0; tt < 4; ++tt) { const float dn = __builtin_amdgcn_rcpf(fmaxf(fabsf(acc[2][tt][0]), en[tt])); float ss = 0.f;
#pragma unroll
            for (int e = 0; e < 2; ++e)
#pragma unroll
                for (int r = 0; r < 4; ++r) { const float hv = acc[e][tt][r] * dn; acc[e][tt][r] = hv; ss += hv * hv; }
            ss += __shfl_xor(ss, 16); ss += __shfl_xor(ss, 32);
            if (fq == 0) red[w * 64 + 16 * tt + fr] = ss; }
        __syncthreads();
#pragma unroll
        for (int tt = 0; tt < 4; ++tt) { float tot = 0.f;
#pragma unroll
            for (int ww = 0; ww < 8; ++ww) tot += red[ww * 64 + 16 * tt + fr];
            rs[tt] = rsqrtf(tot * (1.f / 256.f) + EPS); }
        const int colh = h * 256 + 32 * w + 8 * fq;
        const f32x4 g0 = *(const f32x4*)(gn + colh), g1 = *(const f32x4*)(gn + colh + 4);
#pragma unroll
        for (int tt = 0; tt < 4; ++tt) { bf16_t* op = OML + (tok0 + 16 * tt + fr) * 1024 + colh; const u32x4 ov = *(const u32x4*)op; const float r_ = rs[tt]; u32x4 y;
            y.x = pk2(sigm(bflo(ov.x)) * g0[0] * acc[0][tt][0] * r_, sigm(bfhi(ov.x)) * g0[1] * acc[0][tt][1] * r_);
            y.y = pk2(sigm(bflo(ov.y)) * g0[2] * acc[0][tt][2] * r_, sigm(bfhi(ov.y)) * g0[3] * acc[0][tt][3] * r_);
            y.z = pk2(sigm(bflo(ov.z)) * g1[0] * acc[1][tt][0] * r_, sigm(bfhi(ov.z)) * g1[1] * acc[1][tt][1] * r_);
            y.w = pk2(sigm(bflo(ov.w)) * g1[2] * acc[1][tt][2] * r_, sigm(bfhi(ov.w)) * g1[3] * acc[1][tt][3] * r_);
            *(u32x4*)op = y; }
    }
}

__device__ __forceinline__ void phase10(const Args& a, int wave) {
    const int lane = lane_id();
    const float* ssq = (const float*)(a.ws + O_SSQ3); const float* g = a.in[17];
    const int gw = blockIdx.x * 8 + wave, NGW = gridDim.x * 8;
    for (int row = gw; row < T; row += NGW) { const float rs = row_rstd(ssq, row);
        f32x4* xr = (f32x4*)(a.out + (size_t)row * D) + lane; const f32x4* gr = (const f32x4*)g + lane;
#pragma unroll
        for (int j = 0; j < 4; ++j) xr[64 * j] = xr[64 * j] * rs * gr[64 * j]; }
}

__device__ __forceinline__ void grid_bar(unsigned* bar, unsigned& nbar, int wave) {
    asm volatile("s_waitcnt vmcnt(0)" ::: "memory");
    __syncthreads();
    ++nbar;
    if (wave == 0 && lane_id() == 0) {
        __builtin_amdgcn_fence(__ATOMIC_RELEASE, "agent");
        asm volatile("s_waitcnt vmcnt(0)" ::: "memory");
        __hip_atomic_fetch_add(bar, 1u, __ATOMIC_RELAXED, __HIP_MEMORY_SCOPE_AGENT);
        const unsigned target = nbar * gridDim.x; unsigned sp = 0;
        while (__hip_atomic_load(bar, __ATOMIC_RELAXED, __HIP_MEMORY_SCOPE_AGENT) < target) { __builtin_amdgcn_s_sleep(2); if (++sp > (1u << 24)) break; }
        __builtin_amdgcn_fence(__ATOMIC_ACQUIRE, "agent");
        asm volatile("s_waitcnt vmcnt(0)" ::: "memory");
    }
    __syncthreads();
}

__global__ void __launch_bounds__(512, 2) mk_fwd(Args a) {
    extern __shared__ __attribute__((aligned(16))) unsigned char lds_raw[];
    LAS unsigned char* lds = (LAS unsigned char*)lds_raw;
    const int wave = __builtin_amdgcn_readfirstlane(threadIdx.x >> 6);
    unsigned char* ws = a.ws;
    const int lo = a.ph_lo, hi = a.ph_hi;
    if (lo == 0 && hi == NPHASE) cg::this_grid().sync();
    unsigned nbar = 0; unsigned* bar = (unsigned*)(ws + O_BAR);
#define IN(k) (lo <= (k) && (k) < hi)
#define SEAM(k) do { if (IN(k) && IN((k) + 1)) grid_bar(bar, nbar, wave); } while (0)
    if (IN(0)) phase0(a, lds, wave);
    SEAM(0);
    if (IN(1)) { EpiSeg E{ws}; run_gemm(lds, wave, (const bf16_t*)((unsigned char*)a.out + OO_H), (const bf16_t*)(ws + O_WIN), T, NP1, D, E); }
    SEAM(1);
    if (IN(2)) phase2(a, lds, wave);
    SEAM(2);
    if (IN(3)) phase3(a, wave);
    SEAM(3);
    if (IN(4)) phase4(a, lds, wave);
    SEAM(4);
    if (IN(5)) {
        { EpiGateA E{(const bf16_t*)(ws + O_GA), a.out}; run_gemm(lds, wave, (const bf16_t*)(ws + O_OML), (const bf16_t*)(ws + O_WA), T, D, D, E); }
        { EpiGateB E{(const bf16_t*)(ws + O_GB), a.out, (bf16_t*)(ws + O_MERGED)}; run_gemm(lds, wave, (const bf16_t*)(ws + O_QSW), (const bf16_t*)(ws + O_WB), T, D, D, E); }
    }
    SEAM(5);
    if (IN(6)) { EpiRes E{a.in[0], a.out, (bf16_t*)(ws + O_X1B), (float*)(ws + O_SSQ1)}; run_gemm(lds, wave, (const bf16_t*)(ws + O_MERGED), (const bf16_t*)(ws + O_WOUT), T, D, D, E); }
    SEAM(6);
    if (IN(7)) { EpiUp E{(const float*)(ws + O_SSQ1), (bf16_t*)(ws + O_ACT)}; run_gemm(lds, wave, (const bf16_t*)(ws + O_X1B), (const bf16_t*)(ws + O_WUP), T, FF, D, E); }
    SEAM(7);
    if (IN(8)) {
        { EpiRes E{a.out, a.out, (bf16_t*)(ws + O_X2B), (float*)(ws + O_SSQ2)}; run_gemm(lds, wave, (const bf16_t*)(ws + O_ACT), (const bf16_t*)(ws + O_WDN), T, D, FF, E); }
        { EpiPlain E{(bf16_t*)(ws + O_PP), D}; run_gemm(lds, wave, (const bf16_t*)(ws + O_PB), (const bf16_t*)(ws + O_WP), T, D, PLE, E); }
    }
    SEAM(8);
    if (IN(9)) { EpiPle E{(const float*)(ws + O_SSQ2), (const bf16_t*)(ws + O_PP), a.out, (float*)(ws + O_SSQ3)}; run_gemm(lds, wave, (const bf16_t*)(ws + O_X2B), (const bf16_t*)(ws + O_WG), T, D, D, E); }
    SEAM(9);
    if (IN(10)) phase10(a, wave);
#undef IN
#undef SEAM
}

extern "C" void kernel_launch(void* const* d_in, const int* in_sizes, int n_in, void* d_out, int out_size, void* d_ws, size_t ws_size, hipStream_t stream) {
    static int grid = 0;
    if (grid == 0) {
        if (n_in != 18 || out_size != T * D || ws_size < WS_NEED) { fprintf(stderr, "kernel_launch: unexpected shapes (n_in %d out %d ws %zu)\n", n_in, out_size, ws_size); grid = -1; return; }
        int dev = 0, cus = 0, per_cu = 0;
        if (hipGetDevice(&dev) != hipSuccess || hipDeviceGetAttribute(&cus, hipDeviceAttributeMultiprocessorCount, dev) != hipSuccess) { grid = -1; return; }
        if (hipFuncSetAttribute((const void*)mk_fwd, hipFuncAttributeMaxDynamicSharedMemorySize, LDS_BYTES) != hipSuccess) { fprintf(stderr, "kernel_launch: hipFuncSetAttribute failed\n"); grid = -1; return; }
        if (hipOccupancyMaxActiveBlocksPerMultiprocessor(&per_cu, (const void*)mk_fwd, 512, LDS_BYTES) != hipSuccess || per_cu < 1) per_cu = 1;
        (void)hipGetLastError();
        grid = cus;
    }
    if (grid < 0) return;
    if (hipMemsetAsync((char*)d_ws + O_BAR, 0, 256, stream) != hipSuccess) { fprintf(stderr, "kernel_launch: memset failed\n"); return; }
    Args a{};
    for (int i = 0; i < 18; ++i) a.in[i] = (const float*)d_in[i];
    a.out = (float*)d_out; a.ws = (unsigned char*)d_ws;
#if MK_N_LAUNCHES == 1
    a.ph_lo = 0; a.ph_hi = NPHASE;
    void* args[] = {&a};
    hipError_t e = hipLaunchCooperativeKernel((const void*)mk_fwd, dim3(grid), dim3(512), args, LDS_BYTES, stream);
    if (e != hipSuccess) fprintf(stderr, "cooperative launch failed: %s (grid %d)\n", hipGetErrorString(e), grid);
#else
    for (int p = 0; p < NPHASE; ++p) { a.ph_lo = p; a.ph_hi = p + 1; hipLaunchKernelGGL(mk_fwd, dim3(grid), dim3(512), LDS_BYTES, stream, a); }
#endif
}
```

```cpp
#include <hip/hip_runtime.h>
#include <hip/hip_cooperative_groups.h>
#include <cstdio>
#include <cstdint>
namespace cg = cooperative_groups;
namespace pg8 {
#define PG8_LAS __attribute__((address_space(3)))
typedef unsigned short bf16_t;
typedef short bf16x8 __attribute__((ext_vector_type(8)));
typedef float f32x4 __attribute__((ext_vector_type(4)));
typedef unsigned u32x4 __attribute__((ext_vector_type(4)));
constexpr int BM = 256, BK = 64, HALF = 128, HTB = HALF * BK * 2  , STAGE_BYTES = 8 * HTB, NXCD = 8, WGM = 8;

__host__ __device__ __forceinline__ int lds_byte(int r, int c) { const int st = (r >> 4) * 2 + (c >> 5), rr = r & 15, cc = c & 31, ob = rr * 64 + cc * 2; return st * 1024 + (ob ^ (((ob >> 9) & 1) << 5)); }
__host__ __device__ __forceinline__ void stage_rc(int b, int& R, int& C) { const int st = b / 1024, sb = b % 1024, swz = sb ^ (((sb >> 9) & 1) << 5); R = (st >> 1) * 16 + swz / 64; C = (st & 1) * 32 + (swz % 64) / 2; }
__host__ __device__ __forceinline__ int perm32(int rho) { const int n = rho >> 4, i = rho & 15; return 8 * (i >> 2) + 4 * n + (i & 3); }

struct Unit { int pm, pn; };
struct Gemm { const bf16_t* A; const bf16_t* Bt; int M, N, K; };

struct StaticOrder {
    int nM, nN, nwg, G, c;
    __host__ __device__ void init(int M, int N, int G_, int c_) { nM = M / BM; nN = N / BM; nwg = nM * nN; G = G_; c = c_; }
    __host__ __device__ bool next(int i, Unit& u) const {
        const long L = (long)i * G + c; if (L >= nwg) return false;
        int wgid = (int)L; { const int q = nwg / NXCD, r = nwg % NXCD, xcd = wgid % NXCD, off = wgid / NXCD; wgid = (xcd < r ? xcd * (q + 1) : r * (q + 1) + (xcd - r) * q) + off; }
        const int nig = WGM * nN, gid = wgid / nig, fm = gid * WGM, gsz = (nM - fm) < WGM ? (nM - fm) : WGM;
        u.pm = fm + ((wgid % nig) % gsz); u.pn = (wgid % nig) / gsz; return true;
    }
    __device__ __forceinline__ void a_ready(const Unit&) const {}
    __device__ __forceinline__ void done(const Unit&) const {}
};
__device__ __forceinline__ unsigned cvt_pk_bf16(float lo, float hi) { unsigned r; asm volatile("v_cvt_pk_bf16_f32 %0, %1, %2" : "=v"(r) : "v"(lo), "v"(hi)); return r; }
template <class Epi, class Sched, bool ALIGN_EPI = false, bool SP2 = false>
__device__ __forceinline__ void gemm_phase(PG8_LAS unsigned char* lds, const Gemm g, const Sched& S, const Epi& E, const int wid) {
    int lane; asm volatile("v_mbcnt_lo_u32_b32 %0, -1, 0\n\tv_mbcnt_hi_u32_b32 %0, -1, %0" : "=v"(lane));
    const int tid = wid * 64 + lane, wr = wid >> 2, wc = wid & 3, fr = lane & 15, fq = lane >> 4;
    const int K = g.K, nt = K / BK;
    unsigned voffA[2], voffB[2];
#pragma unroll
    for (int i = 0; i < 2; ++i) { int R, C; stage_rc(tid * 16 + i * 8192, R, C); const int Rb = Epi::PERM ? ((R & ~31) + perm32(R & 31)) : R;
        voffA[i] = (unsigned)(R * K + C) * 2u; voffB[i] = (unsigned)(Rb * K + C) * 2u; }
    const size_t kstep = (size_t)(BK * 2);
    const size_t hstep = (size_t)HALF * K * 2;
    const size_t tstep = 2 * hstep;
    const unsigned ldsw = (unsigned)wid * 1024u;
    const int aoff = lds_byte(wr * 64 + fr, fq * 8), boff = lds_byte(wc * 32 + fr, fq * 8);
#define PG8_SA(b, h) (((b) * 2 + (h)) * HTB)
#define PG8_SB(b, h) ((4 + (b) * 2 + (h)) * HTB)
#define PG8_STAGE(bufoff, gbase, voff) do { _Pragma("unroll") for (int _i = 0; _i < 2; ++_i) \
        __builtin_amdgcn_global_load_lds((const unsigned*)((const char*)(gbase) + (voff)[_i]), (PG8_LAS unsigned*)(lds + (bufoff) + ldsw + _i * 8192), 16, 0, 0); } while (0)
#define PG8_LDA(dst, b, h) do { _Pragma("unroll") for (int m = 0; m < 4; ++m) _Pragma("unroll") for (int k = 0; k < 2; ++k) dst[m][k] = *(const PG8_LAS bf16x8*)(lds + PG8_SA(b, h) + aoff + m * 2048 + k * 1024); } while (0)
#define PG8_LDB(dst, b, h) do { _Pragma("unroll") for (int n = 0; n < 2; ++n) _Pragma("unroll") for (int k = 0; k < 2; ++k) dst[n][k] = *(const PG8_LAS bf16x8*)(lds + PG8_SB(b, h) + boff + n * 2048 + k * 1024); } while (0)
#define PG8_MMA(ai, bj, At, Bt) do { __builtin_amdgcn_s_setprio(1); _Pragma("unroll") for (int m = 0; m < 4; ++m) _Pragma("unroll") for (int n = 0; n < 2; ++n) _Pragma("unroll") for (int k = 0; k < 2; ++k) \
        acc[ai][bj][m][n] = __builtin_amdgcn_mfma_f32_16x16x32_bf16(Bt[n][k], At[m][k], acc[ai][bj][m][n], 0, 0, 0); __builtin_amdgcn_s_setprio(0); } while (0)
#define PG8_WAIT_V(n) asm volatile("s_waitcnt vmcnt(" #n ")" ::: "memory")
#define PG8_WAIT_L(n) asm volatile("s_waitcnt lgkmcnt(" #n ")" ::: "memory")
#define PG8_BAR __builtin_amdgcn_s_barrier()
#define PG8_SCHED __builtin_amdgcn_sched_barrier(0)
    Unit cur, nxt; int ui = 0;
    if (!S.next(0, cur)) return;
    f32x4 acc[2][2][4][2];
#pragma unroll
    for (int a = 0; a < 2; ++a)
#pragma unroll
        for (int b = 0; b < 2; ++b)
#pragma unroll
            for (int m = 0; m < 4; ++m)
#pragma unroll
                for (int n = 0; n < 2; ++n) acc[a][b][m][n] = (f32x4){0.f, 0.f, 0.f, 0.f};
    bf16x8 At[4][2], B0[2][2], B1[2][2];
    const char* cA = (const char*)g.A + (size_t)cur.pm * tstep; const char* cB = (const char*)g.Bt + (size_t)cur.pn * tstep;
    S.a_ready(cur);
    if constexpr (SP2) {
        PG8_STAGE(PG8_SB(0, 0), cB, voffB); PG8_STAGE(PG8_SB(0, 1), cB + hstep, voffB); PG8_STAGE(PG8_SA(0, 0), cA, voffA); PG8_STAGE(PG8_SA(0, 1), cA + hstep, voffA);
        if (wr == 1) PG8_BAR;
        PG8_WAIT_V(2); PG8_BAR;
        PG8_STAGE(PG8_SB(1, 0), cB + kstep, voffB); PG8_STAGE(PG8_SA(1, 0), cA + kstep, voffA); PG8_STAGE(PG8_SB(1, 1), cB + hstep + kstep, voffB);
        PG8_WAIT_V(6); PG8_BAR;
    } else {
        PG8_STAGE(PG8_SB(0, 0), cB, voffB); PG8_STAGE(PG8_SA(0, 0), cA, voffA); PG8_STAGE(PG8_SB(0, 1), cB + hstep, voffB); PG8_STAGE(PG8_SA(0, 1), cA + hstep, voffA);
        if (wr == 1) PG8_BAR;
        PG8_WAIT_V(4); PG8_BAR;
        PG8_STAGE(PG8_SB(1, 0), cB + kstep, voffB); PG8_STAGE(PG8_SA(1, 0), cA + kstep, voffA); PG8_STAGE(PG8_SB(1, 1), cB + hstep + kstep, voffB);
        PG8_WAIT_V(6); PG8_BAR;
    }
    for (;;) {
        const bool has_next = S.next(ui + 1, nxt);
        const char* nA = has_next ? (const char*)g.A + (size_t)nxt.pm * tstep : cA; const char* nB = has_next ? (const char*)g.Bt + (size_t)nxt.pn * tstep : cB;
        for (int t = 0; t < nt; t += 2) {
            const bool last = (t == nt - 2);
            const char* a1 = cA + (size_t)(t + 1) * kstep;
            const char* a2 = last ? nA : cA + (size_t)(t + 2) * kstep; const char* b2 = last ? nB : cB + (size_t)(t + 2) * kstep;
            const char* a3 = a2 + kstep; const char* b3 = b2 + kstep;
            if (last && has_next) S.a_ready(nxt);
            if constexpr (SP2) {
            PG8_LDB(B0, 0, 0); PG8_LDB(B1, 0, 1); PG8_SCHED; PG8_LDA(At, 0, 0); PG8_STAGE(PG8_SA(1, 1), a1 + hstep, voffA);
            PG8_WAIT_V(8); PG8_WAIT_L(0); PG8_BAR; PG8_MMA(0, 0, At, B0); PG8_MMA(0, 1, At, B1); PG8_BAR; PG8_SCHED;
            PG8_LDA(At, 0, 1); PG8_STAGE(PG8_SB(0, 0), b2, voffB); PG8_STAGE(PG8_SB(0, 1), b2 + hstep, voffB); PG8_STAGE(PG8_SA(0, 0), a2, voffA);
            PG8_WAIT_V(8); PG8_WAIT_L(0); PG8_BAR; PG8_MMA(1, 0, At, B0); PG8_MMA(1, 1, At, B1); PG8_BAR; PG8_SCHED;
            PG8_LDB(B0, 1, 0); PG8_LDB(B1, 1, 1); PG8_SCHED; PG8_LDA(At, 1, 0); PG8_STAGE(PG8_SA(0, 1), a2 + hstep, voffA);
            PG8_WAIT_V(8); PG8_WAIT_L(0); PG8_BAR; PG8_MMA(0, 0, At, B0); PG8_MMA(0, 1, At, B1); PG8_BAR; PG8_SCHED;
            PG8_LDA(At, 1, 1); PG8_STAGE(PG8_SB(1, 0), b3, voffB); PG8_STAGE(PG8_SB(1, 1), b3 + hstep, voffB); PG8_STAGE(PG8_SA(1, 0), a3, voffA);
            PG8_WAIT_V(8); PG8_WAIT_L(0); PG8_BAR; PG8_MMA(1, 0, At, B0); PG8_MMA(1, 1, At, B1); PG8_BAR; PG8_SCHED;
            } else {
            PG8_LDB(B0, 0, 0); PG8_SCHED; PG8_LDA(At, 0, 0); PG8_STAGE(PG8_SA(1, 1), a1 + hstep, voffA);
            PG8_WAIT_L(8); PG8_BAR; PG8_WAIT_L(0); PG8_MMA(0, 0, At, B0); PG8_BAR; PG8_SCHED;
            PG8_LDB(B1, 0, 1); PG8_STAGE(PG8_SB(0, 0), b2, voffB);
            PG8_BAR; PG8_WAIT_L(0); PG8_MMA(0, 1, At, B1); PG8_BAR;
            PG8_LDA(At, 0, 1); PG8_STAGE(PG8_SA(0, 0), a2, voffA);
            PG8_BAR; PG8_WAIT_L(0); PG8_MMA(1, 0, At, B0); PG8_BAR; PG8_SCHED;
            PG8_STAGE(PG8_SB(0, 1), b2 + hstep, voffB);
            PG8_WAIT_V(6); PG8_BAR; PG8_MMA(1, 1, At, B1); PG8_BAR;
            PG8_LDB(B0, 1, 0); PG8_SCHED; PG8_LDA(At, 1, 0); PG8_STAGE(PG8_SA(0, 1), a2 + hstep, voffA);
            PG8_WAIT_L(8); PG8_BAR; PG8_WAIT_L(0); PG8_MMA(0, 0, At, B0); PG8_BAR; PG8_SCHED;
            PG8_LDB(B1, 1, 1); PG8_STAGE(PG8_SB(1, 0), b3, voffB);
            PG8_BAR; PG8_WAIT_L(0); PG8_MMA(0, 1, At, B1); PG8_BAR;
            PG8_LDA(At, 1, 1); PG8_STAGE(PG8_SA(1, 0), a3, voffA);
            PG8_BAR; PG8_WAIT_L(0); PG8_MMA(1, 0, At, B0); PG8_BAR; PG8_SCHED;
            PG8_STAGE(PG8_SB(1, 1), b3 + hstep, voffB);
            PG8_WAIT_V(6); PG8_BAR; PG8_MMA(1, 1, At, B1); PG8_BAR;
            }
        }
        if constexpr (ALIGN_EPI) { if (wr == 0) PG8_BAR; }
        if constexpr (!Epi::AFTER_DRAIN) { E(acc, cur, wr, wc, fr, fq); S.done(cur); }
        if (!has_next) break;
#pragma unroll
        for (int a = 0; a < 2; ++a)
#pragma unroll
            for (int b = 0; b < 2; ++b)
#pragma unroll
                for (int m = 0; m < 4; ++m)
#pragma unroll
                    for (int n = 0; n < 2; ++n) acc[a][b][m][n] = (f32x4){0.f, 0.f, 0.f, 0.f};
        cur = nxt; cA = nA; cB = nB; ++ui;
        if constexpr (ALIGN_EPI) { if (wr == 1) PG8_BAR; }
    }
    PG8_WAIT_V(0);
    if constexpr (!ALIGN_EPI) { if (wr == 0) PG8_BAR; }
    PG8_BAR;
    if constexpr (Epi::AFTER_DRAIN) { E.fused(acc, cur, wr, wc, fr, fq, lds, wid, lane); S.done(cur); }
#undef PG8_SA
#undef PG8_SB
#undef PG8_STAGE
#undef PG8_LDA
#undef PG8_LDB
#undef PG8_MMA
#undef PG8_WAIT_V
#undef PG8_WAIT_L
#undef PG8_BAR
#undef PG8_SCHED
}
}

#ifndef MK_N_LAUNCHES
#define MK_N_LAUNCHES 1
#endif
constexpr int NB = 4, SEQ = 8192, T = NB * SEQ, D = 1024, NIN = 6664, NP1 = 6656, FF = 4096, PLE = 256;
constexpr int NCH = SEQ / 64;
constexpr int CROWS = 272;
constexpr float EPS = 1e-6f;
constexpr int NPHASE = 11;
typedef pg8::bf16_t bf16_t;
typedef pg8::bf16x8 bf16x8;
typedef pg8::f32x4 f32x4;
typedef pg8::u32x4 u32x4;
typedef unsigned u32x2 __attribute__((ext_vector_type(2)));
#define LAS __attribute__((address_space(3)))

constexpr size_t MiB = 1u << 20;
constexpr size_t O_WIN = 0, O_WA = 13 * MiB, O_WB = 15 * MiB, O_WOUT = 17 * MiB, O_WG = 19 * MiB, O_WUP = 21 * MiB, O_WDN = 29 * MiB, O_WP = 37 * MiB;
constexpr size_t O_GWH = 37 * MiB + 512 * 1024, O_CBL = O_GWH + 256 * 1024, O_CMW = O_CBL + 8192, O_CAMAX = O_CMW + 8192, O_CM = O_CAMAX + 8192, O_CTR = O_CM + 8192, O_BAR = O_CTR + 256;
constexpr size_t O_QK = 40 * MiB, O_VML = 104 * MiB, O_VSW = 168 * MiB, O_KSW = 184 * MiB, O_OML = 200 * MiB, O_QSW = 264 * MiB, O_GA = 328 * MiB, O_GB = 392 * MiB;
constexpr size_t O_KT = 456 * MiB, O_VTSW = 488 * MiB, O_SSQ1 = 504 * MiB, O_SSQ2 = 506 * MiB, O_SSQ3 = 508 * MiB;
constexpr size_t O_GIG = 510 * MiB, O_GLF = O_GIG + 512 * 1024, O_GBC = 511 * MiB, O_GL = O_GBC + 512 * 1024;
constexpr size_t O_CST = 40 * MiB;
constexpr size_t O_MERGED = 40 * MiB, O_X1B = 104 * MiB, O_ACT = 200 * MiB, O_X2B = 40 * MiB, O_PB = 456 * MiB, O_PP = 104 * MiB;
constexpr size_t WS_NEED = 512 * MiB;
constexpr size_t OO_H = 0, OO_QKP = 0, OO_VT = 64 * MiB;
constexpr int LDS_BYTES = 147456;

__device__ __forceinline__ int lane_id() { int l; asm volatile("v_mbcnt_lo_u32_b32 %0, -1, 0\n\tv_mbcnt_hi_u32_b32 %0, -1, %0" : "=v"(l)); return l; }
__device__ __forceinline__ unsigned pk2(float lo, float hi) { return pg8::cvt_pk_bf16(lo, hi); }
__device__ __forceinline__ float bflo(unsigned w) { return __builtin_bit_cast(float, w << 16); }
__device__ __forceinline__ float bfhi(unsigned w) { return __builtin_bit_cast(float, w & 0xffff0000u); }
__device__ __forceinline__ float sigm(float x) { return __builtin_amdgcn_rcpf(1.f + __expf(-x)); }
__device__ __forceinline__ float wave_sum(float v) {
#pragma unroll
    for (int o = 1; o < 64; o <<= 1) v += __shfl_xor(v, o);
    return v;
}
__device__ __forceinline__ float wave_max(float v) {
#pragma unroll
    for (int o = 1; o < 64; o <<= 1) v = fmaxf(v, __shfl_xor(v, o));
    return v;
}
__device__ __forceinline__ bf16x8 ld8(const bf16_t* p) { return *(const bf16x8*)p; }
__device__ __forceinline__ f32x4 mfma16(bf16x8 a, bf16x8 b, f32x4 c) { return __builtin_amdgcn_mfma_f32_16x16x32_bf16(a, b, c, 0, 0, 0); }
__device__ __forceinline__ bf16x8 scale8(bf16x8 v, float s) {
    u32x4 u = __builtin_bit_cast(u32x4, v), o;
    o.x = pk2(bflo(u.x) * s, bfhi(u.x) * s); o.y = pk2(bflo(u.y) * s, bfhi(u.y) * s); o.z = pk2(bflo(u.z) * s, bfhi(u.z) * s); o.w = pk2(bflo(u.w) * s, bfhi(u.w) * s);
    return __builtin_bit_cast(bf16x8, o);
}
__device__ __forceinline__ float rdlane(float v, int l) { return __builtin_bit_cast(float, __builtin_amdgcn_readlane(__builtin_bit_cast(int, v), l)); }

#define EPI_LOOP_BEGIN const int row0 = u.pm * 256 + wr * 64 + fr, col0 = u.pn * 256 + wc * 32 + 8 * fq; \
    _Pragma("unroll") for (int ai = 0; ai < 2; ++ai) _Pragma("unroll") for (int m = 0; m < 4; ++m) { const int row = row0 + ai * 128 + m * 16;
#define EPI_LOOP_END }
typedef pg8::Unit Unit;

struct EpiSeg {
    static constexpr bool PERM = true, AFTER_DRAIN = false;
    unsigned char* ws;
    __device__ __forceinline__ void operator()(const f32x4 (&acc)[2][2][4][2], const Unit& u, int wr, int wc, int fr, int fq) const {
        const int pn = u.pn; size_t off; int ldc, ct;
        if (pn < 4) { off = O_QK; ldc = 1024; ct = pn; } else if (pn < 8) { off = O_VML; ldc = 1024; ct = pn - 4; } else if (pn < 12) { off = O_OML; ldc = 1024; ct = pn - 8; }
        else if (pn < 16) { off = O_QSW; ldc = 1024; ct = pn - 12; } else if (pn < 17) { off = O_KSW; ldc = 256; ct = 0; } else if (pn < 18) { off = O_VSW; ldc = 256; ct = 0; }
        else if (pn < 22) { off = O_GA; ldc = 1024; ct = pn - 18; } else { off = O_GB; ldc = 1024; ct = pn - 22; }
        bf16_t* base = (bf16_t*)(ws + off) + ct * 256 + wc * 32 + 8 * fq;
        const int row0 = u.pm * 256 + wr * 64 + fr;
#pragma unroll
        for (int ai = 0; ai < 2; ++ai)
#pragma unroll
            for (int m = 0; m < 4; ++m) { bf16_t* rowp = base + (size_t)(row0 + ai * 128 + m * 16) * ldc;
#pragma unroll
                for (int bj = 0; bj < 2; ++bj) { const f32x4 v0 = acc[ai][bj][m][0], v1 = acc[ai][bj][m][1]; u32x4 w;
                    w.x = pk2(v0[0], v0[1]); w.y = pk2(v0[2], v0[3]); w.z = pk2(v1[0], v1[1]); w.w = pk2(v1[2], v1[3]); *(u32x4*)(rowp + bj * 128) = w; } }
    }
};
struct EpiPlain {
    static constexpr bool PERM = true, AFTER_DRAIN = false;
    bf16_t* O; int ldc;
    __device__ __forceinline__ void operator()(const f32x4 (&acc)[2][2][4][2], const Unit& u, int wr, int wc, int fr, int fq) const {
        EPI_LOOP_BEGIN
#pragma unroll
            for (int bj = 0; bj < 2; ++bj) { const f32x4 v0 = acc[ai][bj][m][0], v1 = acc[ai][bj][m][1]; u32x4 w;
                w.x = pk2(v0[0], v0[1]); w.y = pk2(v0[2], v0[3]); w.z = pk2(v1[0], v1[1]); w.w = pk2(v1[2], v1[3]); *(u32x4*)(O + (size_t)row * ldc + col0 + bj * 128) = w; }
        EPI_LOOP_END
    }
};
struct EpiGateA {
    static constexpr bool PERM = true, AFTER_DRAIN = false;
    const bf16_t* G; float* M1;
    __device__ __forceinline__ void operator()(const f32x4 (&acc)[2][2][4][2], const Unit& u, int wr, int wc, int fr, int fq) const {
        EPI_LOOP_BEGIN
#pragma unroll
            for (int bj = 0; bj < 2; ++bj) { const size_t idx = (size_t)row * D + col0 + bj * 128; const u32x4 g = *(const u32x4*)(G + idx);
                const f32x4 v0 = acc[ai][bj][m][0], v1 = acc[ai][bj][m][1]; f32x4 o0, o1;
                o0[0] = sigm(bflo(g.x)) * v0[0]; o0[1] = sigm(bfhi(g.x)) * v0[1]; o0[2] = sigm(bflo(g.y)) * v0[2]; o0[3] = sigm(bfhi(g.y)) * v0[3];
                o1[0] = sigm(bflo(g.z)) * v1[0]; o1[1] = sigm(bfhi(g.z)) * v1[1]; o1[2] = sigm(bflo(g.w)) * v1[2]; o1[3] = sigm(bfhi(g.w)) * v1[3];
                *(f32x4*)(M1 + idx) = o0; *(f32x4*)(M1 + idx + 4) = o1; }
        EPI_LOOP_END
    }
};
struct EpiGateB {
    static constexpr bool PERM = true, AFTER_DRAIN = false;
    const bf16_t* G; const float* M1; bf16_t* O;
    __device__ __forceinline__ void operator()(const f32x4 (&acc)[2][2][4][2], const Unit& u, int wr, int wc, int fr, int fq) const {
        EPI_LOOP_BEGIN
#pragma unroll
            for (int bj = 0; bj < 2; ++bj) { const size_t idx = (size_t)row * D + col0 + bj * 128; const u32x4 g = *(const u32x4*)(G + idx);
                const f32x4 a0 = *(const f32x4*)(M1 + idx), a1 = *(const f32x4*)(M1 + idx + 4);
                const f32x4 v0 = acc[ai][bj][m][0], v1 = acc[ai][bj][m][1]; u32x4 w;
                w.x = pk2(a0[0] + sigm(bflo(g.x)) * v0[0], a0[1] + sigm(bfhi(g.x)) * v0[1]); w.y = pk2(a0[2] + sigm(bflo(g.y)) * v0[2], a0[3] + sigm(bfhi(g.y)) * v0[3]);
                w.z = pk2(a1[0] + sigm(bflo(g.z)) * v1[0], a1[1] + sigm(bfhi(g.z)) * v1[1]); w.w = pk2(a1[2] + sigm(bflo(g.w)) * v1[2], a1[3] + sigm(bfhi(g.w)) * v1[3]);
                *(u32x4*)(O + idx) = w; }
        EPI_LOOP_END
    }
};
struct EpiRes {
    static constexpr bool PERM = true, AFTER_DRAIN = false;
    const float* XI; float* XO; bf16_t* XB; float* SSQ;
    __device__ __forceinline__ void operator()(const f32x4 (&acc)[2][2][4][2], const Unit& u, int wr, int wc, int fr, int fq) const {
        EPI_LOOP_BEGIN
            float ss = 0.f;
#pragma unroll
            for (int bj = 0; bj < 2; ++bj) { const size_t idx = (size_t)row * D + col0 + bj * 128;
                const f32x4 o0 = *(const f32x4*)(XI + idx) + acc[ai][bj][m][0], o1 = *(const f32x4*)(XI + idx + 4) + acc[ai][bj][m][1];
                *(f32x4*)(XO + idx) = o0; *(f32x4*)(XO + idx + 4) = o1;
                u32x4 w; w.x = pk2(o0[0], o0[1]); w.y = pk2(o0[2], o0[3]); w.z = pk2(o1[0], o1[1]); w.w = pk2(o1[2], o1[3]); *(u32x4*)(XB + idx) = w;
                ss += (o0[0] * o0[0] + o0[1] * o0[1]) + (o0[2] * o0[2] + o0[3] * o0[3]) + (o1[0] * o1[0] + o1[1] * o1[1]) + (o1[2] * o1[2] + o1[3] * o1[3]); }
            ss += __shfl_xor(ss, 16); ss += __shfl_xor(ss, 32);
            if (fq == 0) SSQ[(size_t)row * 16 + u.pn * 4 + wc] = ss;
        EPI_LOOP_END
    }
};
__device__ __forceinline__ float row_rstd(const float* SSQ, int row) {
    const f32x4* p = (const f32x4*)(SSQ + (size_t)row * 16); const f32x4 a = p[0], b = p[1], c = p[2], d = p[3];
    const float s = ((a[0] + a[1]) + (a[2] + a[3])) + ((b[0] + b[1]) + (b[2] + b[3])) + ((c[0] + c[1]) + (c[2] + c[3])) + ((d[0] + d[1]) + (d[2] + d[3]));
    return rsqrtf(s * (1.f / D) + EPS);
}
struct EpiUp {
    static constexpr bool PERM = true, AFTER_DRAIN = false;
    const float* SSQ; bf16_t* O;
    __device__ __forceinline__ void operator()(const f32x4 (&acc)[2][2][4][2], const Unit& u, int wr, int wc, int fr, int fq) const {
        EPI_LOOP_BEGIN
            const float rs = row_rstd(SSQ, row);
#pragma unroll
            for (int bj = 0; bj < 2; ++bj) { f32x4 v0 = acc[ai][bj][m][0] * rs, v1 = acc[ai][bj][m][1] * rs;
#pragma unroll
                for (int e = 0; e < 4; ++e) { const float a = fmaxf(v0[e], 0.f), b = fmaxf(v1[e], 0.f); v0[e] = a * a; v1[e] = b * b; }
                u32x4 w; w.x = pk2(v0[0], v0[1]); w.y = pk2(v0[2], v0[3]); w.z = pk2(v1[0], v1[1]); w.w = pk2(v1[2], v1[3]); *(u32x4*)(O + (size_t)row * FF + col0 + bj * 128) = w; }
        EPI_LOOP_END
    }
};
struct EpiPle {
    static constexpr bool PERM = true, AFTER_DRAIN = false;
    const float* SSQI; const bf16_t* PP; float* X; float* SSQO;
    __device__ __forceinline__ void operator()(const f32x4 (&acc)[2][2][4][2], const Unit& u, int wr, int wc, int fr, int fq) const {
        EPI_LOOP_BEGIN
            const float rs = row_rstd(SSQI, row); float ss = 0.f;
#pragma unroll
            for (int bj = 0; bj < 2; ++bj) { const size_t idx = (size_t)row * D + col0 + bj * 128; const u32x4 p = *(const u32x4*)(PP + idx);
                const f32x4 v0 = acc[ai][bj][m][0] * rs, v1 = acc[ai][bj][m][1] * rs; f32x4 o0 = *(const f32x4*)(X + idx), o1 = *(const f32x4*)(X + idx + 4);
                o0[0] += sigm(v0[0]) * bflo(p.x); o0[1] += sigm(v0[1]) * bfhi(p.x); o0[2] += sigm(v0[2]) * bflo(p.y); o0[3] += sigm(v0[3]) * bfhi(p.y);
                o1[0] += sigm(v1[0]) * bflo(p.z); o1[1] += sigm(v1[1]) * bfhi(p.z); o1[2] += sigm(v1[2]) * bflo(p.w); o1[3] += sigm(v1[3]) * bfhi(p.w);
                *(f32x4*)(X + idx) = o0; *(f32x4*)(X + idx + 4) = o1;
                ss += (o0[0] * o0[0] + o0[1] * o0[1]) + (o0[2] * o0[2] + o0[3] * o0[3]) + (o1[0] * o1[0] + o1[1] * o1[1]) + (o1[2] * o1[2] + o1[3] * o1[3]); }
            ss += __shfl_xor(ss, 16); ss += __shfl_xor(ss, 32);
            if (fq == 0) SSQO[(size_t)row * 16 + u.pn * 4 + wc] = ss;
        EPI_LOOP_END
    }
};

template <class Epi> __device__ __forceinline__ void run_gemm(LAS unsigned char* lds, int wave, const bf16_t* A, const bf16_t* Bt, int M, int N, int K, const Epi& E) {
    pg8::Gemm g{A, Bt, M, N, K}; pg8::StaticOrder S; S.init(M, N, (int)gridDim.x, (int)blockIdx.x);
    pg8::gemm_phase<Epi, pg8::StaticOrder, true, true>(lds, g, S, E, wave);
}

__device__ __forceinline__ void p0_transpose_item(const float* W, int ldw, int K, int nblk, bf16_t* WT, const float* ksc, LAS float* scr, int item, int lane) {
    const int kb = item / nblk, nb = item % nblk, k0 = 64 * kb, n0 = 32 * nb;
#pragma unroll 8
    for (int i = 0; i < 32; ++i) { const int kk = 2 * i + (lane >> 5); float v = W[(size_t)(k0 + kk) * ldw + n0 + (lane & 31)]; if (ksc) v *= ksc[k0 + kk]; scr[kk * 33 + (lane & 31)] = v; }
    asm volatile("s_waitcnt lgkmcnt(0)" ::: "memory");
    const int c = lane & 7;
#pragma unroll
    for (int j = 0; j < 4; ++j) { const int n = (lane >> 3) + 8 * j; const LAS float* s = scr + (8 * c) * 33 + n;
        u32x4 o; o.x = pk2(s[0 * 33], s[1 * 33]); o.y = pk2(s[2 * 33], s[3 * 33]); o.z = pk2(s[4 * 33], s[5 * 33]); o.w = pk2(s[6 * 33], s[7 * 33]);
        *(u32x4*)(WT + (size_t)(n0 + n) * K + k0 + 8 * c) = o; }
    asm volatile("s_waitcnt lgkmcnt(0)" ::: "memory");
}
__device__ __forceinline__ float logsigmoid(float z) { return fminf(z, 0.f) - log1pf(__expf(-fabsf(z))); }

struct Args { const float* in[18]; float* out; unsigned char* ws; int ph_lo, ph_hi; };

__device__ __forceinline__ void phase0(const Args& a, LAS unsigned char* lds, int wave) {
    const int lane = lane_id();
    unsigned char* ws = a.ws;
    LAS float* scr = (LAS float*)(lds + wave * 16384);
    const int gw = blockIdx.x * 8 + wave, NGW = gridDim.x * 8;
    if (blockIdx.x == 0 && wave == 0 && lane == 0) *(unsigned*)(ws + O_CTR) = 0u;
    constexpr int I_IN1 = 16 * 96, I_IN2 = 16 * 112, I_SQ = 16 * 32, I_UP = 16 * 128, I_DN = 64 * 32, I_P = 4 * 32;
    constexpr int NITEMS = I_IN1 + I_IN2 + 4 * I_SQ + I_UP + I_DN + I_P;
    const float* w_in = a.in[3];
    for (int it = gw; it < NITEMS; it += NGW) {
        int r = it;
        if (r < I_IN1) { p0_transpose_item(w_in, NIN, D, 96, (bf16_t*)(ws + O_WIN), nullptr, scr, r, lane); continue; } r -= I_IN1;
        if (r < I_IN2) { p0_transpose_item(w_in + 3080, NIN, D, 112, (bf16_t*)(ws + O_WIN) + (size_t)3072 * D, nullptr, scr, r, lane); continue; } r -= I_IN2;
        if (r < I_SQ) { p0_transpose_item(a.in[8], D, D, 32, (bf16_t*)(ws + O_WA), nullptr, scr, r, lane); continue; } r -= I_SQ;
        if (r < I_SQ) { p0_transpose_item(a.in[9], D, D, 32, (bf16_t*)(ws + O_WB), nullptr, scr, r, lane); continue; } r -= I_SQ;
        if (r < I_SQ) { p0_transpose_item(a.in[10], D, D, 32, (bf16_t*)(ws + O_WOUT), nullptr, scr, r, lane); continue; } r -= I_SQ;
        if (r < I_SQ) { p0_transpose_item(a.in[15], D, D, 32, (bf16_t*)(ws + O_WG), a.in[14], scr, r, lane); continue; } r -= I_SQ;
        if (r < I_UP) { p0_transpose_item(a.in[12], FF, D, 128, (bf16_t*)(ws + O_WUP), a.in[11], scr, r, lane); continue; } r -= I_UP;
        if (r < I_DN) { p0_transpose_item(a.in[13], D, FF, 32, (bf16_t*)(ws + O_WDN), nullptr, scr, r, lane); continue; } r -= I_DN;
        p0_transpose_item(a.in[16], D, PLE, 32, (bf16_t*)(ws + O_WP), nullptr, scr, r, lane);
    }
    const float* x = a.in[0]; const float* g = a.in[2]; const float* bif = a.in[5];
    bf16_t* H = (bf16_t*)((unsigned char*)a.out + OO_H);
    float* gig = (float*)(ws + O_GIG); float* glf = (float*)(ws + O_GLF);
    for (int row = gw; row < T; row += NGW) {
        const f32x4* xr = (const f32x4*)(x + (size_t)row * D) + lane; const f32x4* gr = (const f32x4*)g + lane;
        f32x4 v[4]; float s = 0.f;
#pragma unroll
        for (int j = 0; j < 4; ++j) { v[j] = xr[64 * j]; s += (v[j][0] * v[j][0] + v[j][1] * v[j][1]) + (v[j][2] * v[j][2] + v[j][3] * v[j][3]); }
        const float rstd = rsqrtf(wave_sum(s) * (1.f / D) + EPS);
        float g8[8];
#pragma unroll
        for (int e = 0; e < 8; ++e) g8[e] = 0.f;
        u32x2* o8 = (u32x2*)(H + (size_t)row * D) + lane;
#pragma unroll
        for (int j = 0; j < 4; ++j) { const f32x4 hv = v[j] * rstd * gr[64 * j]; u32x2 o; o.x = pk2(hv[0], hv[1]); o.y = pk2(hv[2], hv[3]); o8[64 * j] = o;
#pragma unroll
            for (int e = 0; e < 4; ++e) { const int k = 4 * lane + 256 * j + e; const f32x4* wr = (const f32x4*)(w_in + (size_t)k * NIN + 3072); const f32x4 w0 = wr[0], w1 = wr[1];
                g8[0] += hv[e] * w0[0]; g8[1] += hv[e] * w0[1]; g8[2] += hv[e] * w0[2]; g8[3] += hv[e] * w0[3]; g8[4] += hv[e] * w1[0]; g8[5] += hv[e] * w1[1]; g8[6] += hv[e] * w1[2]; g8[7] += hv[e] * w1[3]; } }
#pragma unroll
        for (int e = 0; e < 8; ++e) g8[e] = wave_sum(g8[e]);
        if (lane == 0) { const int b = row / SEQ, s_ = row % SEQ;
#pragma unroll
            for (int hh = 0; hh < 4; ++hh) { gig[(size_t)(b * 4 + hh) * SEQ + s_] = g8[hh] + bif[hh]; glf[(size_t)(b * 4 + hh) * SEQ + s_] = logsigmoid(g8[4 + hh] + bif[4 + hh]); } }
    }
}

__device__ __forceinline__ void gate_chunk(float lf, float ig, int lane, float& b, float& av, float& amax, float& pm) {
    float v = lf;
#pragma unroll
    for (int o = 1; o < 64; o <<= 1) { const float t = __shfl_up(v, o); if (lane >= o) v += t; }
    b = v; av = ig - v; float q = av;
#pragma unroll
    for (int o = 1; o < 64; o <<= 1) { const float t = __shfl_up(q, o); if (lane >= o) q = fmaxf(q, t); }
    pm = q; amax = wave_max(av);
}
__device__ __forceinline__ void phase2(const Args& a, LAS unsigned char* lds, int wave) {
    const int lane = lane_id();
    unsigned char* ws = a.ws;
    LAS unsigned* tile = (LAS unsigned*)(lds + wave * 16384);
    LAS unsigned short* tile16 = (LAS unsigned short*)tile;
    const int gw = blockIdx.x * 8 + wave, NGW = gridDim.x * 8;
    const bf16_t* QK = (const bf16_t*)(ws + O_QK); const bf16_t* VML = (const bf16_t*)(ws + O_VML); const bf16_t* VSW = (const bf16_t*)(ws + O_VSW);
    bf16_t* QKP = (bf16_t*)((unsigned char*)a.out + OO_QKP); bf16_t* VT = (bf16_t*)((unsigned char*)a.out + OO_VT);
    bf16_t* KT = (bf16_t*)(ws + O_KT); bf16_t* VTSW = (bf16_t*)(ws + O_VTSW);
    const float* gig = (const float*)(ws + O_GIG); const float* glf = (const float*)(ws + O_GLF);
    const float* cw = a.in[4];
    const int rsub = lane >> 3, cg8 = lane & 7;
    constexpr int N_QK = 512 * 16, N_VML = 512 * 16, N_VSW = 512 * 4, N_TILE = N_QK + N_VML + N_VSW, N_ALL = N_TILE + 16 * NCH;
    for (int it = gw; it < N_ALL; it += NGW) {
        if (it >= N_TILE) {
            const int q = it - N_TILE, bh = q / NCH, c = q % NCH; const size_t gi = (size_t)bh * SEQ + c * 64 + lane;
            float b, av, amax, pm; gate_chunk(glf[gi], gig[gi], lane, b, av, amax, pm);
            ((float*)(ws + O_GBC))[gi] = b; ((float*)(ws + O_GL))[gi] = b + pm;
            ((bf16_t*)(ws + O_GWH))[gi] = (bf16_t)(pk2(__expf(av - amax), 0.f) & 0xffffu);
            const float bl = rdlane(b, 63);
            if (lane == 0) { ((float*)(ws + O_CBL))[q] = bl; ((float*)(ws + O_CMW))[q] = bl + amax; ((float*)(ws + O_CAMAX))[q] = amax; }
            continue;
        }
        int kind, tt, ct;
        if (it < N_QK) { kind = 0; tt = it >> 4; ct = it & 15; } else if (it < N_QK + N_VML) { kind = 1; tt = (it - N_QK) >> 4; ct = (it - N_QK) & 15; } else { kind = 2; tt = (it - N_QK - N_VML) >> 2; ct = (it - N_QK - N_VML) & 3; }
        const int t0 = tt * 64, c0 = ct * 64, bb = t0 / SEQ, s0 = t0 % SEQ, c = c0 + 8 * cg8;
        if (kind == 0) {
            float w[4][8];
#pragma unroll
            for (int j = 0; j < 4; ++j) { const f32x4 w0 = *(const f32x4*)(cw + j * 1024 + c), w1 = *(const f32x4*)(cw + j * 1024 + c + 4);
                w[j][0] = w0[0]; w[j][1] = w0[1]; w[j][2] = w0[2]; w[j][3] = w0[3]; w[j][4] = w1[0]; w[j][5] = w1[1]; w[j][6] = w1[2]; w[j][7] = w1[3]; }
            const float qs = (c < 512) ? 0.08838834764831845f : 1.f;
#pragma unroll 2
            for (int i = 0; i < 8; ++i) { const int r = 8 * i + rsub, t = t0 + r, sp = s0 + r;
                float acc8[8];
#pragma unroll
                for (int e = 0; e < 8; ++e) acc8[e] = 0.f;
#pragma unroll
                for (int j = 0; j < 4; ++j) { if (sp - 3 + j >= 0) { const u32x4 xv = *(const u32x4*)(QK + (size_t)(t - 3 + j) * 1024 + c);
                        acc8[0] += w[j][0] * bflo(xv.x); acc8[1] += w[j][1] * bfhi(xv.x); acc8[2] += w[j][2] * bflo(xv.y); acc8[3] += w[j][3] * bfhi(xv.y);
                        acc8[4] += w[j][4] * bflo(xv.z); acc8[5] += w[j][5] * bfhi(xv.z); acc8[6] += w[j][6] * bflo(xv.w); acc8[7] += w[j][7] * bfhi(xv.w); } }
#pragma unroll
                for (int e = 0; e < 8; ++e) acc8[e] = acc8[e] * sigm(acc8[e]) * qs;
                u32x4 o; o.x = pk2(acc8[0], acc8[1]); o.y = pk2(acc8[2], acc8[3]); o.z = pk2(acc8[4], acc8[5]); o.w = pk2(acc8[6], acc8[7]);
                *(u32x4*)(QKP + (size_t)t * 1024 + c) = o;
                if (c0 >= 512) { LAS unsigned* tp = tile + r * 33 + 4 * cg8; tp[0] = o.x; tp[1] = o.y; tp[2] = o.z; tp[3] = o.w; } }
            if (c0 < 512) continue;
        } else {
            float wh = 1.f;
            if (kind == 1) { const int bh = bb * 4 + (c0 >> 8); const size_t gi = (size_t)bh * SEQ + s0 + lane; float b, av, amax, pm; gate_chunk(glf[gi], gig[gi], lane, b, av, amax, pm); wh = __expf(av - amax); }
            const bf16_t* src = (kind == 1) ? VML : VSW; const int ld = (kind == 1) ? 1024 : 256;
#pragma unroll 2
            for (int i = 0; i < 8; ++i) { const int r = 8 * i + rsub; u32x4 o = *(const u32x4*)(src + (size_t)(t0 + r) * ld + c);
                const float sc = __shfl(wh, r);
                if (kind == 1) { o.x = pk2(bflo(o.x) * sc, bfhi(o.x) * sc); o.y = pk2(bflo(o.y) * sc, bfhi(o.y) * sc); o.z = pk2(bflo(o.z) * sc, bfhi(o.z) * sc); o.w = pk2(bflo(o.w) * sc, bfhi(o.w) * sc); }
                LAS unsigned* tp = tile + r * 33 + 4 * cg8; tp[0] = o.x; tp[1] = o.y; tp[2] = o.z; tp[3] = o.w; }
        }
        asm volatile("s_waitcnt lgkmcnt(0)" ::: "memory");
        bf16_t* dst; int C, cb;
        if (kind == 0) { dst = KT; C = 512; cb = c0 - 512; } else if (kind == 1) { dst = VT; C = 1024; cb = c0; } else { dst = VTSW; C = 256; cb = c0; }
#pragma unroll 2
        for (int i = 0; i < 8; ++i) { const int ch = 8 * i + (lane >> 3), tg = lane & 7; const LAS unsigned short* sp = tile16 + (8 * tg) * 66 + ch;
            u32x4 o; o.x = (unsigned)sp[0] | ((unsigned)sp[66] << 16); o.y = (unsigned)sp[2 * 66] | ((unsigned)sp[3 * 66] << 16); o.z = (unsigned)sp[4 * 66] | ((unsigned)sp[5 * 66] << 16); o.w = (unsigned)sp[6 * 66] | ((unsigned)sp[7 * 66] << 16);
            *(u32x4*)(dst + ((size_t)bb * C + cb + ch) * SEQ + s0 + 8 * tg) = o; }
        asm volatile("s_waitcnt lgkmcnt(0)" ::: "memory");
    }
}

__device__ __forceinline__ void scan_unit(const Args& a, int u, int lane) {
    unsigned char* ws = a.ws;
    const int dq = u & 3, sl = (u >> 2) % 17, bh = u / 68, fr = lane & 15, fq = lane >> 4;
    const bf16_t* KT = (const bf16_t*)(ws + O_KT); const bf16_t* VT = (const bf16_t*)((unsigned char*)a.out + OO_VT); const bf16_t* GWH = (const bf16_t*)(ws + O_GWH);
    const bf16_t* pa = KT + (size_t)(bh * 128 + 32 * dq + fr) * SEQ + 8 * fq;
    const bf16_t* pb = (sl < 16) ? VT + (size_t)(bh * 256 + 16 * sl + fr) * SEQ + 8 * fq : GWH + (size_t)bh * SEQ + 8 * fq;
    bf16_t* pst = (bf16_t*)(ws + O_CST) + ((size_t)(bh * NCH) * CROWS + 16 * sl + fr) * 128 + 32 * dq + 4 * fq;
    const float* cbl = (const float*)(ws + O_CBL) + bh * NCH; const float* cmw = (const float*)(ws + O_CMW) + bh * NCH; float* cm = (float*)(ws + O_CM) + bh * NCH;
    const float bl0 = cbl[lane], bl1 = cbl[64 + lane], mw0 = cmw[lane], mw1 = cmw[64 + lane];
    const bool wr_m = (sl == 0 && dq == 0 && lane == 0);
    constexpr int PF = 4;
    bf16x8 ra[PF][4], rb[PF][2];
#define SC_LOAD(slot, cc) do { ra[slot][0] = ld8(pa + (cc) * 64); ra[slot][1] = ld8(pa + (cc) * 64 + 32); ra[slot][2] = ld8(pa + 16 * SEQ + (cc) * 64); ra[slot][3] = ld8(pa + 16 * SEQ + (cc) * 64 + 32); \
        rb[slot][0] = ld8(pb + (cc) * 64); rb[slot][1] = ld8(pb + (cc) * 64 + 32); } while (0)
#pragma unroll
    for (int p = 0; p < PF; ++p) SC_LOAD(p, p);
    f32x4 acc0 = {0.f, 0.f, 0.f, 0.f}, acc1 = {0.f, 0.f, 0.f, 0.f}; float mst = 0.f;
    for (int c0 = 0; c0 < NCH; c0 += PF) {
#pragma unroll
        for (int p = 0; p < PF; ++p) { const int c = c0 + p;
            bf16_t* st = pst + (size_t)c * (CROWS * 128);
            u32x2 s0; s0.x = pk2(acc0[0], acc0[1]); s0.y = pk2(acc0[2], acc0[3]); *(u32x2*)st = s0;
            u32x2 s1; s1.x = pk2(acc1[0], acc1[1]); s1.y = pk2(acc1[2], acc1[3]); *(u32x2*)(st + 16) = s1;
            const float bl = (c < 64) ? rdlane(bl0, c & 63) : rdlane(bl1, c & 63), mw = (c < 64) ? rdlane(mw0, c & 63) : rdlane(mw1, c & 63);
            if (wr_m) cm[c] = mst;
            const float mn = fmaxf(bl + mst, mw), decay = __expf(bl + mst - mn), eta = __expf(mw - mn);
            const f32x4 z = {0.f, 0.f, 0.f, 0.f};
            f32x4 t0 = mfma16(ra[p][0], rb[p][0], z); t0 = mfma16(ra[p][1], rb[p][1], t0);
            f32x4 t1 = mfma16(ra[p][2], rb[p][0], z); t1 = mfma16(ra[p][3], rb[p][1], t1);
            acc0 = acc0 * decay + t0 * eta; acc1 = acc1 * decay + t1 * eta; mst = mn;
            if (c + PF < NCH) SC_LOAD(p, c + PF);
        }
    }
#undef SC_LOAD
}

__device__ __forceinline__ void swa_unit(const Args& a, int wu, int lane) {
    unsigned char* ws = a.ws;
    const int g16 = wu & 511, hq = (wu >> 9) & 15, b = wu >> 13, kvh = hq >> 2, fr = lane & 15, fq = lane >> 4;
    bf16_t* QSW = (bf16_t*)(ws + O_QSW); const bf16_t* KSW = (const bf16_t*)(ws + O_KSW); const bf16_t* VTSW = (const bf16_t*)(ws + O_VTSW);
    const int t0 = 16 * g16, tq = t0 + fr, kb = t0 - 144;
    const bf16_t* qp = QSW + (size_t)(b * SEQ + tq) * 1024 + hq * 64 + 8 * fq;
    const bf16x8 qf0 = ld8(qp), qf1 = ld8(qp + 32);
    const float sink = a.in[7][hq];
    f32x4 st[10];
    const int krow = 8 * (fr >> 2) + (fr & 3);
#pragma unroll
    for (int tau = 0; tau < 10; ++tau) { const int i = tau >> 1, e = tau & 1; int kp = kb + 32 * i + krow + 4 * e; kp = kp < 0 ? 0 : kp;
        const bf16_t* kq = KSW + (size_t)(b * SEQ + kp) * 256 + kvh * 64 + 8 * fq;
        f32x4 s = {0.f, 0.f, 0.f, 0.f}; s = mfma16(ld8(kq), qf0, s); s = mfma16(ld8(kq + 32), qf1, s); st[tau] = s; }
    float mx = -1e30f;
#pragma unroll
    for (int tau = 0; tau < 10; ++tau) { const int i = tau >> 1, e = tau & 1;
#pragma unroll
        for (int r = 0; r < 4; ++r) { const int kp = kb + 32 * i + 8 * fq + 4 * e + r, df = tq - kp; const bool ok = (kp >= 0) && (df >= 0) && (df < 128);
            const float l = ok ? st[tau][r] * 0.125f : -1e30f; st[tau][r] = l; mx = fmaxf(mx, l); } }
    mx = fmaxf(mx, __shfl_xor(mx, 16)); mx = fmaxf(mx, __shfl_xor(mx, 32)); mx = fmaxf(mx, sink);
    float sum = 0.f;
#pragma unroll
    for (int tau = 0; tau < 10; ++tau)
#pragma unroll
        for (int r = 0; r < 4; ++r) { const float p = __expf(st[tau][r] - mx); st[tau][r] = p; sum += p; }
    sum += __shfl_xor(sum, 16); sum += __shfl_xor(sum, 32);
    const float inv = 1.f / (sum + __expf(sink - mx));
    bf16x8 pf[5];
#pragma unroll
    for (int i = 0; i < 5; ++i) { u32x4 w; w.x = pk2(st[2 * i][0], st[2 * i][1]); w.y = pk2(st[2 * i][2], st[2 * i][3]); w.z = pk2(st[2 * i + 1][0], st[2 * i + 1][1]); w.w = pk2(st[2 * i + 1][2], st[2 * i + 1][3]); pf[i] = __builtin_bit_cast(bf16x8, w); }
    f32x4 o[4];
#pragma unroll
    for (int mt = 0; mt < 4; ++mt) { const int hd = 16 * (fr >> 2) + 4 * mt + (fr & 3); const bf16_t* vp = VTSW + (size_t)((b * 4 + kvh) * 64 + hd) * SEQ;
        f32x4 s = {0.f, 0.f, 0.f, 0.f};
#pragma unroll
        for (int i = 0; i < 5; ++i) { int sp = kb + 32 * i + 8 * fq; sp = sp < 0 ? 0 : sp; s = mfma16(ld8(vp + sp), pf[i], s); }
        o[mt] = s * inv; }
    u32x4 w0, w1; w0.x = pk2(o[0][0], o[0][1]); w0.y = pk2(o[0][2], o[0][3]); w0.z = pk2(o[1][0], o[1][1]); w0.w = pk2(o[1][2], o[1][3]);
    w1.x = pk2(o[2][0], o[2][1]); w1.y = pk2(o[2][2], o[2][3]); w1.z = pk2(o[3][0], o[3][1]); w1.w = pk2(o[3][2], o[3][3]);
    bf16_t* op = QSW + (size_t)(b * SEQ + tq) * 1024 + hq * 64 + 16 * fq;
    *(u32x4*)op = w0; *(u32x4*)(op + 8) = w1;
}
__device__ __forceinline__ void phase3(const Args& a, int wave) {
    const int lane = lane_id();
    const int gwm = wave * (int)gridDim.x + (int)blockIdx.x;
    if (gwm < 16 * 17 * 4) scan_unit(a, gwm, lane);
    unsigned* ctr = (unsigned*)(a.ws + O_CTR);
    for (;;) {
        unsigned wu = 0; if (lane == 0) wu = atomicAdd(ctr, 1u);
        wu = (unsigned)__builtin_amdgcn_readfirstlane((int)wu);
        if (wu >= (unsigned)(NB * 16 * 512)) break;
        swa_unit(a, (int)wu, lane);
    }
}

__device__ __forceinline__ void phase4(const Args& a, LAS unsigned char* lds, int wave) {
    const int lane = lane_id();
    unsigned char* ws = a.ws;
    { const f32x4* p = (const f32x4*)a.in[1]; u32x2* pbo = (u32x2*)(ws + O_PB); const int n = T * PLE / 4;
        for (int i = blockIdx.x * 512 + wave * 64 + lane; i < n; i += gridDim.x * 512) { const f32x4 v = p[i]; u32x2 o; o.x = pk2(v[0], v[1]); o.y = pk2(v[2], v[3]); pbo[i] = o; } }
    const bf16_t* QKP = (const bf16_t*)((unsigned char*)a.out + OO_QKP); const bf16_t* VT = (const bf16_t*)((unsigned char*)a.out + OO_VT);
    const bf16_t* CST = (const bf16_t*)(ws + O_CST); const bf16_t* GWH = (const bf16_t*)(ws + O_GWH); bf16_t* OML = (bf16_t*)(ws + O_OML);
    const float* gbc = (const float*)(ws + O_GBC); const float* gL = (const float*)(ws + O_GL); const float* cm = (const float*)(ws + O_CM); const float* camax = (const float*)(ws + O_CAMAX);
    const float* gn = a.in[6];
    LAS bf16_t* Pt = (LAS bf16_t*)lds;
    LAS float* red = (LAS float*)(lds + 16384);
    const int fr = lane & 15, fq = lane >> 4, w = wave;
    for (int un = blockIdx.x; un < 16 * NCH; un += gridDim.x) {
        const int bh = un / NCH, c = un % NCH, bb = bh >> 2, h = bh & 3; const size_t tok0 = (size_t)bb * SEQ + c * 64;
        const float m_c = cm[un], amax = camax[un];
        float F[4], wi[4], en[4];
#pragma unroll
        for (int tt = 0; tt < 4; ++tt) { const size_t gi = (size_t)bh * SEQ + c * 64 + 16 * tt + fr; const float bt = gbc[gi], mt = fmaxf(bt + m_c, gL[gi]);
            F[tt] = __expf(bt - mt + amax); wi[tt] = __expf(bt + m_c - mt); en[tt] = __expf(-mt); }
        { const int st = w >> 1; const bf16_t* kp = QKP + (tok0 + 16 * st + fr) * 1024 + 512 + h * 128 + 8 * fq;
            bf16x8 kf[4];
#pragma unroll
            for (int ks = 0; ks < 4; ++ks) kf[ks] = ld8(kp + 32 * ks);
#pragma unroll
            for (int j = 0; j < 2; ++j) { const int tt = 2 * (w & 1) + j; const bf16_t* qp = QKP + (tok0 + 16 * tt + fr) * 1024 + h * 128 + 8 * fq;
                f32x4 s = {0.f, 0.f, 0.f, 0.f};
#pragma unroll
                for (int ks = 0; ks < 4; ++ks) s = mfma16(kf[ks], ld8(qp + 32 * ks), s);
                const int t = 16 * tt + fr, sb = 16 * st + 4 * fq; const float f = (j == 0) ? F[2 * (w & 1)] : F[2 * (w & 1) + 1];
                float p0 = (sb + 0 <= t) ? s[0] * f : 0.f, p1 = (sb + 1 <= t) ? s[1] * f : 0.f, p2 = (sb + 2 <= t) ? s[2] * f : 0.f, p3 = (sb + 3 <= t) ? s[3] * f : 0.f;
                u32x2 o; o.x = pk2(p0, p1); o.y = pk2(p2, p3); *(LAS u32x2*)(Pt + t * 72 + sb) = o; } }
        bf16x8 qt[4][4];
#pragma unroll
        for (int tt = 0; tt < 4; ++tt) { const bf16_t* qp = QKP + (tok0 + 16 * tt + fr) * 1024 + h * 128 + 8 * fq;
#pragma unroll
            for (int ks = 0; ks < 4; ++ks) qt[tt][ks] = scale8(ld8(qp + 32 * ks), wi[tt]); }
        __syncthreads();
        f32x4 acc[3][4];
#pragma unroll
        for (int e = 0; e < 3; ++e) { const int dvr = 32 * w + 8 * (fr >> 2) + 4 * e + (fr & 3); const int crow = (e < 2) ? dvr : 256 + fr;
            const bf16_t* cp = CST + ((size_t)un * CROWS + crow) * 128 + 8 * fq;
            const bf16_t* vp = (e < 2) ? VT + (size_t)(bh * 256 + dvr) * SEQ + c * 64 + 8 * fq : GWH + (size_t)bh * SEQ + c * 64 + 8 * fq;
            bf16x8 ca[4], va[2];
#pragma unroll
            for (int ks = 0; ks < 4; ++ks) ca[ks] = ld8(cp + 32 * ks);
            va[0] = ld8(vp); va[1] = ld8(vp + 32);
#pragma unroll
            for (int tt = 0; tt < 4; ++tt) { f32x4 s = {0.f, 0.f, 0.f, 0.f};
#pragma unroll
                for (int ks = 0; ks < 4; ++ks) s = mfma16(ca[ks], qt[tt][ks], s);
#pragma unroll
                for (int k2 = 0; k2 < 2; ++k2) s = mfma16(va[k2], *(const LAS bf16x8*)(Pt + (16 * tt + fr) * 72 + 32 * k2 + 8 * fq), s);
                acc[e][tt] = s; } }
        float rs[4];
#pragma unroll
        for (int tt = 0; tt < 4; ++tt) { const float dn = __builtin_amdgcn_rcpf(fmaxf(fabsf(acc[2][tt][0]), en[tt])); float ss = 0.f;
#pragma unroll
            for (int e = 0; e < 2; ++e)
#pragma unroll
                for (int r = 0; r < 4; ++r) { const float hv = acc[e][tt][r] * dn; acc[e][tt][r] = hv; ss += hv * hv; }
            ss += __shfl_xor(ss, 16); ss += __shfl_xor(ss, 32);
            if (fq == 0) red[w * 64 + 16 * tt + fr] = ss; }
        __syncthreads();
#pragma unroll
        for (int tt = 0; tt < 4; ++tt) { float tot = 0.f;
#pragma unroll
            for (int ww = 0; ww < 8; ++ww) tot += red[ww * 64 + 16 * tt + fr];
            rs[tt] = rsqrtf(tot * (1.f / 256.f) + EPS); }
        const int colh = h * 256 + 32 * w + 8 * fq;
        const f32x4 g0 = *(const f32x4*)(gn + colh), g1 = *(const f32x4*)(gn + colh + 4);
#pragma unroll
        for (int tt = 0; tt < 4; ++tt) { bf16_t* op = OML + (tok0 + 16 * tt + fr) * 1024 + colh; const u32x4 ov = *(const u32x4*)op; const float r_ = rs[tt]; u32x4 y;
            y.x = pk2(sigm(bflo(ov.x)) * g0[0] * acc[0][tt][0] * r_, sigm(bfhi(ov.x)) * g0[1] * acc[0][tt][1] * r_);
            y.y = pk2(sigm(bflo(ov.y)) * g0[2] * acc[0][tt][2] * r_, sigm(bfhi(ov.y)) * g0[3] * acc[0][tt][3] * r_);
            y.z = pk2(sigm(bflo(ov.z)) * g1[0] * acc[1][tt][0] * r_, sigm(bfhi(ov.z)) * g1[1] * acc[1][tt][1] * r_);
            y.w = pk2(sigm(bflo(ov.w)) * g1[2] * acc[1][tt][2] * r_, sigm(bfhi(ov.w)) * g1[3] * acc[1][tt][3] * r_);
            *(u32x4*)op = y; }
    }
}

__device__ __forceinline__ void phase10(const Args& a, int wave) {
    const int lane = lane_id();
    const float* ssq = (const float*)(a.ws + O_SSQ3); const float* g = a.in[17];
    const int gw = blockIdx.x * 8 + wave, NGW = gridDim.x * 8;
    for (int row = gw; row < T; row += NGW) { const float rs = row_rstd(ssq, row);
        f32x4* xr = (f32x4*)(a.out + (size_t)row * D) + lane; const f32x4* gr = (const f32x4*)g + lane;
#pragma unroll
        for (int j = 0; j < 4; ++j) xr[64 * j] = xr[64 * j] * rs * gr[64 * j]; }
}

__device__ __forceinline__ void grid_bar(unsigned* bar, unsigned& nbar, int wave) {
    asm volatile("s_waitcnt vmcnt(0)" ::: "memory");
    __syncthreads();
    ++nbar;
    if (wave == 0 && lane_id() == 0) {
        __builtin_amdgcn_fence(__ATOMIC_RELEASE, "agent");
        asm volatile("s_waitcnt vmcnt(0)" ::: "memory");
        __hip_atomic_fetch_add(bar, 1u, __ATOMIC_RELAXED, __HIP_MEMORY_SCOPE_AGENT);
        const unsigned target = nbar * gridDim.x; unsigned sp = 0;
        while (__hip_atomic_load(bar, __ATOMIC_RELAXED, __HIP_MEMORY_SCOPE_AGENT) < target) { __builtin_amdgcn_s_sleep(2); if (++sp > (1u << 24)) break; }
        __builtin_amdgcn_fence(__ATOMIC_ACQUIRE, "agent");
        asm volatile("s_waitcnt vmcnt(0)" ::: "memory");
    }
    __syncthreads();
}

__global__ void __launch_bounds__(512, 2) mk_fwd(Args a) {
    extern __shared__ __attribute__((aligned(16))) unsigned char lds_raw[];
    LAS unsigned char* lds = (LAS unsigned char*)lds_raw;
    const int wave = __builtin_amdgcn_readfirstlane(threadIdx.x >> 6);
    unsigned char* ws = a.ws;
    const int lo = a.ph_lo, hi = a.ph_hi;
    if (lo == 0 && hi == NPHASE) cg::this_grid().sync();
    unsigned nbar = 0; unsigned* bar = (unsigned*)(ws + O_BAR);
#define IN(k) (lo <= (k) && (k) < hi)
#define SEAM(k) do { if (IN(k) && IN((k) + 1)) grid_bar(bar, nbar, wave); } while (0)
    if (IN(0)) phase0(a, lds, wave);
    SEAM(0);
    if (IN(1)) { EpiSeg E{ws}; run_gemm(lds, wave, (const bf16_t*)((unsigned char*)a.out + OO_H), (const bf16_t*)(ws + O_WIN), T, NP1, D, E); }
    SEAM(1);
    if (IN(2)) phase2(a, lds, wave);
    SEAM(2);
    if (IN(3)) phase3(a, wave);
    SEAM(3);
    if (IN(4)) phase4(a, lds, wave);
    SEAM(4);
    if (IN(5)) {
        { EpiGateA E{(const bf16_t*)(ws + O_GA), a.out}; run_gemm(lds, wave, (const bf16_t*)(ws + O_OML), (const bf16_t*)(ws + O_WA), T, D, D, E); }
        { EpiGateB E{(const bf16_t*)(ws + O_GB), a.out, (bf16_t*)(ws + O_MERGED)}; run_gemm(lds, wave, (const bf16_t*)(ws + O_QSW), (const bf16_t*)(ws + O_WB), T, D, D, E); }
    }
    SEAM(5);
    if (IN(6)) { EpiRes E{a.in[0], a.out, (bf16_t*)(ws + O_X1B), (float*)(ws + O_SSQ1)}; run_gemm(lds, wave, (const bf16_t*)(ws + O_MERGED), (const bf16_t*)(ws + O_WOUT), T, D, D, E); }
    SEAM(6);
    if (IN(7)) { EpiUp E{(const float*)(ws + O_SSQ1), (bf16_t*)(ws + O_ACT)}; run_gemm(lds, wave, (const bf16_t*)(ws + O_X1B), (const bf16_t*)(ws + O_WUP), T, FF, D, E); }
    SEAM(7);
    if (IN(8)) {
        { EpiRes E{a.out, a.out, (bf16_t*)(ws + O_X2B), (float*)(ws + O_SSQ2)}; run_gemm(lds, wave, (const bf16_t*)(ws + O_ACT), (const bf16_t*)(ws + O_WDN), T, D, FF, E); }
        { EpiPlain E{(bf16_t*)(ws + O_PP), D}; run_gemm(lds, wave, (const bf16_t*)(ws + O_PB), (const bf16_t*)(ws + O_WP), T, D, PLE, E); }
    }
    SEAM(8);
    if (IN(9)) { EpiPle E{(const float*)(ws + O_SSQ2), (const bf16_t*)(ws + O_PP), a.out, (float*)(ws + O_SSQ3)}; run_gemm(lds, wave, (const bf16_t*)(ws + O_X2B), (const bf16_t*)(ws + O_WG), T, D, D, E); }
    SEAM(9);
    if (IN(10)) phase10(a, wave);
#undef IN
#undef SEAM
}

extern "C" void kernel_launch(void* const* d_in, const int* in_sizes, int n_in, void* d_out, int out_size, void* d_ws, size_t ws_size, hipStream_t stream) {
    static int grid = 0;
    if (grid == 0) {
        if (n_in != 18 || out_size != T * D || ws_size < WS_NEED) { fprintf(stderr, "kernel_launch: unexpected shapes (n_in %d out %d ws %zu)\n", n_in, out_size, ws_size); grid = -1; return; }
        int dev = 0, cus = 0, per_cu = 0;
        if (hipGetDevice(&dev) != hipSuccess || hipDeviceGetAttribute(&cus, hipDeviceAttributeMultiprocessorCount, dev) != hipSuccess) { grid = -1; return; }
        if (hipFuncSetAttribute((const void*)mk_fwd, hipFuncAttributeMaxDynamicSharedMemorySize, LDS_BYTES) != hipSuccess) { fprintf(stderr, "kernel_launch: hipFuncSetAttribute failed\n"); grid = -1; return; }
        if (hipOccupancyMaxActiveBlocksPerMultiprocessor(&per_cu, (const void*)mk_fwd, 512, LDS_BYTES) != hipSuccess || per_cu < 1) per_cu = 1;
        (void)hipGetLastError();
        grid = cus;
    }
    if (grid < 0) return;
    if (hipMemsetAsync((char*)d_ws + O_BAR, 0, 256, stream) != hipSuccess) { fprintf(stderr, "kernel_launch: memset failed\n"); return; }
    Args a{};
    for (int i = 0; i < 18; ++i) a.in[i] = (const float*)d_in[i];
    a.out = (float*)d_out; a.ws = (unsigned char*)d_ws;
#if MK_N_LAUNCHES == 1
    a.ph_lo = 0; a.ph_hi = NPHASE;
    void* args[] = {&a};
    hipError_t e = hipLaunchCooperativeKernel((const void*)mk_fwd, dim3(grid), dim3(512), args, LDS_BYTES, stream);
    if (e != hipSuccess) fprintf(stderr, "cooperative launch failed: %s (grid %d)\n", hipGetErrorString(e), grid);
#else
    for (int p = 0; p < NPHASE; ++p) { a.ph_lo = p; a.ph_hi = p + 1; hipLaunchKernelGGL(mk_fwd, dim3(grid), dim3(512), LDS_BYTES, stream, a); }
#endif
}
```

```cpp
#include <hip/hip_runtime.h>
#include <hip/hip_cooperative_groups.h>
#include <cstdio>
#include <cstdint>
namespace cg = cooperative_groups;
namespace pg8 {
#define PG8_LAS __attribute__((address_space(3)))
typedef unsigned short bf16_t;
typedef short bf16x8 __attribute__((ext_vector_type(8)));
typedef float f32x4 __attribute__((ext_vector_type(4)));
typedef unsigned u32x4 __attribute__((ext_vector_type(4)));
constexpr int BM = 256, BK = 64, HALF = 128, HTB = HALF * BK * 2  , STAGE_BYTES = 8 * HTB, NXCD = 8, WGM = 8;

__host__ __device__ __forceinline__ int lds_byte(int r, int c) { const int st = (r >> 4) * 2 + (c >> 5), rr = r & 15, cc = c & 31, ob = rr * 64 + cc * 2; return st * 1024 + (ob ^ (((ob >> 9) & 1) << 5)); }
__host__ __device__ __forceinline__ void stage_rc(int b, int& R, int& C) { const int st = b / 1024, sb = b % 1024, swz = sb ^ (((sb >> 9) & 1) << 5); R = (st >> 1) * 16 + swz / 64; C = (st & 1) * 32 + (swz % 64) / 2; }
__host__ __device__ __forceinline__ int perm32(int rho) { const int n = rho >> 4, i = rho & 15; return 8 * (i >> 2) + 4 * n + (i & 3); }

struct Unit { int pm, pn; };
struct Gemm { const bf16_t* A; const bf16_t* Bt; int M, N, K; };

struct StaticOrder {
    int nM, nN, nwg, G, c;
    __host__ __device__ void init(int M, int N, int G_, int c_) { nM = M / BM; nN = N / BM; nwg = nM * nN; G = G_; c = c_; }
    __host__ __device__ bool next(int i, Unit& u) const {
        const long L = (long)i * G + c; if (L >= nwg) return false;
        int wgid = (int)L; { const int q = nwg / NXCD, r = nwg % NXCD, xcd = wgid % NXCD, off = wgid / NXCD; wgid = (xcd < r ? xcd * (q + 1) : r * (q + 1) + (xcd - r) * q) + off; }
        const int nig = WGM * nN, gid = wgid / nig, fm = gid * WGM, gsz = (nM - fm) < WGM ? (nM - fm) : WGM;
        u.pm = fm + ((wgid % nig) % gsz); u.pn = (wgid % nig) / gsz; return true;
    }
    __device__ __forceinline__ void a_ready(const Unit&) const {}
    __device__ __forceinline__ void done(const Unit&) const {}
};
__device__ __forceinline__ unsigned cvt_pk_bf16(float lo, float hi) { unsigned r; asm volatile("v_cvt_pk_bf16_f32 %0, %1, %2" : "=v"(r) : "v"(lo), "v"(hi)); return r; }
template <class Epi, class Sched, bool ALIGN_EPI = false, bool SP2 = false>
__device__ __forceinline__ void gemm_phase(PG8_LAS unsigned char* lds, const Gemm g, const Sched& S, const Epi& E, const int wid) {
    int lane; asm volatile("v_mbcnt_lo_u32_b32 %0, -1, 0\n\tv_mbcnt_hi_u32_b32 %0, -1, %0" : "=v"(lane));
    const int tid = wid * 64 + lane, wr = wid >> 2, wc = wid & 3, fr = lane & 15, fq = lane >> 4;
    const int K = g.K, nt = K / BK;
    unsigned voffA[2], voffB[2];
#pragma unroll
    for (int i = 0; i < 2; ++i) { int R, C; stage_rc(tid * 16 + i * 8192, R, C); const int Rb = Epi::PERM ? ((R & ~31) + perm32(R & 31)) : R;
        voffA[i] = (unsigned)(R * K + C) * 2u; voffB[i] = (unsigned)(Rb * K + C) * 2u; }
    const size_t kstep = (size_t)(BK * 2);
    const size_t hstep = (size_t)HALF * K * 2;
    const size_t tstep = 2 * hstep;
    const unsigned ldsw = (unsigned)wid * 1024u;
    const int aoff = lds_byte(wr * 64 + fr, fq * 8), boff = lds_byte(wc * 32 + fr, fq * 8);
#define PG8_SA(b, h) (((b) * 2 + (h)) * HTB)
#define PG8_SB(b, h) ((4 + (b) * 2 + (h)) * HTB)
#define PG8_STAGE(bufoff, gbase, voff) do { _Pragma("unroll") for (int _i = 0; _i < 2; ++_i) \
        __builtin_amdgcn_global_load_lds((const unsigned*)((const char*)(gbase) + (voff)[_i]), (PG8_LAS unsigned*)(lds + (bufoff) + ldsw + _i * 8192), 16, 0, 0); } while (0)
#define PG8_LDA(dst, b, h) do { _Pragma("unroll") for (int m = 0; m < 4; ++m) _Pragma("unroll") for (int k = 0; k < 2; ++k) dst[m][k] = *(const PG8_LAS bf16x8*)(lds + PG8_SA(b, h) + aoff + m * 2048 + k * 1024); } while (0)
#define PG8_LDB(dst, b, h) do { _Pragma("unroll") for (int n = 0; n < 2; ++n) _Pragma("unroll") for (int k = 0; k < 2; ++k) dst[n][k] = *(const PG8_LAS bf16x8*)(lds + PG8_SB(b, h) + boff + n * 2048 + k * 1024); } while (0)
#define PG8_MMA(ai, bj, At, Bt) do { __builtin_amdgcn_s_setprio(1); _Pragma("unroll") for (int m = 0; m < 4; ++m) _Pragma("unroll") for (int n = 0; n < 2; ++n) _Pragma("unroll") for (int k = 0; k < 2; ++k) \
        acc[ai][bj][m][n] = __builtin_amdgcn_mfma_f32_16x16x32_bf16(Bt[n][k], At[m][k], acc[ai][bj][m][n], 0, 0, 0); __builtin_amdgcn_s_setprio(0); } while (0)
#define PG8_WAIT_V(n) asm volatile("s_waitcnt vmcnt(" #n ")" ::: "memory")
#define PG8_WAIT_L(n) asm volatile("s_waitcnt lgkmcnt(" #n ")" ::: "memory")
#define PG8_BAR __builtin_amdgcn_s_barrier()
#define PG8_SCHED __builtin_amdgcn_sched_barrier(0)
    Unit cur, nxt; int ui = 0;
    if (!S.next(0, cur)) return;
    f32x4 acc[2][2][4][2];
#pragma unroll
    for (int a = 0; a < 2; ++a)
#pragma unroll
        for (int b = 0; b < 2; ++b)
#pragma unroll
            for (int m = 0; m < 4; ++m)
#pragma unroll
                for (int n = 0; n < 2; ++n) acc[a][b][m][n] = (f32x4){0.f, 0.f, 0.f, 0.f};
    bf16x8 At[4][2], B0[2][2], B1[2][2];
    const char* cA = (const char*)g.A + (size_t)cur.pm * tstep; const char* cB = (const char*)g.Bt + (size_t)cur.pn * tstep;
    S.a_ready(cur);
    if constexpr (SP2) {
        PG8_STAGE(PG8_SB(0, 0), cB, voffB); PG8_STAGE(PG8_SB(0, 1), cB + hstep, voffB); PG8_STAGE(PG8_SA(0, 0), cA, voffA); PG8_STAGE(PG8_SA(0, 1), cA + hstep, voffA);
        if (wr == 1) PG8_BAR;
        PG8_WAIT_V(2); PG8_BAR;
        PG8_STAGE(PG8_SB(1, 0), cB + kstep, voffB); PG8_STAGE(PG8_SA(1, 0), cA + kstep, voffA); PG8_STAGE(PG8_SB(1, 1), cB + hstep + kstep, voffB);
        PG8_WAIT_V(6); PG8_BAR;
    } else {
        PG8_STAGE(PG8_SB(0, 0), cB, voffB); PG8_STAGE(PG8_SA(0, 0), cA, voffA); PG8_STAGE(PG8_SB(0, 1), cB + hstep, voffB); PG8_STAGE(PG8_SA(0, 1), cA + hstep, voffA);
        if (wr == 1) PG8_BAR;
        PG8_WAIT_V(4); PG8_BAR;
        PG8_STAGE(PG8_SB(1, 0), cB + kstep, voffB); PG8_STAGE(PG8_SA(1, 0), cA + kstep, voffA); PG8_STAGE(PG8_SB(1, 1), cB + hstep + kstep, voffB);
        PG8_WAIT_V(6); PG8_BAR;
    }
    for (;;) {
        const bool has_next = S.next(ui + 1, nxt);
        const char* nA = has_next ? (const char*)g.A + (size_t)nxt.pm * tstep : cA; const char* nB = has_next ? (const char*)g.Bt + (size_t)nxt.pn * tstep : cB;
        for (int t = 0; t < nt; t += 2) {
            const bool last = (t == nt - 2);
            const char* a1 = cA + (size_t)(t + 1) * kstep;
            const char* a2 = last ? nA : cA + (size_t)(t + 2) * kstep; const char* b2 = last ? nB : cB + (size_t)(t + 2) * kstep;
            const char* a3 = a2 + kstep; const char* b3 = b2 + kstep;
            if (last && has_next) S.a_ready(nxt);
            if constexpr (SP2) {
            PG8_LDB(B0, 0, 0); PG8_LDB(B1, 0, 1); PG8_SCHED; PG8_LDA(At, 0, 0); PG8_STAGE(PG8_SA(1, 1), a1 + hstep, voffA);
            PG8_WAIT_V(8); PG8_WAIT_L(0); PG8_BAR; PG8_MMA(0, 0, At, B0); PG8_MMA(0, 1, At, B1); PG8_BAR; PG8_SCHED;
            PG8_LDA(At, 0, 1); PG8_STAGE(PG8_SB(0, 0), b2, voffB); PG8_STAGE(PG8_SB(0, 1), b2 + hstep, voffB); PG8_STAGE(PG8_SA(0, 0), a2, voffA);
            PG8_WAIT_V(8); PG8_WAIT_L(0); PG8_BAR; PG8_MMA(1, 0, At, B0); PG8_MMA(1, 1, At, B1); PG8_BAR; PG8_SCHED;
            PG8_LDB(B0, 1, 0); PG8_LDB(B1, 1, 1); PG8_SCHED; PG8_LDA(At, 1, 0); PG8_STAGE(PG8_SA(0, 1), a2 + hstep, voffA);
            PG8_WAIT_V(8); PG8_WAIT_L(0); PG8_BAR; PG8_MMA(0, 0, At, B0); PG8_MMA(0, 1, At, B1); PG8_BAR; PG8_SCHED;
            PG8_LDA(At, 1, 1); PG8_STAGE(PG8_SB(1, 0), b3, voffB); PG8_STAGE(PG8_SB(1, 1), b3 + hstep, voffB); PG8_STAGE(PG8_SA(1, 0), a3, voffA);
            PG8_WAIT_V(8); PG8_WAIT_L(0); PG8_BAR; PG8_MMA(1, 0, At, B0); PG8_MMA(1, 1, At, B1); PG8_BAR; PG8_SCHED;
            } else {
            PG8_LDB(B0, 0, 0); PG8_SCHED; PG8_LDA(At, 0, 0); PG8_STAGE(PG8_SA(1, 1), a1 + hstep, voffA);
            PG8_WAIT_L(8); PG8_BAR; PG8_WAIT_L(0); PG8_MMA(0, 0, At, B0); PG8_BAR; PG8_SCHED;
            PG8_LDB(B1, 0, 1); PG8_STAGE(PG8_SB(0, 0), b2, voffB);
            PG8_BAR; PG8_WAIT_L(0); PG8_MMA(0, 1, At, B1); PG8_BAR;
            PG8_LDA(At, 0, 1); PG8_STAGE(PG8_SA(0, 0), a2, voffA);
            PG8_BAR; PG8_WAIT_L(0); PG8_MMA(1, 0, At, B0); PG8_BAR; PG8_SCHED;
            PG8_STAGE(PG8_SB(0, 1), b2 + hstep, voffB);
            PG8_WAIT_V(6); PG8_BAR; PG8_MMA(1, 1, At, B1); PG8_BAR;
            PG8_LDB(B0, 1, 0); PG8_SCHED; PG8_LDA(At, 1, 0); PG8_STAGE(PG8_SA(0, 1), a2 + hstep, voffA);
            PG8_WAIT_L(8); PG8_BAR; PG8_WAIT_L(0); PG8_MMA(0, 0, At, B0); PG8_BAR; PG8_SCHED;
            PG8_LDB(B1, 1, 1); PG8_STAGE(PG8_SB(1, 0), b3, voffB);
            PG8_BAR; PG8_WAIT_L(0); PG8_MMA(0, 1, At, B1); PG8_BAR;
            PG8_LDA(At, 1, 1); PG8_STAGE(PG8_SA(1, 0), a3, voffA);
            PG8_BAR; PG8_WAIT_L(0); PG8_MMA(1, 0, At, B0); PG8_BAR; PG8_SCHED;
            PG8_STAGE(PG8_SB(1, 1), b3 + hstep, voffB);
            PG8_WAIT_V(6); PG8_BAR; PG8_MMA(1, 1, At, B1); PG8_BAR;
            }
        }
        if constexpr (ALIGN_EPI) { if (wr == 0) PG8_BAR; }
        if constexpr (!Epi::AFTER_DRAIN) { E(acc, cur, wr, wc, fr, fq); S.done(cur); }
        if (!has_next) break;
#pragma unroll
        for (int a = 0; a < 2; ++a)
#pragma unroll
            for (int b = 0; b < 2; ++b)
#pragma unroll
                for (int m = 0; m < 4; ++m)
#pragma unroll
                    for (int n = 0; n < 2; ++n) acc[a][b][m][n] = (f32x4){0.f, 0.f, 0.f, 0.f};
        cur = nxt; cA = nA; cB = nB; ++ui;
        if constexpr (ALIGN_EPI) { if (wr == 1) PG8_BAR; }
    }
    PG8_WAIT_V(0);
    if constexpr (!ALIGN_EPI) { if (wr == 0) PG8_BAR; }
    PG8_BAR;
    if constexpr (Epi::AFTER_DRAIN) { E.fused(acc, cur, wr, wc, fr, fq, lds, wid, lane); S.done(cur); }
#undef PG8_SA
#undef PG8_SB
#undef PG8_STAGE
#undef PG8_LDA
#undef PG8_LDB
#undef PG8_MMA
#undef PG8_WAIT_V
#undef PG8_WAIT_L
#undef PG8_BAR
#undef PG8_SCHED
}
}

#ifndef MK_N_LAUNCHES
#define MK_N_LAUNCHES 1
#endif
constexpr int NB = 4, SEQ = 8192, T = NB * SEQ, D = 1024, NIN = 6664, NP1 = 6656, FF = 4096, PLE = 256;
constexpr int NCH = SEQ / 64;
constexpr int CROWS = 272;
constexpr float EPS = 1e-6f;
constexpr int NPHASE = 11;
typedef pg8::bf16_t bf16_t;
typedef pg8::bf16x8 bf16x8;
typedef pg8::f32x4 f32x4;
typedef pg8::u32x4 u32x4;
typedef unsigned u32x2 __attribute__((ext_vector_type(2)));
#define LAS __attribute__((address_space(3)))

constexpr size_t MiB = 1u << 20;
constexpr size_t O_WIN = 0, O_WA = 13 * MiB, O_WB = 15 * MiB, O_WOUT = 17 * MiB, O_WG = 19 * MiB, O_WUP = 21 * MiB, O_WDN = 29 * MiB, O_WP = 37 * MiB;
constexpr size_t O_GWH = 37 * MiB + 512 * 1024, O_CBL = O_GWH + 256 * 1024, O_CMW = O_CBL + 8192, O_CAMAX = O_CMW + 8192, O_CM = O_CAMAX + 8192, O_CTR = O_CM + 8192, O_BAR = O_CTR + 256, O_TS = O_BAR + 256, O_DUMMY = O_TS + 1024, O_XBAR = 39 * MiB;
constexpr size_t O_QK = 40 * MiB, O_VML = 104 * MiB, O_VSW = 168 * MiB, O_KSW = 184 * MiB, O_OML = 200 * MiB, O_QSW = 264 * MiB, O_GA = 328 * MiB, O_GB = 392 * MiB;
constexpr size_t O_KT = 456 * MiB, O_VTSW = 488 * MiB, O_SSQ1 = 504 * MiB, O_SSQ2 = 506 * MiB, O_SSQ3 = 508 * MiB;
constexpr size_t O_GIG = 510 * MiB, O_GLF = O_GIG + 512 * 1024, O_GBC = 511 * MiB, O_GL = O_GBC + 512 * 1024;
constexpr size_t O_CST = 40 * MiB;
constexpr size_t O_MERGED = 40 * MiB, O_X1B = 104 * MiB, O_ACT = 200 * MiB, O_X2B = 40 * MiB, O_PB = 456 * MiB, O_PP = 104 * MiB, O_X3B = 200 * MiB;
constexpr size_t WS_NEED = 512 * MiB;
constexpr size_t OO_H = 0, OO_QKP = 0, OO_VT = 64 * MiB;
constexpr int LDS_BYTES = 147456;

__device__ __forceinline__ int lane_id() { int l; asm volatile("v_mbcnt_lo_u32_b32 %0, -1, 0\n\tv_mbcnt_hi_u32_b32 %0, -1, %0" : "=v"(l)); return l; }
__device__ __forceinline__ unsigned pk2(float lo, float hi) { return pg8::cvt_pk_bf16(lo, hi); }
__device__ __forceinline__ float bflo(unsigned w) { return __builtin_bit_cast(float, w << 16); }
__device__ __forceinline__ float bfhi(unsigned w) { return __builtin_bit_cast(float, w & 0xffff0000u); }
__device__ __forceinline__ float sigm(float x) { return __builtin_amdgcn_rcpf(1.f + __expf(-x)); }
__device__ __forceinline__ float wave_sum(float v) {
#pragma unroll
    for (int o = 1; o < 64; o <<= 1) v += __shfl_xor(v, o);
    return v;
}
__device__ __forceinline__ float wave_max(float v) {
#pragma unroll
    for (int o = 1; o < 64; o <<= 1) v = fmaxf(v, __shfl_xor(v, o));
    return v;
}
__device__ __forceinline__ bf16x8 ld8(const bf16_t* p) { return *(const bf16x8*)p; }
__device__ __forceinline__ f32x4 mfma16(bf16x8 a, bf16x8 b, f32x4 c) { return __builtin_amdgcn_mfma_f32_16x16x32_bf16(a, b, c, 0, 0, 0); }
__device__ __forceinline__ bf16x8 scale8(bf16x8 v, float s) {
    u32x4 u = __builtin_bit_cast(u32x4, v), o;
    o.x = pk2(bflo(u.x) * s, bfhi(u.x) * s); o.y = pk2(bflo(u.y) * s, bfhi(u.y) * s); o.z = pk2(bflo(u.z) * s, bfhi(u.z) * s); o.w = pk2(bflo(u.w) * s, bfhi(u.w) * s);
    return __builtin_bit_cast(bf16x8, o);
}
__device__ __forceinline__ size_t tpos(int row, int s) { return (size_t)row * SEQ + (size_t)(((((s >> 6) + row) & 127) << 6) + (s & 63)); }
__device__ __forceinline__ void st16_nt(void* p, u32x4 v) { asm volatile("global_store_dwordx4 %0, %1, off nt" :: "v"(p), "v"(v) : "memory"); }
__device__ __forceinline__ float rdlane(float v, int l) { return __builtin_bit_cast(float, __builtin_amdgcn_readlane(__builtin_bit_cast(int, v), l)); }

#define EPI_LOOP_BEGIN const int row0 = u.pm * 256 + wr * 64 + fr, col0 = u.pn * 256 + wc * 32 + 8 * fq; \
    _Pragma("unroll") for (int ai = 0; ai < 2; ++ai) _Pragma("unroll") for (int m = 0; m < 4; ++m) { const int row = row0 + ai * 128 + m * 16;
#define EPI_LOOP_END }
typedef pg8::Unit Unit;

struct EpiSeg {
    static constexpr bool PERM = true, AFTER_DRAIN = false;
    unsigned char* ws;
    __device__ __forceinline__ void operator()(const f32x4 (&acc)[2][2][4][2], const Unit& u, int wr, int wc, int fr, int fq) const {
        const int pn = u.pn; size_t off; int ldc, ct;
        if (pn < 4) { off = O_QK; ldc = 1024; ct = pn; } else if (pn < 8) { off = O_VML; ldc = 1024; ct = pn - 4; } else if (pn < 12) { off = O_OML; ldc = 1024; ct = pn - 8; }
        else if (pn < 16) { off = O_QSW; ldc = 1024; ct = pn - 12; } else if (pn < 17) { off = O_KSW; ldc = 256; ct = 0; } else if (pn < 18) { off = O_VSW; ldc = 256; ct = 0; }
        else if (pn < 22) { off = O_GA; ldc = 1024; ct = pn - 18; } else { off = O_GB; ldc = 1024; ct = pn - 22; }
        bf16_t* base = (bf16_t*)(ws + off) + ct * 256 + wc * 32 + 8 * fq;
        const int row0 = u.pm * 256 + wr * 64 + fr;
#pragma unroll
        for (int ai = 0; ai < 2; ++ai)
#pragma unroll
            for (int m = 0; m < 4; ++m) { bf16_t* rowp = base + (size_t)(row0 + ai * 128 + m * 16) * ldc;
#pragma unroll
                for (int bj = 0; bj < 2; ++bj) { const f32x4 v0 = acc[ai][bj][m][0], v1 = acc[ai][bj][m][1]; u32x4 w;
                    w.x = pk2(v0[0], v0[1]); w.y = pk2(v0[2], v0[3]); w.z = pk2(v1[0], v1[1]); w.w = pk2(v1[2], v1[3]); *(u32x4*)(rowp + bj * 128) = w; } }
    }
};
struct EpiPlain {
    static constexpr bool PERM = true, AFTER_DRAIN = false;
    bf16_t* O; int ldc;
    __device__ __forceinline__ void operator()(const f32x4 (&acc)[2][2][4][2], const Unit& u, int wr, int wc, int fr, int fq) const {
        EPI_LOOP_BEGIN
#pragma unroll
            for (int bj = 0; bj < 2; ++bj) { const f32x4 v0 = acc[ai][bj][m][0], v1 = acc[ai][bj][m][1]; u32x4 w;
                w.x = pk2(v0[0], v0[1]); w.y = pk2(v0[2], v0[3]); w.z = pk2(v1[0], v1[1]); w.w = pk2(v1[2], v1[3]); *(u32x4*)(O + (size_t)row * ldc + col0 + bj * 128) = w; }
        EPI_LOOP_END
    }
};
#define EPI_ROWCOL const int row0 = u.pm * 256 + wr * 64 + fr, col0 = u.pn * 256 + wc * 32 + 8 * fq;
struct EpiGateA {
    static constexpr bool PERM = true, AFTER_DRAIN = false;
    const bf16_t* G; bf16_t* M1;
    __device__ __forceinline__ void operator()(const f32x4 (&acc)[2][2][4][2], const Unit& u, int wr, int wc, int fr, int fq) const {
        EPI_ROWCOL
#pragma unroll
        for (int ai = 0; ai < 2; ++ai)
#pragma unroll
          for (int mh = 0; mh < 2; ++mh) { u32x4 g[2][2];
#pragma unroll
            for (int mm = 0; mm < 2; ++mm)
#pragma unroll
                for (int bj = 0; bj < 2; ++bj) g[mm][bj] = *(const u32x4*)(G + (size_t)(row0 + ai * 128 + (2 * mh + mm) * 16) * D + col0 + bj * 128);
#pragma unroll
            for (int mm = 0; mm < 2; ++mm)
#pragma unroll
                for (int bj = 0; bj < 2; ++bj) { const int m = 2 * mh + mm; const size_t idx = (size_t)(row0 + ai * 128 + m * 16) * D + col0 + bj * 128; const u32x4 gv = g[mm][bj];
                    const f32x4 v0 = acc[ai][bj][m][0], v1 = acc[ai][bj][m][1]; f32x4 o0, o1;
                    o0[0] = sigm(bflo(gv.x)) * v0[0]; o0[1] = sigm(bfhi(gv.x)) * v0[1]; o0[2] = sigm(bflo(gv.y)) * v0[2]; o0[3] = sigm(bfhi(gv.y)) * v0[3];
                    o1[0] = sigm(bflo(gv.z)) * v1[0]; o1[1] = sigm(bfhi(gv.z)) * v1[1]; o1[2] = sigm(bflo(gv.w)) * v1[2]; o1[3] = sigm(bfhi(gv.w)) * v1[3];
                    u32x4 w; w.x = pk2(o0[0], o0[1]); w.y = pk2(o0[2], o0[3]); w.z = pk2(o1[0], o1[1]); w.w = pk2(o1[2], o1[3]); *(u32x4*)(M1 + idx) = w; } }
    }
};
struct EpiGateB {
    static constexpr bool PERM = true, AFTER_DRAIN = false;
    const bf16_t* G; const bf16_t* M1; bf16_t* O;
    __device__ __forceinline__ void operator()(const f32x4 (&acc)[2][2][4][2], const Unit& u, int wr, int wc, int fr, int fq) const {
        EPI_ROWCOL
#pragma unroll
        for (int ai = 0; ai < 2; ++ai)
#pragma unroll
            for (int mh = 0; mh < 2; ++mh) { u32x4 g[2][2], am[2][2];
#pragma unroll
                for (int mm = 0; mm < 2; ++mm)
#pragma unroll
                    for (int bj = 0; bj < 2; ++bj) { const size_t idx = (size_t)(row0 + ai * 128 + (2 * mh + mm) * 16) * D + col0 + bj * 128;
                        g[mm][bj] = *(const u32x4*)(G + idx); am[mm][bj] = *(const u32x4*)(M1 + idx); }
#pragma unroll
                for (int mm = 0; mm < 2; ++mm)
#pragma unroll
                    for (int bj = 0; bj < 2; ++bj) { const int m = 2 * mh + mm; const size_t idx = (size_t)(row0 + ai * 128 + m * 16) * D + col0 + bj * 128; const u32x4 gv = g[mm][bj];
                        const f32x4 v0 = acc[ai][bj][m][0], v1 = acc[ai][bj][m][1]; const u32x4 mv = am[mm][bj]; const f32x4 b0 = {bflo(mv.x), bfhi(mv.x), bflo(mv.y), bfhi(mv.y)}, b1 = {bflo(mv.z), bfhi(mv.z), bflo(mv.w), bfhi(mv.w)}; u32x4 w;
                        w.x = pk2(b0[0] + sigm(bflo(gv.x)) * v0[0], b0[1] + sigm(bfhi(gv.x)) * v0[1]); w.y = pk2(b0[2] + sigm(bflo(gv.y)) * v0[2], b0[3] + sigm(bfhi(gv.y)) * v0[3]);
                        w.z = pk2(b1[0] + sigm(bflo(gv.z)) * v1[0], b1[1] + sigm(bfhi(gv.z)) * v1[1]); w.w = pk2(b1[2] + sigm(bflo(gv.w)) * v1[2], b1[3] + sigm(bfhi(gv.w)) * v1[3]);
                        *(u32x4*)(O + idx) = w; } }
    }
};
template <bool XBF> struct EpiRes {
    static constexpr bool PERM = true, AFTER_DRAIN = false;
    const void* XI; bf16_t* XB; float* SSQ;
    __device__ __forceinline__ void operator()(const f32x4 (&acc)[2][2][4][2], const Unit& u, int wr, int wc, int fr, int fq) const {
        EPI_ROWCOL
#pragma unroll
        for (int ai = 0; ai < 2; ++ai)
#pragma unroll
          for (int mh = 0; mh < 2; ++mh) { f32x4 x0[2][2], x1[2][2];
#pragma unroll
            for (int mm = 0; mm < 2; ++mm)
#pragma unroll
                for (int bj = 0; bj < 2; ++bj) { const size_t idx = (size_t)(row0 + ai * 128 + (2 * mh + mm) * 16) * D + col0 + bj * 128;
                    if (XBF) { const u32x4 v = *(const u32x4*)((const bf16_t*)XI + idx); x0[mm][bj] = (f32x4){bflo(v.x), bfhi(v.x), bflo(v.y), bfhi(v.y)}; x1[mm][bj] = (f32x4){bflo(v.z), bfhi(v.z), bflo(v.w), bfhi(v.w)}; }
                    else { x0[mm][bj] = *(const f32x4*)((const float*)XI + idx); x1[mm][bj] = *(const f32x4*)((const float*)XI + idx + 4); } }
#pragma unroll
            for (int mm = 0; mm < 2; ++mm) { const int m = 2 * mh + mm, row = row0 + ai * 128 + m * 16; float ss = 0.f;
#pragma unroll
                for (int bj = 0; bj < 2; ++bj) { const size_t idx = (size_t)row * D + col0 + bj * 128;
                    const f32x4 o0 = x0[mm][bj] + acc[ai][bj][m][0], o1 = x1[mm][bj] + acc[ai][bj][m][1];
                    u32x4 w; w.x = pk2(o0[0], o0[1]); w.y = pk2(o0[2], o0[3]); w.z = pk2(o1[0], o1[1]); w.w = pk2(o1[2], o1[3]); *(u32x4*)(XB + idx) = w;
                    ss += (o0[0] * o0[0] + o0[1] * o0[1]) + (o0[2] * o0[2] + o0[3] * o0[3]) + (o1[0] * o1[0] + o1[1] * o1[1]) + (o1[2] * o1[2] + o1[3] * o1[3]); }
                ss += __shfl_xor(ss, 16); ss += __shfl_xor(ss, 32);
                if (fq == 0) SSQ[(size_t)row * 16 + u.pn * 4 + wc] = ss; } }
    }
};
__device__ __forceinline__ float row_rstd(const float* SSQ, int row) {
    const f32x4* p = (const f32x4*)(SSQ + (size_t)row * 16); const f32x4 a = p[0], b = p[1], c = p[2], d = p[3];
    const float s = ((a[0] + a[1]) + (a[2] + a[3])) + ((b[0] + b[1]) + (b[2] + b[3])) + ((c[0] + c[1]) + (c[2] + c[3])) + ((d[0] + d[1]) + (d[2] + d[3]));
    return rsqrtf(s * (1.f / D) + EPS);
}
__device__ __forceinline__ float row_rstd4(const float* SSQ, int row, int fq) {
    const f32x4 a = ((const f32x4*)(SSQ + (size_t)row * 16))[fq]; float s = (a[0] + a[1]) + (a[2] + a[3]);
    s += __shfl_xor(s, 16); s += __shfl_xor(s, 32);
    return rsqrtf(s * (1.f / D) + EPS);
}
struct EpiUp {
    static constexpr bool PERM = true, AFTER_DRAIN = false;
    const float* SSQ; bf16_t* O;
    __device__ __forceinline__ void operator()(const f32x4 (&acc)[2][2][4][2], const Unit& u, int wr, int wc, int fr, int fq) const {
        EPI_ROWCOL
        float rsv[2][4];
#pragma unroll
        for (int ai = 0; ai < 2; ++ai)
#pragma unroll
            for (int m = 0; m < 4; ++m) rsv[ai][m] = row_rstd4(SSQ, row0 + ai * 128 + m * 16, fq);
#pragma unroll
        for (int ai = 0; ai < 2; ++ai)
#pragma unroll
            for (int m = 0; m < 4; ++m) { const int row = row0 + ai * 128 + m * 16; const float rs = rsv[ai][m];
#pragma unroll
                for (int bj = 0; bj < 2; ++bj) { f32x4 v0 = acc[ai][bj][m][0] * rs, v1 = acc[ai][bj][m][1] * rs;
#pragma unroll
                    for (int e = 0; e < 4; ++e) { const float a = fmaxf(v0[e], 0.f), b = fmaxf(v1[e], 0.f); v0[e] = a * a; v1[e] = b * b; }
                    u32x4 w; w.x = pk2(v0[0], v0[1]); w.y = pk2(v0[2], v0[3]); w.z = pk2(v1[0], v1[1]); w.w = pk2(v1[2], v1[3]); *(u32x4*)(O + (size_t)row * FF + col0 + bj * 128) = w; } }
    }
};
struct EpiPle {
    static constexpr bool PERM = true, AFTER_DRAIN = false;
    const float* SSQI; const bf16_t* PP; const bf16_t* XR; bf16_t* X; float* SSQO;
    __device__ __forceinline__ void operator()(const f32x4 (&acc)[2][2][4][2], const Unit& u, int wr, int wc, int fr, int fq) const {
        EPI_ROWCOL
        float rsv[2][4];
#pragma unroll
        for (int ai = 0; ai < 2; ++ai)
#pragma unroll
            for (int m = 0; m < 4; ++m) rsv[ai][m] = row_rstd4(SSQI, row0 + ai * 128 + m * 16, fq);
#pragma unroll
        for (int ai = 0; ai < 2; ++ai)
#pragma unroll
            for (int mh = 0; mh < 2; ++mh) { u32x4 pv[2][2], xv[2][2];
#pragma unroll
                for (int mm = 0; mm < 2; ++mm)
#pragma unroll
                    for (int bj = 0; bj < 2; ++bj) { const size_t idx = (size_t)(row0 + ai * 128 + (2 * mh + mm) * 16) * D + col0 + bj * 128;
                        pv[mm][bj] = *(const u32x4*)(PP + idx); xv[mm][bj] = *(const u32x4*)(XR + idx); }
#pragma unroll
                for (int mm = 0; mm < 2; ++mm) { const int m = 2 * mh + mm, row = row0 + ai * 128 + m * 16; const float rs = rsv[ai][m]; float ss = 0.f;
#pragma unroll
                    for (int bj = 0; bj < 2; ++bj) { const size_t idx = (size_t)row * D + col0 + bj * 128; const u32x4 p = pv[mm][bj];
                        const f32x4 v0 = acc[ai][bj][m][0] * rs, v1 = acc[ai][bj][m][1] * rs; const u32x4 xr = xv[mm][bj]; f32x4 o0 = {bflo(xr.x), bfhi(xr.x), bflo(xr.y), bfhi(xr.y)}, o1 = {bflo(xr.z), bfhi(xr.z), bflo(xr.w), bfhi(xr.w)};
                        o0[0] += sigm(v0[0]) * bflo(p.x); o0[1] += sigm(v0[1]) * bfhi(p.x); o0[2] += sigm(v0[2]) * bflo(p.y); o0[3] += sigm(v0[3]) * bfhi(p.y);
                        o1[0] += sigm(v1[0]) * bflo(p.z); o1[1] += sigm(v1[1]) * bfhi(p.z); o1[2] += sigm(v1[2]) * bflo(p.w); o1[3] += sigm(v1[3]) * bfhi(p.w);
                        { u32x4 w; w.x = pk2(o0[0], o0[1]); w.y = pk2(o0[2], o0[3]); w.z = pk2(o1[0], o1[1]); w.w = pk2(o1[2], o1[3]); *(u32x4*)(X + idx) = w; }
                        ss += (o0[0] * o0[0] + o0[1] * o0[1]) + (o0[2] * o0[2] + o0[3] * o0[3]) + (o1[0] * o1[0] + o1[1] * o1[1]) + (o1[2] * o1[2] + o1[3] * o1[3]); }
                    ss += __shfl_xor(ss, 16); ss += __shfl_xor(ss, 32);
                    if (fq == 0) SSQO[(size_t)row * 16 + u.pn * 4 + wc] = ss; } }
    }
};

template <class Epi> __device__ __forceinline__ void run_gemm(LAS unsigned char* lds, int wave, const bf16_t* A, const bf16_t* Bt, int M, int N, int K, const Epi& E) {
    pg8::Gemm g{A, Bt, M, N, K}; pg8::StaticOrder S; S.init(M, N, (int)gridDim.x, (int)blockIdx.x);
    pg8::gemm_phase<Epi, pg8::StaticOrder, true, true>(lds, g, S, E, wave);
}

__device__ __forceinline__ void p0_transpose_item(const float* W, int ldw, int K, int nblk, bf16_t* WT, const float* ksc, LAS float* scr, int item, int lane) {
    const int kb = item / nblk, nb = item % nblk, k0 = 64 * kb, n0 = 32 * nb;
#pragma unroll 8
    for (int i = 0; i < 32; ++i) { const int kk = 2 * i + (lane >> 5); float v = W[(size_t)(k0 + kk) * ldw + n0 + (lane & 31)]; if (ksc) v *= ksc[k0 + kk]; scr[kk * 33 + (lane & 31)] = v; }
    asm volatile("s_waitcnt lgkmcnt(0)" ::: "memory");
    const int c = lane & 7;
#pragma unroll
    for (int j = 0; j < 4; ++j) { const int n = (lane >> 3) + 8 * j; const LAS float* s = scr + (8 * c) * 33 + n;
        u32x4 o; o.x = pk2(s[0 * 33], s[1 * 33]); o.y = pk2(s[2 * 33], s[3 * 33]); o.z = pk2(s[4 * 33], s[5 * 33]); o.w = pk2(s[6 * 33], s[7 * 33]);
        *(u32x4*)(WT + (size_t)(n0 + n) * K + k0 + 8 * c) = o; }
    asm volatile("s_waitcnt lgkmcnt(0)" ::: "memory");
}
__device__ __forceinline__ float logsigmoid(float z) { return fminf(z, 0.f) - log1pf(__expf(-fabsf(z))); }

struct Args { const float* in[18]; float* out; unsigned char* ws; int ph_lo, ph_hi; };

__device__ __forceinline__ void phase0(const Args& a, LAS unsigned char* lds, int wave) {
    const int lane = lane_id();
    unsigned char* ws = a.ws;
    LAS float* scr = (LAS float*)(lds + wave * 16384);
    const int gw = blockIdx.x * 8 + wave, NGW = gridDim.x * 8;
    if (blockIdx.x == 0 && wave == 0 && lane == 0) *(unsigned*)(ws + O_CTR) = 0u;
    constexpr int I_IN1 = 16 * 96, I_IN2 = 16 * 112, I_SQ = 16 * 32, I_UP = 16 * 128, I_DN = 64 * 32, I_P = 4 * 32;
    constexpr int NITEMS = I_IN1 + I_IN2 + 4 * I_SQ + I_UP + I_DN + I_P;
    const float* w_in = a.in[3];
    for (int it = gw; it < NITEMS; it += NGW) {
        int r = it;
        if (r < I_IN1) { p0_transpose_item(w_in, NIN, D, 96, (bf16_t*)(ws + O_WIN), nullptr, scr, r, lane); continue; } r -= I_IN1;
        if (r < I_IN2) { p0_transpose_item(w_in + 3080, NIN, D, 112, (bf16_t*)(ws + O_WIN) + (size_t)3072 * D, nullptr, scr, r, lane); continue; } r -= I_IN2;
        if (r < I_SQ) { p0_transpose_item(a.in[8], D, D, 32, (bf16_t*)(ws + O_WA), nullptr, scr, r, lane); continue; } r -= I_SQ;
        if (r < I_SQ) { p0_transpose_item(a.in[9], D, D, 32, (bf16_t*)(ws + O_WB), nullptr, scr, r, lane); continue; } r -= I_SQ;
        if (r < I_SQ) { p0_transpose_item(a.in[10], D, D, 32, (bf16_t*)(ws + O_WOUT), nullptr, scr, r, lane); continue; } r -= I_SQ;
        if (r < I_SQ) { p0_transpose_item(a.in[15], D, D, 32, (bf16_t*)(ws + O_WG), a.in[14], scr, r, lane); continue; } r -= I_SQ;
        if (r < I_UP) { p0_transpose_item(a.in[12], FF, D, 128, (bf16_t*)(ws + O_WUP), a.in[11], scr, r, lane); continue; } r -= I_UP;
        if (r < I_DN) { p0_transpose_item(a.in[13], D, FF, 32, (bf16_t*)(ws + O_WDN), nullptr, scr, r, lane); continue; } r -= I_DN;
        p0_transpose_item(a.in[16], D, PLE, 32, (bf16_t*)(ws + O_WP), nullptr, scr, r, lane);
    }
    const float* x = a.in[0]; const float* g = a.in[2]; const float* bif = a.in[5];
    __syncthreads();
    LAS float* wgT = (LAS float*)lds;
    { const int t = wave * 64 + lane;
#pragma unroll
      for (int i = 0; i < 2; ++i) { const int k = 2 * t + i; const f32x4* wr = (const f32x4*)(w_in + (size_t)k * NIN + 3072); const f32x4 w0 = wr[0], w1 = wr[1];
          wgT[0 * 1024 + k] = w0[0]; wgT[1 * 1024 + k] = w0[1]; wgT[2 * 1024 + k] = w0[2]; wgT[3 * 1024 + k] = w0[3]; wgT[4 * 1024 + k] = w1[0]; wgT[5 * 1024 + k] = w1[1]; wgT[6 * 1024 + k] = w1[2]; wgT[7 * 1024 + k] = w1[3]; } }
    __syncthreads();
    bf16_t* H = (bf16_t*)((unsigned char*)a.out + OO_H);
    float* gig = (float*)(ws + O_GIG); float* glf = (float*)(ws + O_GLF);
    f32x4 vv[2][4];
#define P0_LOAD(VV, row_) do { _Pragma("unroll") for (int k = 0; k < 2; ++k) { int r = (row_) + k * NGW; r = r < T ? r : T - 1; const f32x4* xr = (const f32x4*)(x + (size_t)r * D) + lane; \
            _Pragma("unroll") for (int j = 0; j < 4; ++j) VV[k][j] = xr[64 * j]; } } while (0)
    P0_LOAD(vv, gw);
    for (int rowp = gw; rowp < T; rowp += 2 * NGW) {
        f32x4 vn[2][4];
        P0_LOAD(vn, rowp + 2 * NGW);
#pragma unroll
        for (int k = 0; k < 2; ++k) { const int row = rowp + k * NGW; const f32x4* gr = (const f32x4*)g + lane;
        float s = 0.f;
#pragma unroll
        for (int j = 0; j < 4; ++j) { const f32x4 v = vv[k][j]; s += (v[0] * v[0] + v[1] * v[1]) + (v[2] * v[2] + v[3] * v[3]); }
        const float rstd = rsqrtf(wave_sum(s) * (1.f / D) + EPS);
        float g8[8];
#pragma unroll
        for (int e = 0; e < 8; ++e) g8[e] = 0.f;
        u32x2* o8 = (u32x2*)(H + (size_t)row * D) + lane;
#pragma unroll
        for (int j = 0; j < 4; ++j) { const f32x4 hv = vv[k][j] * rstd * gr[64 * j]; u32x2 o; o.x = pk2(hv[0], hv[1]); o.y = pk2(hv[2], hv[3]); o8[64 * j] = o;
#pragma unroll
            for (int c = 0; c < 8; ++c) { const f32x4 w4 = *(const LAS f32x4*)(wgT + c * 1024 + 4 * lane + 256 * j); g8[c] += (hv[0] * w4[0] + hv[1] * w4[1]) + (hv[2] * w4[2] + hv[3] * w4[3]); } }
#pragma unroll
        for (int e = 0; e < 8; ++e) g8[e] = wave_sum(g8[e]);
        if (lane == 0) { const int b = row / SEQ, s_ = row % SEQ;
#pragma unroll
            for (int hh = 0; hh < 4; ++hh) { gig[(size_t)(b * 4 + hh) * SEQ + s_] = g8[hh] + bif[hh]; glf[(size_t)(b * 4 + hh) * SEQ + s_] = logsigmoid(g8[4 + hh] + bif[4 + hh]); } }
        }
#pragma unroll
        for (int k = 0; k < 2; ++k)
#pragma unroll
            for (int j = 0; j < 4; ++j) vv[k][j] = vn[k][j];
    }
#undef P0_LOAD
}

__device__ __forceinline__ void gate_chunk(float lf, float ig, int lane, float& b, float& av, float& amax, float& pm) {
    float v = lf;
#pragma unroll
    for (int o = 1; o < 64; o <<= 1) { const float t = __shfl_up(v, o); if (lane >= o) v += t; }
    b = v; av = ig - v; float q = av;
#pragma unroll
    for (int o = 1; o < 64; o <<= 1) { const float t = __shfl_up(q, o); if (lane >= o) q = fmaxf(q, t); }
    pm = q; amax = wave_max(av);
}
__device__ __forceinline__ void phase2(const Args& a, LAS unsigned char* lds, int wave) {
    const int lane = lane_id();
    unsigned char* ws = a.ws;
    LAS unsigned* tile = (LAS unsigned*)(lds + wave * 16384);
    LAS unsigned short* tile16 = (LAS unsigned short*)tile;
    const int gw = blockIdx.x * 8 + wave, NGW = gridDim.x * 8;
    const bf16_t* QK = (const bf16_t*)(ws + O_QK); const bf16_t* VML = (const bf16_t*)(ws + O_VML); const bf16_t* VSW = (const bf16_t*)(ws + O_VSW);
    bf16_t* QKP = (bf16_t*)((unsigned char*)a.out + OO_QKP); bf16_t* VT = (bf16_t*)((unsigned char*)a.out + OO_VT);
    bf16_t* KT = (bf16_t*)(ws + O_KT); bf16_t* VTSW = (bf16_t*)(ws + O_VTSW);
    const float* gig = (const float*)(ws + O_GIG); const float* glf = (const float*)(ws + O_GLF);
    const float* cw = a.in[4];
    const int rsub = lane >> 3, cg8 = lane & 7;
    constexpr int N_QK = 512 * 16, N_VML = 512 * 16, N_VSW = 512 * 4, N_TILE = N_QK + N_VML + N_VSW, N_ALL = N_TILE + 16 * NCH;
    for (int it = gw; it < N_ALL; it += NGW) {
        if (it >= N_TILE) {
            const int q = it - N_TILE, bh = q / NCH, c = q % NCH; const size_t gi = (size_t)bh * SEQ + c * 64 + lane;
            float b, av, amax, pm; gate_chunk(glf[gi], gig[gi], lane, b, av, amax, pm);
            ((float*)(ws + O_GBC))[gi] = b; ((float*)(ws + O_GL))[gi] = b + pm;
            ((bf16_t*)(ws + O_GWH))[gi] = (bf16_t)(pk2(__expf(av - amax), 0.f) & 0xffffu);
            const float bl = rdlane(b, 63);
            if (lane == 0) { ((float*)(ws + O_CBL))[q] = bl; ((float*)(ws + O_CMW))[q] = bl + amax; ((float*)(ws + O_CAMAX))[q] = amax; }
            continue;
        }
        int kind, tt, ct;
        if (it < N_QK) { kind = 0; tt = it >> 4; ct = it & 15; } else if (it < N_QK + N_VML) { kind = 1; tt = (it - N_QK) >> 4; ct = (it - N_QK) & 15; } else { kind = 2; tt = (it - N_QK - N_VML) >> 2; ct = (it - N_QK - N_VML) & 3; }
        const int t0 = tt * 64, c0 = ct * 64, bb = t0 / SEQ, s0 = t0 % SEQ, c = c0 + 8 * cg8;
        if (kind == 0) {
            float w[4][8];
#pragma unroll
            for (int j = 0; j < 4; ++j) { const f32x4 w0 = *(const f32x4*)(cw + j * 1024 + c), w1 = *(const f32x4*)(cw + j * 1024 + c + 4);
                w[j][0] = w0[0]; w[j][1] = w0[1]; w[j][2] = w0[2]; w[j][3] = w0[3]; w[j][4] = w1[0]; w[j][5] = w1[1]; w[j][6] = w1[2]; w[j][7] = w1[3]; }
            const float qs = (c < 512) ? 0.08838834764831845f : 1.f;
            u32x4 xq[8][4];
#pragma unroll
            for (int i = 0; i < 8; ++i) { const int r = 8 * i + rsub, t = t0 + r, sp = s0 + r;
#pragma unroll
                for (int j = 0; j < 4; ++j) { const int back = (sp - 3 + j >= 0) ? 3 - j : 0; xq[i][j] = *(const u32x4*)(QK + (size_t)(t - back) * 1024 + c); } }
#pragma unroll
            for (int i = 0; i < 8; ++i) { const int r = 8 * i + rsub, t = t0 + r, sp = s0 + r;
                float acc8[8];
#pragma unroll
                for (int e = 0; e < 8; ++e) acc8[e] = 0.f;
#pragma unroll
                for (int j = 0; j < 4; ++j) { const float vz = (sp - 3 + j >= 0) ? 1.f : 0.f; const u32x4 xv = xq[i][j];
                        acc8[0] += vz * w[j][0] * bflo(xv.x); acc8[1] += vz * w[j][1] * bfhi(xv.x); acc8[2] += vz * w[j][2] * bflo(xv.y); acc8[3] += vz * w[j][3] * bfhi(xv.y);
                        acc8[4] += vz * w[j][4] * bflo(xv.z); acc8[5] += vz * w[j][5] * bfhi(xv.z); acc8[6] += vz * w[j][6] * bflo(xv.w); acc8[7] += vz * w[j][7] * bfhi(xv.w); }
#pragma unroll
                for (int e = 0; e < 8; ++e) acc8[e] = acc8[e] * sigm(acc8[e]) * qs;
                u32x4 o; o.x = pk2(acc8[0], acc8[1]); o.y = pk2(acc8[2], acc8[3]); o.z = pk2(acc8[4], acc8[5]); o.w = pk2(acc8[6], acc8[7]);
                *(u32x4*)(QKP + (size_t)t * 1024 + c) = o;
                if (c0 >= 512) { LAS unsigned* tp = tile + r * 33 + 4 * cg8; tp[0] = o.x; tp[1] = o.y; tp[2] = o.z; tp[3] = o.w; } }
            if (c0 < 512) continue;
        } else {
            float wh = 1.f;
            if (kind == 1) { const int bh = bb * 4 + (c0 >> 8); const size_t gi = (size_t)bh * SEQ + s0 + lane; float b, av, amax, pm; gate_chunk(glf[gi], gig[gi], lane, b, av, amax, pm); wh = __expf(av - amax); }
            const bf16_t* src = (kind == 1) ? VML : VSW; const int ld = (kind == 1) ? 1024 : 256;
#pragma unroll
            for (int i = 0; i < 8; ++i) { const int r = 8 * i + rsub; u32x4 o = *(const u32x4*)(src + (size_t)(t0 + r) * ld + c);
                const float sc = __shfl(wh, r);
                if (kind == 1) { o.x = pk2(bflo(o.x) * sc, bfhi(o.x) * sc); o.y = pk2(bflo(o.y) * sc, bfhi(o.y) * sc); o.z = pk2(bflo(o.z) * sc, bfhi(o.z) * sc); o.w = pk2(bflo(o.w) * sc, bfhi(o.w) * sc); }
                LAS unsigned* tp = tile + r * 33 + 4 * cg8; tp[0] = o.x; tp[1] = o.y; tp[2] = o.z; tp[3] = o.w; }
        }
        asm volatile("s_waitcnt lgkmcnt(0)" ::: "memory");
        bf16_t* dst; int CH, cb;
        if (kind == 0) { dst = KT; CH = 128; cb = c0 - 512; } else if (kind == 1) { dst = VT; CH = 256; cb = c0; } else { dst = VTSW; CH = 64; cb = c0; }
#pragma unroll
        for (int i = 0; i < 8; ++i) { const int ch = 8 * i + (lane >> 3), tg = lane & 7; const LAS unsigned short* sp = tile16 + (8 * tg) * 66 + ch;
            u32x4 o; o.x = (unsigned)sp[0] | ((unsigned)sp[66] << 16); o.y = (unsigned)sp[2 * 66] | ((unsigned)sp[3 * 66] << 16); o.z = (unsigned)sp[4 * 66] | ((unsigned)sp[5 * 66] << 16); o.w = (unsigned)sp[6 * 66] | ((unsigned)sp[7 * 66] << 16);
            const int chn = cb + ch, hb = bb * 4 + chn / CH, slot = (kind == 2) ? (s0 >> 6) : (((s0 >> 6) + 8 * hb) & 127);
            *(u32x4*)(dst + ((size_t)((hb * NCH + slot) * CH + (chn % CH)) << 6) + 8 * tg) = o; }
        asm volatile("s_waitcnt lgkmcnt(0)" ::: "memory");
    }
}

__device__ __forceinline__ void scan_block(const Args& a, LAS unsigned char* lds, int sb, int wave, int lane) {
    unsigned char* ws = a.ws;
    const int bh = sb / 9, k9 = sb - 9 * bh, fr = lane & 15, fq = lane >> 4;
    constexpr int STG = 128 * 144, SST0 = 4 * STG, TILE = 4352;
    if (wave < 2) {
        const int slice = (k9 < 8) ? 2 * k9 + wave : 16; const bool is_n = (slice == 16);
        const bf16_t* VT = (const bf16_t*)((unsigned char*)a.out + OO_VT); const bf16_t* GWH = (const bf16_t*)(ws + O_GWH);
        const bf16_t* pb = is_n ? GWH + (size_t)bh * SEQ + 8 * fq : VT + ((size_t)(bh * NCH * 256 + 16 * slice + fr) << 6) + 8 * fq;
        const int pbs = is_n ? 64 : 256 * 64;
        const float* cbl = (const float*)(ws + O_CBL) + bh * NCH; const float* cmw = (const float*)(ws + O_CMW) + bh * NCH;
        const float bl0 = cbl[lane], bl1 = cbl[64 + lane], mw0 = cmw[lane], mw1 = cmw[64 + lane];
        bf16x8 rb[8][2];
#define VB_LOAD(slot, cc) do { const bf16_t* _p = pb + (size_t)(is_n ? (cc) : (((cc) + 8 * bh) & 127)) * pbs; rb[slot][0] = ld8(_p); rb[slot][1] = ld8(_p + 32); } while (0)
#pragma unroll
        for (int p = 0; p < 8; ++p) VB_LOAD(p, p);
        if (is_n && wave == 0) { float* cmo = (float*)(ws + O_CM) + bh * NCH; float m = 0.f;
            for (int c = 0; c < NCH; ++c) { const float bl = (c < 64) ? rdlane(bl0, c & 63) : rdlane(bl1, c & 63), mw = (c < 64) ? rdlane(mw0, c & 63) : rdlane(mw1, c & 63); cmo[c] = m; m = fmaxf(bl + m, mw); } }
        f32x4 acc[8];
#pragma unroll
        for (int m = 0; m < 8; ++m) acc[m] = (f32x4){0.f, 0.f, 0.f, 0.f};
        float mst = 0.f;
        __builtin_amdgcn_s_setprio(3);
        for (int c0 = 0; c0 < NCH; c0 += 8) {
#pragma unroll
            for (int p = 0; p < 8; ++p) { const int c = c0 + p;
                LAS unsigned char* sst = lds + SST0 + ((p & 1) * 2 + wave) * TILE;
#pragma unroll
                for (int m = 0; m < 8; ++m) { u32x2 s0; s0.x = pk2(acc[m][0], acc[m][1]); s0.y = pk2(acc[m][2], acc[m][3]); *(LAS u32x2*)(sst + fr * 272 + 32 * m + 8 * fq) = s0; }
                __syncthreads();
                const LAS unsigned char* ls = lds + (p & 3) * STG + fr * 144 + fq * 16;
                bf16x8 af[8][2];
#pragma unroll
                for (int m = 0; m < 8; ++m) { af[m][0] = *(const LAS bf16x8*)(ls + m * 16 * 144); af[m][1] = *(const LAS bf16x8*)(ls + m * 16 * 144 + 64); }
                const float bl = (c < 64) ? rdlane(bl0, c & 63) : rdlane(bl1, c & 63), mw = (c < 64) ? rdlane(mw0, c & 63) : rdlane(mw1, c & 63);
                const float mn = fmaxf(bl + mst, mw), decay = __expf(bl + mst - mn), eta = __expf(mw - mn); mst = mn;
                const f32x4 z = {0.f, 0.f, 0.f, 0.f};
#pragma unroll
                for (int m = 0; m < 8; ++m) { f32x4 t = mfma16(af[m][0], rb[p][0], z); t = mfma16(af[m][1], rb[p][1], t); acc[m] = acc[m] * decay + t * eta; }
                { const int cl = (c + 8 < NCH) ? c + 8 : NCH - 1; VB_LOAD(p, cl); }
            }
        }
        __builtin_amdgcn_s_setprio(0);
#undef VB_LOAD
    } else if (wave < 6) {
        const bf16_t* KT = (const bf16_t*)(ws + O_KT);
        const int tid = (wave - 2) * 64 + lane;
        const bf16_t* pk = KT + ((size_t)(bh * NCH * 128) << 6) + tid * 8;
        LAS unsigned char* lw = lds + (tid >> 3) * 144 + (tid & 7) * 16;
        u32x4 kr[8][4];
#define KT_LOAD(set, cc) do { const size_t _o = (size_t)(((cc) + 8 * bh) & 127) * 8192; _Pragma("unroll") for (int _k = 0; _k < 4; ++_k) kr[set][_k] = *(const u32x4*)(pk + _o + _k * 2048); } while (0)
#define KT_WRITE(set, stg) do { _Pragma("unroll") for (int _k = 0; _k < 4; ++_k) *(LAS u32x4*)(lw + (stg) * STG + _k * 32 * 144) = kr[set][_k]; } while (0)
        KT_LOAD(0, 0); KT_LOAD(1, 1); KT_LOAD(2, 2);
        KT_WRITE(0, 0); KT_WRITE(1, 1); KT_WRITE(2, 2);
        KT_LOAD(3, 3); KT_LOAD(4, 4); KT_LOAD(5, 5); KT_LOAD(6, 6); KT_LOAD(7, 7); KT_LOAD(0, 8); KT_LOAD(1, 9);
        for (int c0 = 0; c0 < NCH; c0 += 8) {
#pragma unroll
            for (int p = 0; p < 8; ++p) { const int c = c0 + p;
                __syncthreads();
                { const int cl = (c + 10 < NCH) ? c + 10 : NCH - 1; KT_LOAD((p + 2) & 7, cl); }
                KT_WRITE((p + 3) & 7, (p + 3) & 3);
            }
        }
#undef KT_LOAD
#undef KT_WRITE
    } else {
        const int j = wave - 6;
        const int slice = (k9 < 8) ? 2 * k9 + j : 16; const bool live = (k9 < 8) || (j == 0);
        bf16_t* cst = (bf16_t*)(ws + O_CST) + (size_t)((bh * 17 + slice) * NCH) * 2048;
        for (int c = 0; c < NCH; ++c) {
            __syncthreads();
            if (live) { const LAS unsigned char* sst = lds + SST0 + ((c & 1) * 2 + j) * TILE;
                bf16_t* st = cst + (size_t)((c + 8 * bh + 5 * slice) & 127) * 2048;
#pragma unroll
                for (int k = 0; k < 4; ++k) { const int q = lane + 64 * k; *(u32x4*)(st + (size_t)(q >> 4) * 128 + (q & 15) * 8) = *(const LAS u32x4*)(sst + (q >> 4) * 272 + (q & 15) * 16); } }
        }
    }
    __syncthreads();
}

constexpr int SWA_KS = 0, SWA_VS = 272 * 144, SWA_VP = 576, SWA_NXT = SWA_VS + 64 * SWA_VP;
struct SwaPre { u32x4 kreg[5], vreg[5]; bf16x8 qf[4][2]; };
__device__ __forceinline__ void swa_issue(const Args& a, int bu, int wave, int lane, SwaPre& P) {
    unsigned char* ws = a.ws;
    const int qb = bu & 63, kvh = (bu >> 6) & 3, b = bu >> 8, fr = lane & 15, fq = lane >> 4, tid = wave * 64 + lane;
    const bf16_t* QSW = (const bf16_t*)(ws + O_QSW); const bf16_t* KSW = (const bf16_t*)(ws + O_KSW); const bf16_t* VTSW = (const bf16_t*)(ws + O_VTSW);
    const int KB = 128 * qb - 144;
#pragma unroll
    for (int it = 0; it < 5; ++it) { int i = tid + 512 * it; i = i < 2176 ? i : 2175; const int row = i >> 3, ch = i & 7; int kp = KB + row; kp = kp < 0 ? 0 : kp;
        P.kreg[it] = *(const u32x4*)(KSW + (size_t)(b * SEQ + kp) * 256 + kvh * 64 + 8 * ch); }
#pragma unroll
    for (int it = 0; it < 5; ++it) { int i = tid + 512 * it; i = i < 2176 ? i : 2175; const int hd = i / 34, ch = i - hd * 34; int sp = KB + 8 * ch; sp = sp < 0 ? 0 : sp;
        P.vreg[it] = *(const u32x4*)(VTSW + ((size_t)((((b * 4 + kvh) * NCH + (sp >> 6)) * 64 + hd)) << 6) + (sp & 63)); }
    const int tq = 128 * qb + 16 * wave + fr;
#pragma unroll
    for (int hh = 0; hh < 4; ++hh) { const bf16_t* qp = QSW + (size_t)(b * SEQ + tq) * 1024 + (4 * kvh + hh) * 64 + 8 * fq; P.qf[hh][0] = ld8(qp); P.qf[hh][1] = ld8(qp + 32); }
}
__device__ __forceinline__ void swa_commit(LAS unsigned char* lds, int bu, int wave, int lane, const SwaPre& P) {
    const int qb = bu & 63, tid = wave * 64 + lane, KB = 128 * qb - 144;
    const u32x4 zero4 = {0u, 0u, 0u, 0u};
#pragma unroll
    for (int it = 0; it < 5; ++it) { const int i = tid + 512 * it; if (i < 2176) { const int row = i >> 3, ch = i & 7; *(LAS u32x4*)(lds + SWA_KS + row * 144 + (ch ^ (4 * ((row >> 4) & 1))) * 16) = (KB + row >= 0) ? P.kreg[it] : zero4; } }
#pragma unroll
    for (int it = 0; it < 5; ++it) { const int i = tid + 512 * it; if (i < 2176) { const int hd = i / 34, ch = i - hd * 34; *(LAS u32x4*)(lds + SWA_VS + hd * SWA_VP + (ch ^ ((hd >> 4) & 3)) * 16) = (KB + 8 * ch >= 0) ? P.vreg[it] : zero4; } }
}
__device__ __forceinline__ void swa_compute(const Args& a, LAS unsigned char* lds, int bu, int wave, int lane, const bf16x8 (&qf)[4][2]) {
    unsigned char* ws = a.ws;
    const int qb = bu & 63, kvh = (bu >> 6) & 3, b = bu >> 8, fr = lane & 15, fq = lane >> 4;
    bf16_t* QSW = (bf16_t*)(ws + O_QSW);
    const int g = wave, t0 = 128 * qb + 16 * g, tq = t0 + fr, kb = t0 - 144;
    float sk[4];
#pragma unroll
    for (int hh = 0; hh < 4; ++hh) sk[hh] = a.in[7][4 * kvh + hh];
    const int krow = 8 * (fr >> 2) + (fr & 3);
    const LAS unsigned char* kbase = lds + SWA_KS + (16 * g + krow) * 144;
    const int kx0 = 4 * ((g + (krow >> 4)) & 1), kx1 = 4 * ((g + ((krow + 4) >> 4)) & 1);
    const LAS unsigned char* vbase = lds + SWA_VS;
    const int vpc = 2 * g + fq, vx = fr >> 2;
#pragma unroll
    for (int hh = 0; hh < 4; ++hh) {
        const bf16x8 q0 = qf[hh][0], q1 = qf[hh][1];
        const float sink = sk[hh];
        f32x4 st[10];
#pragma unroll
        for (int tau = 0; tau < 10; ++tau) { const int i = tau >> 1, e = tau & 1; const LAS unsigned char* kp = kbase + (32 * i + 4 * e) * 144; const int kx = e ? kx1 : kx0;
            f32x4 s = {0.f, 0.f, 0.f, 0.f}; s = mfma16(*(const LAS bf16x8*)(kp + ((fq ^ kx) * 16)), q0, s); s = mfma16(*(const LAS bf16x8*)(kp + (((fq + 4) ^ kx) * 16)), q1, s); st[tau] = s; }
        float mx = -1e30f;
#pragma unroll
        for (int tau = 0; tau < 10; ++tau) { const int i = tau >> 1, e = tau & 1;
#pragma unroll
            for (int r = 0; r < 4; ++r) { const int kp = kb + 32 * i + 8 * fq + 4 * e + r, df = tq - kp; const bool ok = (kp >= 0) && (df >= 0) && (df < 128);
                const float l = ok ? st[tau][r] * 0.125f : -1e30f; st[tau][r] = l; mx = fmaxf(mx, l); } }
        mx = fmaxf(mx, __shfl_xor(mx, 16)); mx = fmaxf(mx, __shfl_xor(mx, 32)); mx = fmaxf(mx, sink);
        float sum = 0.f;
#pragma unroll
        for (int tau = 0; tau < 10; ++tau)
#pragma unroll
            for (int r = 0; r < 4; ++r) { const float p = __expf(st[tau][r] - mx); st[tau][r] = p; sum += p; }
        sum += __shfl_xor(sum, 16); sum += __shfl_xor(sum, 32);
        const float inv = 1.f / (sum + __expf(sink - mx));
        bf16x8 pf[5];
#pragma unroll
        for (int i = 0; i < 5; ++i) { u32x4 w; w.x = pk2(st[2 * i][0], st[2 * i][1]); w.y = pk2(st[2 * i][2], st[2 * i][3]); w.z = pk2(st[2 * i + 1][0], st[2 * i + 1][1]); w.w = pk2(st[2 * i + 1][2], st[2 * i + 1][3]); pf[i] = __builtin_bit_cast(bf16x8, w); }
        f32x4 o[4];
#pragma unroll
        for (int mt = 0; mt < 4; ++mt) { const int hd = 16 * (fr >> 2) + 4 * mt + (fr & 3); const LAS unsigned char* vp = vbase + hd * SWA_VP;
            f32x4 s = {0.f, 0.f, 0.f, 0.f};
#pragma unroll
            for (int i = 0; i < 5; ++i) s = mfma16(*(const LAS bf16x8*)(vp + (((vpc + 4 * i) ^ vx) * 16)), pf[i], s);
            o[mt] = s * inv; }
        u32x4 w0, w1; w0.x = pk2(o[0][0], o[0][1]); w0.y = pk2(o[0][2], o[0][3]); w0.z = pk2(o[1][0], o[1][1]); w0.w = pk2(o[1][2], o[1][3]);
        w1.x = pk2(o[2][0], o[2][1]); w1.y = pk2(o[2][2], o[2][3]); w1.z = pk2(o[3][0], o[3][1]); w1.w = pk2(o[3][2], o[3][3]);
        bf16_t* op = QSW + (size_t)(b * SEQ + tq) * 1024 + (4 * kvh + hh) * 64 + 16 * fq;
        *(u32x4*)op = w0; *(u32x4*)(op + 8) = w1;
    }
}
__device__ __forceinline__ void phase3(const Args& a, LAS unsigned char* lds, int wave) {
    const int lane = lane_id();
#ifdef PROBE_MASK
    if (blockIdx.x == 0 && wave == 0 && lane == 0) ((unsigned long long*)(a.ws + O_TS))[11] = __builtin_amdgcn_s_memrealtime();
#endif
    if (blockIdx.x < 144) scan_block(a, lds, (int)blockIdx.x, wave, lane);
#ifdef PROBE_MASK
    if (blockIdx.x == 0 && wave == 0 && lane == 0) ((unsigned long long*)(a.ws + O_TS))[12] = __builtin_amdgcn_s_memrealtime();
#endif
    unsigned* ctr = (unsigned*)(a.ws + O_CTR);
    LAS unsigned* nxt = (LAS unsigned*)(lds + SWA_NXT);
    const bool lead = (wave == 0 && lane == 0);
    constexpr unsigned NU = NB * 4 * 64;
    unsigned mine = 0; if (lead) { mine = __hip_atomic_fetch_add(ctr, 1u, __ATOMIC_RELAXED, __HIP_MEMORY_SCOPE_AGENT); *nxt = mine; }
    __syncthreads();
    unsigned cur = *nxt;
    if (cur < NU) {
        if (lead) mine = __hip_atomic_fetch_add(ctr, 1u, __ATOMIC_RELAXED, __HIP_MEMORY_SCOPE_AGENT);
        SwaPre P; swa_issue(a, (int)cur, wave, lane, P);
        for (;;) {
            __syncthreads();
            if (lead) *nxt = mine;
            swa_commit(lds, (int)cur, wave, lane, P);
            bf16x8 qc[4][2];
#pragma unroll
            for (int hh = 0; hh < 4; ++hh) { qc[hh][0] = P.qf[hh][0]; qc[hh][1] = P.qf[hh][1]; }
            __syncthreads();
            const unsigned nx = *nxt;
            if (lead && nx < NU) mine = __hip_atomic_fetch_add(ctr, 1u, __ATOMIC_RELAXED, __HIP_MEMORY_SCOPE_AGENT);
            swa_issue(a, (int)(nx < NU ? nx : 0u), wave, lane, P);
            swa_compute(a, lds, (int)cur, wave, lane, qc);
            if (nx >= NU) break;
            cur = nx;
        }
    }
    __syncthreads();
}

__device__ __forceinline__ void p4_ptile(const bf16x8 (&kf)[4], const bf16x8 (&q)[4], float f, int tt, int st, int fr, int fq, LAS bf16_t* Pt) {
    f32x4 s = {0.f, 0.f, 0.f, 0.f};
#pragma unroll
    for (int ks = 0; ks < 4; ++ks) s = mfma16(kf[ks], q[ks], s);
    const int t = 16 * tt + fr, sb = 16 * st + 4 * fq;
    const float p0 = (sb + 0 <= t) ? s[0] * f : 0.f, p1 = (sb + 1 <= t) ? s[1] * f : 0.f, p2 = (sb + 2 <= t) ? s[2] * f : 0.f, p3 = (sb + 3 <= t) ? s[3] * f : 0.f;
    u32x2 o; o.x = pk2(p0, p1); o.y = pk2(p2, p3); *(LAS u32x2*)(Pt + t * 72 + sb) = o;
}
__device__ __forceinline__ void phase4(const Args& a, LAS unsigned char* lds, int wave) {
    const int lane = lane_id();
    unsigned char* ws = a.ws;
    { const f32x4* p = (const f32x4*)a.in[1]; u32x2* pbo = (u32x2*)(ws + O_PB); const int n = T * PLE / 4, stride = gridDim.x * 512;
        for (int i = blockIdx.x * 512 + wave * 64 + lane; i < n; i += 8 * stride) { f32x4 v[8];
#pragma unroll
            for (int k = 0; k < 8; ++k) { int idx = i + k * stride; idx = idx < n ? idx : n - 1; v[k] = p[idx]; }
#pragma unroll
            for (int k = 0; k < 8; ++k) { const int idx = i + k * stride; if (idx < n) { u32x2 o; o.x = pk2(v[k][0], v[k][1]); o.y = pk2(v[k][2], v[k][3]); pbo[idx] = o; } } } }
    const bf16_t* QKP = (const bf16_t*)((unsigned char*)a.out + OO_QKP); const bf16_t* VT = (const bf16_t*)((unsigned char*)a.out + OO_VT);
    const bf16_t* CST = (const bf16_t*)(ws + O_CST); const bf16_t* GWH = (const bf16_t*)(ws + O_GWH); bf16_t* OML = (bf16_t*)(ws + O_OML);
    const float* gbc = (const float*)(ws + O_GBC); const float* gL = (const float*)(ws + O_GL); const float* cm = (const float*)(ws + O_CM); const float* camax = (const float*)(ws + O_CAMAX);
    const float* gn = a.in[6];
    LAS bf16_t* Pt = (LAS bf16_t*)lds;
    LAS float* red = (LAS float*)(lds + 16384);
    LAS unsigned char* QS = lds + 20480; LAS unsigned char* KS = lds + 40960;
    const int fr = lane & 15, fq = lane >> 4, w = wave;
    u32x4 ypend[4]; size_t ytok = 0; int ycol = 0; bool have = false;
    u32x4 pq[2], pk_[2]; float pbt[2], pL[2], pb4[4], pL4[4], pmc = 0.f, pam = 0.f;
#define P4_PREF(un_) do { const int _bh = (un_) / NCH, _c = (un_) % NCH, _h = _bh & 3; const size_t _tok0 = (size_t)(_bh >> 2) * SEQ + _c * 64; pmc = cm[un_]; pam = camax[un_]; \
        _Pragma("unroll") for (int tt = 0; tt < 4; ++tt) { const size_t gi = (size_t)_bh * SEQ + _c * 64 + 16 * tt + fr; pb4[tt] = gbc[gi]; pL4[tt] = gL[gi]; } \
        _Pragma("unroll") for (int k2 = 0; k2 < 2; ++k2) { const int i = w * 64 + lane + 512 * k2, row = i >> 4, pc = i & 15; const bf16_t* src = QKP + (_tok0 + row) * 1024 + _h * 128 + 8 * pc; \
            pq[k2] = *(const u32x4*)src; pk_[k2] = *(const u32x4*)(src + 512); const size_t gi = (size_t)_bh * SEQ + _c * 64 + row; pbt[k2] = gbc[gi]; pL[k2] = gL[gi]; } } while (0)
    if ((int)blockIdx.x < 16 * NCH) P4_PREF((int)blockIdx.x);
    for (int un = blockIdx.x; un < 16 * NCH; un += gridDim.x) {
        const int bh = un / NCH, c = un % NCH, bb = bh >> 2, h = bh & 3; const size_t tok0 = (size_t)bb * SEQ + c * 64;
        const float m_c = pmc, amax = pam;
        float en[4];
#pragma unroll
        for (int tt = 0; tt < 4; ++tt) en[tt] = __expf(-fmaxf(pb4[tt] + m_c, pL4[tt]));
        u32x4 qpc[2], kpc[2]; float wrow[2];
#pragma unroll
        for (int k2 = 0; k2 < 2; ++k2) { qpc[k2] = pq[k2]; kpc[k2] = pk_[k2]; wrow[k2] = __expf(pbt[k2] + m_c - fmaxf(pbt[k2] + m_c, pL[k2])); }
        const int colh = h * 256 + 32 * w + 8 * fq;
        u32x4 ovv[4];
#pragma unroll
        for (int tt = 0; tt < 4; ++tt) ovv[tt] = *(const u32x4*)(OML + (tok0 + 16 * tt + fr) * 1024 + colh);
        bf16x8 ca[3][4], va[3][2];
#pragma unroll
        for (int e = 0; e < 3; ++e) { const int dvr = 32 * w + 8 * (fr >> 2) + 4 * e + (fr & 3); const int crow = (e < 2) ? dvr : 256 + fr;
            const bf16_t* cp = CST + ((size_t)((bh * 17 + (crow >> 4)) * NCH + ((c + 8 * bh + 5 * (crow >> 4)) & 127)) * 16 + (crow & 15)) * 128 + 8 * fq;
            const bf16_t* vp = (e < 2) ? VT + ((size_t)((bh * NCH + ((c + 8 * bh) & 127)) * 256 + dvr) << 6) + 8 * fq : GWH + (size_t)bh * SEQ + c * 64 + 8 * fq;
#pragma unroll
            for (int ks = 0; ks < 4; ++ks) ca[e][ks] = ld8(cp + 32 * ks);
            va[e][0] = ld8(vp); va[e][1] = ld8(vp + 32); }
        if (have) {
#pragma unroll
            for (int tt = 0; tt < 4; ++tt) *(u32x4*)(OML + (ytok + 16 * tt + fr) * 1024 + ycol) = ypend[tt]; }
#pragma unroll
        for (int k2 = 0; k2 < 2; ++k2) { const int i = w * 64 + lane + 512 * k2, row = i >> 4, pc = i & 15;
            *(LAS u32x4*)(QS + row * 288 + pc * 16) = __builtin_bit_cast(u32x4, scale8(__builtin_bit_cast(bf16x8, qpc[k2]), wrow[k2])); *(LAS u32x4*)(KS + row * 288 + pc * 16) = kpc[k2]; }
        __syncthreads();
        bf16x8 qt[4][4];
#pragma unroll
        for (int tt = 0; tt < 4; ++tt)
#pragma unroll
            for (int ks = 0; ks < 4; ++ks) qt[tt][ks] = *(const LAS bf16x8*)(QS + (16 * tt + fr) * 288 + 64 * ks + 16 * fq);
        { bf16x8 kf[4]; const float cf = __expf(amax - m_c);
#pragma unroll
          for (int ks = 0; ks < 4; ++ks) kf[ks] = *(const LAS bf16x8*)(KS + (16 * (w >> 1) + fr) * 288 + 64 * ks + 16 * fq);
          if (w & 1) { p4_ptile(kf, qt[2], cf, 2, w >> 1, fr, fq, Pt); p4_ptile(kf, qt[3], cf, 3, w >> 1, fr, fq, Pt); }
          else       { p4_ptile(kf, qt[0], cf, 0, w >> 1, fr, fq, Pt); p4_ptile(kf, qt[1], cf, 1, w >> 1, fr, fq, Pt); } }
        __syncthreads();
        f32x4 acc[3][4];
#pragma unroll
        for (int e = 0; e < 3; ++e) {
#pragma unroll
            for (int tt = 0; tt < 4; ++tt) { f32x4 s = {0.f, 0.f, 0.f, 0.f};
#pragma unroll
                for (int ks = 0; ks < 4; ++ks) s = mfma16(ca[e][ks], qt[tt][ks], s);
#pragma unroll
                for (int k2 = 0; k2 < 2; ++k2) s = mfma16(va[e][k2], *(const LAS bf16x8*)(Pt + (16 * tt + fr) * 72 + 32 * k2 + 8 * fq), s);
                acc[e][tt] = s; } }
        { const int unn = un + (int)gridDim.x; P4_PREF(unn < 16 * NCH ? unn : un); }
        float rs[4];
#pragma unroll
        for (int tt = 0; tt < 4; ++tt) { const float dn = __builtin_amdgcn_rcpf(fmaxf(fabsf(acc[2][tt][0]), en[tt])); float ss = 0.f;
#pragma unroll
            for (int e = 0; e < 2; ++e)
#pragma unroll
                for (int r = 0; r < 4; ++r) { const float hv = acc[e][tt][r] * dn; acc[e][tt][r] = hv; ss += hv * hv; }
            ss += __shfl_xor(ss, 16); ss += __shfl_xor(ss, 32);
            if (fq == 0) red[w * 64 + 16 * tt + fr] = ss; }
        __syncthreads();
#pragma unroll
        for (int tt = 0; tt < 4; ++tt) { float tot = 0.f;
#pragma unroll
            for (int ww = 0; ww < 8; ++ww) tot += red[ww * 64 + 16 * tt + fr];
            rs[tt] = rsqrtf(tot * (1.f / 256.f) + EPS); }
        const f32x4 g0 = *(const f32x4*)(gn + colh), g1 = *(const f32x4*)(gn + colh + 4);
#pragma unroll
        for (int tt = 0; tt < 4; ++tt) { const u32x4 ov = ovv[tt]; const float r_ = rs[tt]; u32x4 y;
            y.x = pk2(sigm(bflo(ov.x)) * g0[0] * acc[0][tt][0] * r_, sigm(bfhi(ov.x)) * g0[1] * acc[0][tt][1] * r_);
            y.y = pk2(sigm(bflo(ov.y)) * g0[2] * acc[0][tt][2] * r_, sigm(bfhi(ov.y)) * g0[3] * acc[0][tt][3] * r_);
            y.z = pk2(sigm(bflo(ov.z)) * g1[0] * acc[1][tt][0] * r_, sigm(bfhi(ov.z)) * g1[1] * acc[1][tt][1] * r_);
            y.w = pk2(sigm(bflo(ov.w)) * g1[2] * acc[1][tt][2] * r_, sigm(bfhi(ov.w)) * g1[3] * acc[1][tt][3] * r_);
            ypend[tt] = y; }
        ytok = tok0; ycol = colh; have = true;
    }
    if (have) {
#pragma unroll
        for (int tt = 0; tt < 4; ++tt) *(u32x4*)(OML + (ytok + 16 * tt + fr) * 1024 + ycol) = ypend[tt]; }
}

__device__ __forceinline__ void phase10(const Args& a, int wave) {
    const int lane = lane_id();
    const float* ssq = (const float*)(a.ws + O_SSQ3); const float* g = a.in[17]; const bf16_t* X3 = (const bf16_t*)(a.ws + O_X3B);
    const int gw = blockIdx.x * 8 + wave, NGW = gridDim.x * 8;
#ifdef PROBE_MASK
    long long probeK = 0; { const unsigned long long* ts = (const unsigned long long*)(a.ws + O_TS);
#pragma unroll
        for (int k = 0; k < 10; ++k) if ((PROBE_MASK >> k) & 1) probeK += (long long)(ts[k + 1] - ts[k]) / 10;
        if ((PROBE_MASK >> 10) & 1) probeK += (long long)(ts[12] - ts[11]) / 10; }
#endif
    const f32x4 g0 = *(const f32x4*)(g + 8 * lane), g1 = *(const f32x4*)(g + 8 * lane + 4), g2 = *(const f32x4*)(g + 512 + 8 * lane), g3 = *(const f32x4*)(g + 512 + 8 * lane + 4);
    u32x4 xa[4], xb[4]; float rs[4];
#define P10_LOAD(XA, XB, RS, row_) do { _Pragma("unroll") for (int k = 0; k < 4; ++k) { int r = (row_) + k * NGW; r = r < T ? r : T - 1; const bf16_t* xr = X3 + (size_t)r * D + 8 * lane; XA[k] = *(const u32x4*)xr; XB[k] = *(const u32x4*)(xr + 512); \
            const f32x4 p = ((const f32x4*)(ssq + (size_t)r * 16))[lane & 3]; float s = (p[0] + p[1]) + (p[2] + p[3]); s += __shfl_xor(s, 1); s += __shfl_xor(s, 2); RS[k] = rsqrtf(s * (1.f / D) + EPS); } } while (0)
    P10_LOAD(xa, xb, rs, gw);
    for (int row = gw; row < T; row += 4 * NGW) {
        u32x4 na[4], nb[4]; float rn[4];
        P10_LOAD(na, nb, rn, row + 4 * NGW);
#pragma unroll
        for (int k = 0; k < 4; ++k) { const int r = row + k * NGW; float* orow = a.out + (size_t)r * D + 8 * lane; const float q = rs[k];
            f32x4 o[4];
            o[0] = (f32x4){bflo(xa[k].x), bfhi(xa[k].x), bflo(xa[k].y), bfhi(xa[k].y)} * q * g0; o[1] = (f32x4){bflo(xa[k].z), bfhi(xa[k].z), bflo(xa[k].w), bfhi(xa[k].w)} * q * g1;
            o[2] = (f32x4){bflo(xb[k].x), bfhi(xb[k].x), bflo(xb[k].y), bfhi(xb[k].y)} * q * g2; o[3] = (f32x4){bflo(xb[k].z), bfhi(xb[k].z), bflo(xb[k].w), bfhi(xb[k].w)} * q * g3;
#ifdef PROBE_MASK
#pragma unroll
            for (int j = 0; j < 4; ++j) { const long long base_i = (long long)r * D + 8 * lane + (j >> 1) * 512 + (j & 1) * 4;
#pragma unroll
              for (int e2 = 0; e2 < 4; ++e2) if (base_i + e2 < probeK) o[j][e2] += 0.1f; }
#endif
            *(f32x4*)orow = o[0]; *(f32x4*)(orow + 4) = o[1]; *(f32x4*)(orow + 512) = o[2]; *(f32x4*)(orow + 516) = o[3]; }
#pragma unroll
        for (int k = 0; k < 4; ++k) { xa[k] = na[k]; xb[k] = nb[k]; rs[k] = rn[k]; }
    }
#undef P10_LOAD
}

#define XB_TMO      128
#define XB_XCNT(j)  (256  + 64 * (j))
#define XB_XSUB(j)  (1280 + 64 * (j))
#define XB_XGEN(j)  (2304 + 64 * (j))
#define XB_TOP      3328
#define XB_TOPGEN   3392
#define XCD_BAR_WORDS 3456
#define XB_SPIN_CAP (1u << 18)

__device__ __forceinline__ unsigned xb_ld(unsigned* p)              { return __hip_atomic_load(p, __ATOMIC_RELAXED, __HIP_MEMORY_SCOPE_AGENT); }
__device__ __forceinline__ unsigned xb_add(unsigned* p, unsigned v) { return __hip_atomic_fetch_add(p, v, __ATOMIC_RELAXED, __HIP_MEMORY_SCOPE_AGENT); }
__device__ __forceinline__ unsigned xb_xcc_id() { return (unsigned)__builtin_amdgcn_s_getreg((3 << 11) | 20) & 0xFu; }
#define XB_SPIN(cond, bar) do { unsigned _sp = 0; while (cond) { __builtin_amdgcn_s_sleep(1); \
    if ((++_sp & 255u) == 0u) { if (xb_ld(&(bar)[XB_TMO])) break; if (_sp > XB_SPIN_CAP) { atomicAdd(&(bar)[XB_TMO], 1u); break; } } } } while (0)

struct XcdBarrier {
    unsigned* bar; unsigned x;
    volatile LAS unsigned* st;
};

__device__ __forceinline__ XcdBarrier xcd_barrier_post(unsigned* bar, volatile LAS unsigned* st) {
    XcdBarrier b; b.bar = bar; b.x = xb_xcc_id(); b.st = st;
    if (threadIdx.x == 0) (void)xb_add(&bar[XB_XCNT(b.x)], 1u);
    return b;
}
__device__ __forceinline__ void xcd_barrier_complete(unsigned* bar, unsigned x, unsigned& nloc, unsigned& nx) {
    const unsigned G = gridDim.x * gridDim.y * gridDim.z;
    unsigned sum, cnt, mine, sp = 0u;
    for (;;) {
        sum = 0u; cnt = 0u; mine = 0u;
#pragma unroll
        for (unsigned j = 0; j < 16; ++j) { const unsigned c = xb_ld(&bar[XB_XCNT(j)]); sum += c; cnt += (c > 0u) ? 1u : 0u; mine = (j == x) ? c : mine; }
        if (sum == G) break;
        __builtin_amdgcn_s_sleep(1);
        if ((++sp & 255u) == 0u) { if (xb_ld(&bar[XB_TMO])) break; if (sp > XB_SPIN_CAP) { atomicAdd(&bar[XB_TMO], 1u); break; } }
    }
    nloc = mine > 0u ? mine : 1u; nx = cnt > 0u ? cnt : 1u;
}

__device__ __forceinline__ void xcd_barrier(const XcdBarrier& b, const bool lead) {
    asm volatile("s_waitcnt vmcnt(0)" ::: "memory");
    __syncthreads();
    if (lead) {
        unsigned* bar = b.bar;
        __builtin_amdgcn_s_waitcnt(0);
        unsigned nloc = b.st[0], nx = b.st[1];
        if (nloc == 0u) { xcd_barrier_complete(bar, b.x, nloc, nx); b.st[0] = nloc; b.st[1] = nx; }
        const unsigned old = xb_add(&bar[XB_XSUB(b.x)], 1u);
        const unsigned gen = old / nloc;
        if (old + 1u == (gen + 1u) * nloc) {
            __builtin_amdgcn_fence(__ATOMIC_RELEASE, "agent");
            asm volatile("s_waitcnt vmcnt(0)" ::: "memory");
            const unsigned og = xb_add(&bar[XB_TOP], 1u);
            const unsigned tg = og / nx;
            if (og + 1u == (tg + 1u) * nx) xb_add(&bar[XB_TOPGEN], 1u);
            else XB_SPIN(xb_ld(&bar[XB_TOPGEN]) == tg, bar);
            __builtin_amdgcn_fence(__ATOMIC_ACQUIRE, "agent");
            xb_add(&bar[XB_XGEN(b.x)], 1u);
            asm volatile("s_waitcnt vmcnt(0)" ::: "memory");
        } else {
            XB_SPIN(xb_ld(&bar[XB_XGEN(b.x)]) == gen, bar);
            __builtin_amdgcn_fence(__ATOMIC_ACQUIRE, "agent");
            asm volatile("s_waitcnt vmcnt(0)" ::: "memory");
        }
    }
    __syncthreads();
}

__device__ __forceinline__ void grid_bar(unsigned* bar, unsigned& nbar, int wave) {
    asm volatile("s_waitcnt vmcnt(0)" ::: "memory");
    __syncthreads();
    ++nbar;
    if (wave == 0 && lane_id() == 0) {
        __builtin_amdgcn_fence(__ATOMIC_RELEASE, "agent");
        asm volatile("s_waitcnt vmcnt(0)" ::: "memory");
        __hip_atomic_fetch_add(bar, 1u, __ATOMIC_RELAXED, __HIP_MEMORY_SCOPE_AGENT);
        const unsigned target = nbar * gridDim.x; unsigned sp = 0;
        while (__hip_atomic_load(bar, __ATOMIC_RELAXED, __HIP_MEMORY_SCOPE_AGENT) < target) { __builtin_amdgcn_s_sleep(2); if (++sp > (1u << 24)) break; }
        __builtin_amdgcn_fence(__ATOMIC_ACQUIRE, "agent");
        asm volatile("s_waitcnt vmcnt(0)" ::: "memory");
    }
    __syncthreads();
}

__global__ void __launch_bounds__(512, 2) mk_fwd(Args a) {
    extern __shared__ __attribute__((aligned(16))) unsigned char lds_raw[];
    LAS unsigned char* lds = (LAS unsigned char*)lds_raw;
    const int wave = __builtin_amdgcn_readfirstlane(threadIdx.x >> 6);
    unsigned char* ws = a.ws;
    const int lo = a.ph_lo, hi = a.ph_hi;
    unsigned nbar = 0; unsigned* bar = (unsigned*)(ws + O_BAR);
    volatile LAS unsigned* xst = (volatile LAS unsigned*)(lds + 131072 + 256);
    if (threadIdx.x == 0) { xst[0] = 0u; xst[1] = 0u; }
    __syncthreads();
    const XcdBarrier xb = xcd_barrier_post((unsigned*)(ws + O_XBAR), xst);
    if (lo == 0 && hi == NPHASE) {
        cg::this_grid().sync();
    }
#define IN(k) (lo <= (k) && (k) < hi)
#ifdef PROBE_MASK
#define STAMP(k) do { if (blockIdx.x == 0 && wave == 0 && lane_id() == 0) ((unsigned long long*)(ws + O_TS))[(k)] = __builtin_amdgcn_s_memrealtime(); } while (0)
#else
#define STAMP(k) do { } while (0)
#endif
#define SEAM(k) do { STAMP((k) + 1); if (IN(k) && IN((k) + 1)) xcd_barrier(xb, wave == 0 && lane_id() == 0); } while (0)
    STAMP(0);
    if (IN(0)) phase0(a, lds, wave);
    SEAM(0);
    if (IN(1)) { EpiSeg E{ws}; run_gemm(lds, wave, (const bf16_t*)((unsigned char*)a.out + OO_H), (const bf16_t*)(ws + O_WIN), T, NP1, D, E); }
    SEAM(1);
    if (IN(2)) phase2(a, lds, wave);
    SEAM(2);
    if (IN(3)) phase3(a, lds, wave);
    SEAM(3);
    if (IN(4)) phase4(a, lds, wave);
    SEAM(4);
    if (IN(5)) {
        { EpiGateA E{(const bf16_t*)(ws + O_GA), (bf16_t*)a.out}; run_gemm(lds, wave, (const bf16_t*)(ws + O_OML), (const bf16_t*)(ws + O_WA), T, D, D, E); }
        { EpiGateB E{(const bf16_t*)(ws + O_GB), (const bf16_t*)a.out, (bf16_t*)(ws + O_MERGED)}; run_gemm(lds, wave, (const bf16_t*)(ws + O_QSW), (const bf16_t*)(ws + O_WB), T, D, D, E); }
    }
    SEAM(5);
    if (IN(6)) { EpiRes<false> E{a.in[0], (bf16_t*)a.out, (float*)(ws + O_SSQ1)}; run_gemm(lds, wave, (const bf16_t*)(ws + O_MERGED), (const bf16_t*)(ws + O_WOUT), T, D, D, E); }
    SEAM(6);
    if (IN(7)) { EpiUp E{(const float*)(ws + O_SSQ1), (bf16_t*)(ws + O_ACT)}; run_gemm(lds, wave, (const bf16_t*)a.out, (const bf16_t*)(ws + O_WUP), T, FF, D, E); }
    SEAM(7);
    if (IN(8)) {
        { EpiRes<true> E{a.out, (bf16_t*)(ws + O_X2B), (float*)(ws + O_SSQ2)}; run_gemm(lds, wave, (const bf16_t*)(ws + O_ACT), (const bf16_t*)(ws + O_WDN), T, D, FF, E); }
        { EpiPlain E{(bf16_t*)(ws + O_PP), D}; run_gemm(lds, wave, (const bf16_t*)(ws + O_PB), (const bf16_t*)(ws + O_WP), T, D, PLE, E); }
    }
    SEAM(8);
    if (IN(9)) { EpiPle E{(const float*)(ws + O_SSQ2), (const bf16_t*)(ws + O_PP), (const bf16_t*)(ws + O_X2B), (bf16_t*)(ws + O_X3B), (float*)(ws + O_SSQ3)}; run_gemm(lds, wave, (const bf16_t*)(ws + O_X2B), (const bf16_t*)(ws + O_WG), T, D, D, E); }
    SEAM(9);
    if (IN(10)) phase10(a, wave);
#undef IN
#undef SEAM
}

extern "C" void kernel_launch(void* const* d_in, const int* in_sizes, int n_in, void* d_out, int out_size, void* d_ws, size_t ws_size, hipStream_t stream) {
    static int grid = 0;
    if (grid == 0) {
        if (n_in != 18 || out_size != T * D || ws_size < WS_NEED) { fprintf(stderr, "kernel_launch: unexpected shapes (n_in %d out %d ws %zu)\n", n_in, out_size, ws_size); grid = -1; return; }
        int dev = 0, cus = 0, per_cu = 0;
        if (hipGetDevice(&dev) != hipSuccess || hipDeviceGetAttribute(&cus, hipDeviceAttributeMultiprocessorCount, dev) != hipSuccess) { grid = -1; return; }
        if (hipFuncSetAttribute((const void*)mk_fwd, hipFuncAttributeMaxDynamicSharedMemorySize, LDS_BYTES) != hipSuccess) { fprintf(stderr, "kernel_launch: hipFuncSetAttribute failed\n"); grid = -1; return; }
        if (hipOccupancyMaxActiveBlocksPerMultiprocessor(&per_cu, (const void*)mk_fwd, 512, LDS_BYTES) != hipSuccess || per_cu < 1) per_cu = 1;
        (void)hipGetLastError();
        grid = cus;
    }
    if (grid < 0) return;
    if (hipMemsetAsync((char*)d_ws + O_XBAR, 0, 16384, stream) != hipSuccess) { fprintf(stderr, "kernel_launch: memset failed\n"); return; }
    Args a{};
    for (int i = 0; i < 18; ++i) a.in[i] = (const float*)d_in[i];
    a.out = (float*)d_out; a.ws = (unsigned char*)d_ws;
#if MK_N_LAUNCHES == 1
    a.ph_lo = 0; a.ph_hi = NPHASE;
    void* args[] = {&a};
    hipError_t e = hipLaunchCooperativeKernel((const void*)mk_fwd, dim3(grid), dim3(512), args, LDS_BYTES, stream);
    if (e != hipSuccess) fprintf(stderr, "cooperative launch failed: %s (grid %d)\n", hipGetErrorString(e), grid);
#else
    for (int p = 0; p < NPHASE; ++p) { a.ph_lo = p; a.ph_hi = p + 1; hipLaunchKernelGGL(mk_fwd, dim3(grid), dim3(512), LDS_BYTES, stream, a); }
#endif
}
```

```cpp
#include <hip/hip_runtime.h>
#include <hip/hip_cooperative_groups.h>
#include <cstdio>
#include <cstdint>
namespace cg = cooperative_groups;
namespace pg8 {
#define PG8_LAS __attribute__((address_space(3)))
typedef unsigned short bf16_t;
typedef short bf16x8 __attribute__((ext_vector_type(8)));
typedef float f32x4 __attribute__((ext_vector_type(4)));
typedef unsigned u32x4 __attribute__((ext_vector_type(4)));
constexpr int BM = 256, BK = 64, HALF = 128, HTB = HALF * BK * 2  , STAGE_BYTES = 8 * HTB, NXCD = 8, WGM = 8;

__host__ __device__ __forceinline__ int lds_byte(int r, int c) { const int st = (r >> 4) * 2 + (c >> 5), rr = r & 15, cc = c & 31, ob = rr * 64 + cc * 2; return st * 1024 + (ob ^ (((ob >> 9) & 1) << 5)); }
__host__ __device__ __forceinline__ void stage_rc(int b, int& R, int& C) { const int st = b / 1024, sb = b % 1024, swz = sb ^ (((sb >> 9) & 1) << 5); R = (st >> 1) * 16 + swz / 64; C = (st & 1) * 32 + (swz % 64) / 2; }
__host__ __device__ __forceinline__ int perm32(int rho) { const int n = rho >> 4, i = rho & 15; return 8 * (i >> 2) + 4 * n + (i & 3); }

struct Unit { int pm, pn; };
struct Gemm { const bf16_t* A; const bf16_t* Bt; int M, N, K; };

struct StaticOrder {
    int nM, nN, nwg, G, c;
    __host__ __device__ void init(int M, int N, int G_, int c_) { nM = M / BM; nN = N / BM; nwg = nM * nN; G = G_; c = c_; }
    __host__ __device__ bool next(int i, Unit& u) const {
        const long L = (long)i * G + c; if (L >= nwg) return false;
        int wgid = (int)L; { const int q = nwg / NXCD, r = nwg % NXCD, xcd = wgid % NXCD, off = wgid / NXCD; wgid = (xcd < r ? xcd * (q + 1) : r * (q + 1) + (xcd - r) * q) + off; }
        const int nig = WGM * nN, gid = wgid / nig, fm = gid * WGM, gsz = (nM - fm) < WGM ? (nM - fm) : WGM;
        u.pm = fm + ((wgid % nig) % gsz); u.pn = (wgid % nig) / gsz; return true;
    }
    __device__ __forceinline__ void a_ready(const Unit&) const {}
    __device__ __forceinline__ void done(const Unit&) const {}
};
__device__ __forceinline__ unsigned cvt_pk_bf16(float lo, float hi) { unsigned r; asm volatile("v_cvt_pk_bf16_f32 %0, %1, %2" : "=v"(r) : "v"(lo), "v"(hi)); return r; }
template <class Epi, class Sched, bool ALIGN_EPI = false, bool SP2 = false>
__device__ __forceinline__ void gemm_phase(PG8_LAS unsigned char* lds, const Gemm g, const Sched& S, const Epi& E, const int wid) {
    int lane; asm volatile("v_mbcnt_lo_u32_b32 %0, -1, 0\n\tv_mbcnt_hi_u32_b32 %0, -1, %0" : "=v"(lane));
    const int tid = wid * 64 + lane, wr = wid >> 2, wc = wid & 3, fr = lane & 15, fq = lane >> 4;
    const int K = g.K, nt = K / BK;
    unsigned voffA[2], voffB[2];
#pragma unroll
    for (int i = 0; i < 2; ++i) { int R, C; stage_rc(tid * 16 + i * 8192, R, C); const int Rb = Epi::PERM ? ((R & ~31) + perm32(R & 31)) : R;
        voffA[i] = (unsigned)(R * K + C) * 2u; voffB[i] = (unsigned)(Rb * K + C) * 2u; }
    const size_t kstep = (size_t)(BK * 2);
    const size_t hstep = (size_t)HALF * K * 2;
    const size_t tstep = 2 * hstep;
    const unsigned ldsw = (unsigned)wid * 1024u;
    const int aoff = lds_byte(wr * 64 + fr, fq * 8), boff = lds_byte(wc * 32 + fr, fq * 8);
#define PG8_SA(b, h) (((b) * 2 + (h)) * HTB)
#define PG8_SB(b, h) ((4 + (b) * 2 + (h)) * HTB)
#define PG8_STAGE(bufoff, gbase, voff) do { _Pragma("unroll") for (int _i = 0; _i < 2; ++_i) \
        __builtin_amdgcn_global_load_lds((const unsigned*)((const char*)(gbase) + (voff)[_i]), (PG8_LAS unsigned*)(lds + (bufoff) + ldsw + _i * 8192), 16, 0, 0); } while (0)
#define PG8_LDA(dst, b, h) do { _Pragma("unroll") for (int m = 0; m < 4; ++m) _Pragma("unroll") for (int k = 0; k < 2; ++k) dst[m][k] = *(const PG8_LAS bf16x8*)(lds + PG8_SA(b, h) + aoff + m * 2048 + k * 1024); } while (0)
#define PG8_LDB(dst, b, h) do { _Pragma("unroll") for (int n = 0; n < 2; ++n) _Pragma("unroll") for (int k = 0; k < 2; ++k) dst[n][k] = *(const PG8_LAS bf16x8*)(lds + PG8_SB(b, h) + boff + n * 2048 + k * 1024); } while (0)
#define PG8_MMA(ai, bj, At, Bt) do { __builtin_amdgcn_s_setprio(1); _Pragma("unroll") for (int m = 0; m < 4; ++m) _Pragma("unroll") for (int n = 0; n < 2; ++n) _Pragma("unroll") for (int k = 0; k < 2; ++k) \
        acc[ai][bj][m][n] = __builtin_amdgcn_mfma_f32_16x16x32_bf16(Bt[n][k], At[m][k], acc[ai][bj][m][n], 0, 0, 0); __builtin_amdgcn_s_setprio(0); } while (0)
#define PG8_WAIT_V(n) asm volatile("s_waitcnt vmcnt(" #n ")" ::: "memory")
#define PG8_WAIT_L(n) asm volatile("s_waitcnt lgkmcnt(" #n ")" ::: "memory")
#define PG8_BAR __builtin_amdgcn_s_barrier()
#define PG8_SCHED __builtin_amdgcn_sched_barrier(0)
    Unit cur, nxt; int ui = 0;
    if (!S.next(0, cur)) return;
    f32x4 acc[2][2][4][2];
#pragma unroll
    for (int a = 0; a < 2; ++a)
#pragma unroll
        for (int b = 0; b < 2; ++b)
#pragma unroll
            for (int m = 0; m < 4; ++m)
#pragma unroll
                for (int n = 0; n < 2; ++n) acc[a][b][m][n] = (f32x4){0.f, 0.f, 0.f, 0.f};
    bf16x8 At[4][2], B0[2][2], B1[2][2];
    const char* cA = (const char*)g.A + (size_t)cur.pm * tstep; const char* cB = (const char*)g.Bt + (size_t)cur.pn * tstep;
    S.a_ready(cur);
    if constexpr (SP2) {
        PG8_STAGE(PG8_SB(0, 0), cB, voffB); PG8_STAGE(PG8_SB(0, 1), cB + hstep, voffB); PG8_STAGE(PG8_SA(0, 0), cA, voffA); PG8_STAGE(PG8_SA(0, 1), cA + hstep, voffA);
        if (wr == 1) PG8_BAR;
        PG8_WAIT_V(2); PG8_BAR;
        PG8_STAGE(PG8_SB(1, 0), cB + kstep, voffB); PG8_STAGE(PG8_SA(1, 0), cA + kstep, voffA); PG8_STAGE(PG8_SB(1, 1), cB + hstep + kstep, voffB);
        PG8_WAIT_V(6); PG8_BAR;
    } else {
        PG8_STAGE(PG8_SB(0, 0), cB, voffB); PG8_STAGE(PG8_SA(0, 0), cA, voffA); PG8_STAGE(PG8_SB(0, 1), cB + hstep, voffB); PG8_STAGE(PG8_SA(0, 1), cA + hstep, voffA);
        if (wr == 1) PG8_BAR;
        PG8_WAIT_V(4); PG8_BAR;
        PG8_STAGE(PG8_SB(1, 0), cB + kstep, voffB); PG8_STAGE(PG8_SA(1, 0), cA + kstep, voffA); PG8_STAGE(PG8_SB(1, 1), cB + hstep + kstep, voffB);
        PG8_WAIT_V(6); PG8_BAR;
    }
    for (;;) {
        const bool has_next = S.next(ui + 1, nxt);
        const char* nA = has_next ? (const char*)g.A + (size_t)nxt.pm * tstep : cA; const char* nB = has_next ? (const char*)g.Bt + (size_t)nxt.pn * tstep : cB;
        for (int t = 0; t < nt; t += 2) {
            const bool last = (t == nt - 2);
            const char* a1 = cA + (size_t)(t + 1) * kstep;
            const char* a2 = last ? nA : cA + (size_t)(t + 2) * kstep; const char* b2 = last ? nB : cB + (size_t)(t + 2) * kstep;
            const char* a3 = a2 + kstep; const char* b3 = b2 + kstep;
            if (last && has_next) S.a_ready(nxt);
            if constexpr (SP2) {
            PG8_LDB(B0, 0, 0); PG8_LDB(B1, 0, 1); PG8_SCHED; PG8_LDA(At, 0, 0); PG8_STAGE(PG8_SA(1, 1), a1 + hstep, voffA);
            PG8_WAIT_V(8); PG8_WAIT_L(0); PG8_BAR; PG8_MMA(0, 0, At, B0); PG8_MMA(0, 1, At, B1); PG8_BAR; PG8_SCHED;
            PG8_LDA(At, 0, 1); PG8_STAGE(PG8_SB(0, 0), b2, voffB); PG8_STAGE(PG8_SB(0, 1), b2 + hstep, voffB); PG8_STAGE(PG8_SA(0, 0), a2, voffA);
            PG8_WAIT_V(8); PG8_WAIT_L(0); PG8_BAR; PG8_MMA(1, 0, At, B0); PG8_MMA(1, 1, At, B1); PG8_BAR; PG8_SCHED;
            PG8_LDB(B0, 1, 0); PG8_LDB(B1, 1, 1); PG8_SCHED; PG8_LDA(At, 1, 0); PG8_STAGE(PG8_SA(0, 1), a2 + hstep, voffA);
            PG8_WAIT_V(8); PG8_WAIT_L(0); PG8_BAR; PG8_MMA(0, 0, At, B0); PG8_MMA(0, 1, At, B1); PG8_BAR; PG8_SCHED;
            PG8_LDA(At, 1, 1); PG8_STAGE(PG8_SB(1, 0), b3, voffB); PG8_STAGE(PG8_SB(1, 1), b3 + hstep, voffB); PG8_STAGE(PG8_SA(1, 0), a3, voffA);
            PG8_WAIT_V(8); PG8_WAIT_L(0); PG8_BAR; PG8_MMA(1, 0, At, B0); PG8_MMA(1, 1, At, B1); PG8_BAR; PG8_SCHED;
            } else {
            PG8_LDB(B0, 0, 0); PG8_SCHED; PG8_LDA(At, 0, 0); PG8_STAGE(PG8_SA(1, 1), a1 + hstep, voffA);
            PG8_WAIT_L(8); PG8_BAR; PG8_WAIT_L(0); PG8_MMA(0, 0, At, B0); PG8_BAR; PG8_SCHED;
            PG8_LDB(B1, 0, 1); PG8_STAGE(PG8_SB(0, 0), b2, voffB);
            PG8_BAR; PG8_WAIT_L(0); PG8_MMA(0, 1, At, B1); PG8_BAR;
            PG8_LDA(At, 0, 1); PG8_STAGE(PG8_SA(0, 0), a2, voffA);
            PG8_BAR; PG8_WAIT_L(0); PG8_MMA(1, 0, At, B0); PG8_BAR; PG8_SCHED;
            PG8_STAGE(PG8_SB(0, 1), b2 + hstep, voffB);
            PG8_WAIT_V(6); PG8_BAR; PG8_MMA(1, 1, At, B1); PG8_BAR;
            PG8_LDB(B0, 1, 0); PG8_SCHED; PG8_LDA(At, 1, 0); PG8_STAGE(PG8_SA(0, 1), a2 + hstep, voffA);
            PG8_WAIT_L(8); PG8_BAR; PG8_WAIT_L(0); PG8_MMA(0, 0, At, B0); PG8_BAR; PG8_SCHED;
            PG8_LDB(B1, 1, 1); PG8_STAGE(PG8_SB(1, 0), b3, voffB);
            PG8_BAR; PG8_WAIT_L(0); PG8_MMA(0, 1, At, B1); PG8_BAR;
            PG8_LDA(At, 1, 1); PG8_STAGE(PG8_SA(1, 0), a3, voffA);
            PG8_BAR; PG8_WAIT_L(0); PG8_MMA(1, 0, At, B0); PG8_BAR; PG8_SCHED;
            PG8_STAGE(PG8_SB(1, 1), b3 + hstep, voffB);
            PG8_WAIT_V(6); PG8_BAR; PG8_MMA(1, 1, At, B1); PG8_BAR;
            }
        }
        if constexpr (ALIGN_EPI) { if (wr == 0) PG8_BAR; }
        if constexpr (!Epi::AFTER_DRAIN) { E(acc, cur, wr, wc, fr, fq); S.done(cur); }
        if (!has_next) break;
#pragma unroll
        for (int a = 0; a < 2; ++a)
#pragma unroll
            for (int b = 0; b < 2; ++b)
#pragma unroll
                for (int m = 0; m < 4; ++m)
#pragma unroll
                    for (int n = 0; n < 2; ++n) acc[a][b][m][n] = (f32x4){0.f, 0.f, 0.f, 0.f};
        cur = nxt; cA = nA; cB = nB; ++ui;
        if constexpr (ALIGN_EPI) { if (wr == 1) PG8_BAR; }
    }
    PG8_WAIT_V(0);
    if constexpr (!ALIGN_EPI) { if (wr == 0) PG8_BAR; }
    PG8_BAR;
    if constexpr (Epi::AFTER_DRAIN) { E.fused(acc, cur, wr, wc, fr, fq, lds, wid, lane); S.done(cur); }
#undef PG8_SA
#undef PG8_SB
#undef PG8_STAGE
#undef PG8_LDA
#undef PG8_LDB
#undef PG8_MMA
#undef PG8_WAIT_V
#undef PG8_WAIT_L
#undef PG8_BAR
#undef PG8_SCHED
}
}

#ifndef MK_N_LAUNCHES
#define MK_N_LAUNCHES 1
#endif
constexpr int NB = 4, SEQ = 8192, T = NB * SEQ, D = 1024, NIN = 6664, NP1 = 6656, FF = 4096, PLE = 256;
constexpr int NCH = SEQ / 64;
constexpr int CROWS = 272;
constexpr float EPS = 1e-6f;
constexpr int NPHASE = 11;
typedef pg8::bf16_t bf16_t;
typedef pg8::bf16x8 bf16x8;
typedef pg8::f32x4 f32x4;
typedef pg8::u32x4 u32x4;
typedef unsigned u32x2 __attribute__((ext_vector_type(2)));
#define LAS __attribute__((address_space(3)))

constexpr size_t MiB = 1u << 20;
constexpr size_t O_WIN = 0, O_WA = 13 * MiB, O_WB = 15 * MiB, O_WOUT = 17 * MiB, O_WG = 19 * MiB, O_WUP = 21 * MiB, O_WDN = 29 * MiB, O_WP = 37 * MiB;
constexpr size_t O_GWH = 37 * MiB + 512 * 1024, O_CBL = O_GWH + 256 * 1024, O_CMW = O_CBL + 8192, O_CAMAX = O_CMW + 8192, O_CM = O_CAMAX + 8192, O_CTR = O_CM + 8192, O_BAR = O_CTR + 256, O_TS = O_BAR + 256, O_DUMMY = O_TS + 1024, O_XBAR = 39 * MiB;
constexpr size_t O_QK = 40 * MiB, O_VML = 104 * MiB, O_VSW = 168 * MiB, O_KSW = 184 * MiB, O_OML = 200 * MiB, O_QSW = 264 * MiB, O_GA = 328 * MiB, O_GB = 392 * MiB;
constexpr size_t O_KT = 456 * MiB, O_VTSW = 488 * MiB, O_SSQ1 = 504 * MiB, O_SSQ2 = 506 * MiB, O_SSQ3 = 508 * MiB;
constexpr size_t O_GIG = 510 * MiB, O_GLF = O_GIG + 512 * 1024, O_GBC = 511 * MiB, O_GL = O_GBC + 512 * 1024;
constexpr size_t O_CST = 40 * MiB;
constexpr size_t O_MERGED = 40 * MiB, O_X1B = 104 * MiB, O_ACT = 200 * MiB, O_X2B = 40 * MiB, O_PB = 456 * MiB, O_PP = 104 * MiB, O_X3B = 200 * MiB;
constexpr size_t WS_NEED = 512 * MiB;
constexpr size_t OO_H = 0, OO_QKP = 0, OO_VT = 64 * MiB;
constexpr int LDS_BYTES = 147456;

__device__ __forceinline__ int lane_id() { int l; asm volatile("v_mbcnt_lo_u32_b32 %0, -1, 0\n\tv_mbcnt_hi_u32_b32 %0, -1, %0" : "=v"(l)); return l; }
__device__ __forceinline__ unsigned pk2(float lo, float hi) { return pg8::cvt_pk_bf16(lo, hi); }
__device__ __forceinline__ float bflo(unsigned w) { return __builtin_bit_cast(float, w << 16); }
__device__ __forceinline__ float bfhi(unsigned w) { return __builtin_bit_cast(float, w & 0xffff0000u); }
__device__ __forceinline__ float sigm(float x) { return __builtin_amdgcn_rcpf(1.f + __expf(-x)); }
__device__ __forceinline__ float wave_sum(float v) {
#pragma unroll
    for (int o = 1; o < 64; o <<= 1) v += __shfl_xor(v, o);
    return v;
}
__device__ __forceinline__ float wave_max(float v) {
#pragma unroll
    for (int o = 1; o < 64; o <<= 1) v = fmaxf(v, __shfl_xor(v, o));
    return v;
}
__device__ __forceinline__ bf16x8 ld8(const bf16_t* p) { return *(const bf16x8*)p; }
__device__ __forceinline__ f32x4 mfma16(bf16x8 a, bf16x8 b, f32x4 c) { return __builtin_amdgcn_mfma_f32_16x16x32_bf16(a, b, c, 0, 0, 0); }
__device__ __forceinline__ bf16x8 scale8(bf16x8 v, float s) {
    u32x4 u = __builtin_bit_cast(u32x4, v), o;
    o.x = pk2(bflo(u.x) * s, bfhi(u.x) * s); o.y = pk2(bflo(u.y) * s, bfhi(u.y) * s); o.z = pk2(bflo(u.z) * s, bfhi(u.z) * s); o.w = pk2(bflo(u.w) * s, bfhi(u.w) * s);
    return __builtin_bit_cast(bf16x8, o);
}
__device__ __forceinline__ size_t tpos(int row, int s) { return (size_t)row * SEQ + (size_t)(((((s >> 6) + row) & 127) << 6) + (s & 63)); }
__device__ __forceinline__ void st16_nt(void* p, u32x4 v) { asm volatile("global_store_dwordx4 %0, %1, off nt" :: "v"(p), "v"(v) : "memory"); }
__device__ __forceinline__ float rdlane(float v, int l) { return __builtin_bit_cast(float, __builtin_amdgcn_readlane(__builtin_bit_cast(int, v), l)); }

#define EPI_LOOP_BEGIN const int row0 = u.pm * 256 + wr * 64 + fr, col0 = u.pn * 256 + wc * 32 + 8 * fq; \
    _Pragma("unroll") for (int ai = 0; ai < 2; ++ai) _Pragma("unroll") for (int m = 0; m < 4; ++m) { const int row = row0 + ai * 128 + m * 16;
#define EPI_LOOP_END }
typedef pg8::Unit Unit;

struct EpiSeg {
    static constexpr bool PERM = true, AFTER_DRAIN = false;
    unsigned char* ws;
    __device__ __forceinline__ void operator()(const f32x4 (&acc)[2][2][4][2], const Unit& u, int wr, int wc, int fr, int fq) const {
        const int pn = u.pn; size_t off; int ldc, ct;
        if (pn < 4) { off = O_QK; ldc = 1024; ct = pn; } else if (pn < 8) { off = O_VML; ldc = 1024; ct = pn - 4; } else if (pn < 12) { off = O_OML; ldc = 1024; ct = pn - 8; }
        else if (pn < 16) { off = O_QSW; ldc = 1024; ct = pn - 12; } else if (pn < 17) { off = O_KSW; ldc = 256; ct = 0; } else if (pn < 18) { off = O_VSW; ldc = 256; ct = 0; }
        else if (pn < 22) { off = O_GA; ldc = 1024; ct = pn - 18; } else { off = O_GB; ldc = 1024; ct = pn - 22; }
        bf16_t* base = (bf16_t*)(ws + off) + ct * 256 + wc * 32 + 8 * fq;
        const int row0 = u.pm * 256 + wr * 64 + fr;
#pragma unroll
        for (int ai = 0; ai < 2; ++ai)
#pragma unroll
            for (int m = 0; m < 4; ++m) { bf16_t* rowp = base + (size_t)(row0 + ai * 128 + m * 16) * ldc;
#pragma unroll
                for (int bj = 0; bj < 2; ++bj) { const f32x4 v0 = acc[ai][bj][m][0], v1 = acc[ai][bj][m][1]; u32x4 w;
                    w.x = pk2(v0[0], v0[1]); w.y = pk2(v0[2], v0[3]); w.z = pk2(v1[0], v1[1]); w.w = pk2(v1[2], v1[3]); *(u32x4*)(rowp + bj * 128) = w; } }
    }
};
struct EpiPlain {
    static constexpr bool PERM = true, AFTER_DRAIN = false;
    bf16_t* O; int ldc;
    __device__ __forceinline__ void operator()(const f32x4 (&acc)[2][2][4][2], const Unit& u, int wr, int wc, int fr, int fq) const {
        EPI_LOOP_BEGIN
#pragma unroll
            for (int bj = 0; bj < 2; ++bj) { const f32x4 v0 = acc[ai][bj][m][0], v1 = acc[ai][bj][m][1]; u32x4 w;
                w.x = pk2(v0[0], v0[1]); w.y = pk2(v0[2], v0[3]); w.z = pk2(v1[0], v1[1]); w.w = pk2(v1[2], v1[3]); *(u32x4*)(O + (size_t)row * ldc + col0 + bj * 128) = w; }
        EPI_LOOP_END
    }
};
#define EPI_ROWCOL const int row0 = u.pm * 256 + wr * 64 + fr, col0 = u.pn * 256 + wc * 32 + 8 * fq;
struct EpiGateA {
    static constexpr bool PERM = true, AFTER_DRAIN = false;
    const bf16_t* G; bf16_t* M1;
    __device__ __forceinline__ void operator()(const f32x4 (&acc)[2][2][4][2], const Unit& u, int wr, int wc, int fr, int fq) const {
        EPI_ROWCOL
#pragma unroll
        for (int ai = 0; ai < 2; ++ai)
#pragma unroll
          for (int mh = 0; mh < 2; ++mh) { u32x4 g[2][2];
#pragma unroll
            for (int mm = 0; mm < 2; ++mm)
#pragma unroll
                for (int bj = 0; bj < 2; ++bj) g[mm][bj] = *(const u32x4*)(G + (size_t)(row0 + ai * 128 + (2 * mh + mm) * 16) * D + col0 + bj * 128);
#pragma unroll
            for (int mm = 0; mm < 2; ++mm)
#pragma unroll
                for (int bj = 0; bj < 2; ++bj) { const int m = 2 * mh + mm; const size_t idx = (size_t)(row0 + ai * 128 + m * 16) * D + col0 + bj * 128; const u32x4 gv = g[mm][bj];
                    const f32x4 v0 = acc[ai][bj][m][0], v1 = acc[ai][bj][m][1]; f32x4 o0, o1;
                    o0[0] = sigm(bflo(gv.x)) * v0[0]; o0[1] = sigm(bfhi(gv.x)) * v0[1]; o0[2] = sigm(bflo(gv.y)) * v0[2]; o0[3] = sigm(bfhi(gv.y)) * v0[3];
                    o1[0] = sigm(bflo(gv.z)) * v1[0]; o1[1] = sigm(bfhi(gv.z)) * v1[1]; o1[2] = sigm(bflo(gv.w)) * v1[2]; o1[3] = sigm(bfhi(gv.w)) * v1[3];
                    u32x4 w; w.x = pk2(o0[0], o0[1]); w.y = pk2(o0[2], o0[3]); w.z = pk2(o1[0], o1[1]); w.w = pk2(o1[2], o1[3]); *(u32x4*)(M1 + idx) = w; } }
    }
};
struct EpiGateB {
    static constexpr bool PERM = true, AFTER_DRAIN = false;
    const bf16_t* G; const bf16_t* M1; bf16_t* O;
    __device__ __forceinline__ void operator()(const f32x4 (&acc)[2][2][4][2], const Unit& u, int wr, int wc, int fr, int fq) const {
        EPI_ROWCOL
#pragma unroll
        for (int ai = 0; ai < 2; ++ai)
#pragma unroll
            for (int mh = 0; mh < 2; ++mh) { u32x4 g[2][2], am[2][2];
#pragma unroll
                for (int mm = 0; mm < 2; ++mm)
#pragma unroll
                    for (int bj = 0; bj < 2; ++bj) { const size_t idx = (size_t)(row0 + ai * 128 + (2 * mh + mm) * 16) * D + col0 + bj * 128;
                        g[mm][bj] = *(const u32x4*)(G + idx); am[mm][bj] = *(const u32x4*)(M1 + idx); }
#pragma unroll
                for (int mm = 0; mm < 2; ++mm)
#pragma unroll
                    for (int bj = 0; bj < 2; ++bj) { const int m = 2 * mh + mm; const size_t idx = (size_t)(row0 + ai * 128 + m * 16) * D + col0 + bj * 128; const u32x4 gv = g[mm][bj];
                        const f32x4 v0 = acc[ai][bj][m][0], v1 = acc[ai][bj][m][1]; const u32x4 mv = am[mm][bj]; const f32x4 b0 = {bflo(mv.x), bfhi(mv.x), bflo(mv.y), bfhi(mv.y)}, b1 = {bflo(mv.z), bfhi(mv.z), bflo(mv.w), bfhi(mv.w)}; u32x4 w;
                        w.x = pk2(b0[0] + sigm(bflo(gv.x)) * v0[0], b0[1] + sigm(bfhi(gv.x)) * v0[1]); w.y = pk2(b0[2] + sigm(bflo(gv.y)) * v0[2], b0[3] + sigm(bfhi(gv.y)) * v0[3]);
                        w.z = pk2(b1[0] + sigm(bflo(gv.z)) * v1[0], b1[1] + sigm(bfhi(gv.z)) * v1[1]); w.w = pk2(b1[2] + sigm(bflo(gv.w)) * v1[2], b1[3] + sigm(bfhi(gv.w)) * v1[3]);
                        *(u32x4*)(O + idx) = w; } }
    }
};
template <bool XBF> struct EpiRes {
    static constexpr bool PERM = true, AFTER_DRAIN = false;
    const void* XI; bf16_t* XB; float* SSQ;
    __device__ __forceinline__ void operator()(const f32x4 (&acc)[2][2][4][2], const Unit& u, int wr, int wc, int fr, int fq) const {
        EPI_ROWCOL
#pragma unroll
        for (int ai = 0; ai < 2; ++ai)
#pragma unroll
          for (int mh = 0; mh < 2; ++mh) { f32x4 x0[2][2], x1[2][2];
#pragma unroll
            for (int mm = 0; mm < 2; ++mm)
#pragma unroll
                for (int bj = 0; bj < 2; ++bj) { const size_t idx = (size_t)(row0 + ai * 128 + (2 * mh + mm) * 16) * D + col0 + bj * 128;
                    if (XBF) { const u32x4 v = *(const u32x4*)((const bf16_t*)XI + idx); x0[mm][bj] = (f32x4){bflo(v.x), bfhi(v.x), bflo(v.y), bfhi(v.y)}; x1[mm][bj] = (f32x4){bflo(v.z), bfhi(v.z), bflo(v.w), bfhi(v.w)}; }
                    else { x0[mm][bj] = *(const f32x4*)((const float*)XI + idx); x1[mm][bj] = *(const f32x4*)((const float*)XI + idx + 4); } }
#pragma unroll
            for (int mm = 0; mm < 2; ++mm) { const int m = 2 * mh + mm, row = row0 + ai * 128 + m * 16; float ss = 0.f;
#pragma unroll
                for (int bj = 0; bj < 2; ++bj) { const size_t idx = (size_t)row * D + col0 + bj * 128;
                    const f32x4 o0 = x0[mm][bj] + acc[ai][bj][m][0], o1 = x1[mm][bj] + acc[ai][bj][m][1];
                    u32x4 w; w.x = pk2(o0[0], o0[1]); w.y = pk2(o0[2], o0[3]); w.z = pk2(o1[0], o1[1]); w.w = pk2(o1[2], o1[3]); *(u32x4*)(XB + idx) = w;
                    ss += (o0[0] * o0[0] + o0[1] * o0[1]) + (o0[2] * o0[2] + o0[3] * o0[3]) + (o1[0] * o1[0] + o1[1] * o1[1]) + (o1[2] * o1[2] + o1[3] * o1[3]); }
                ss += __shfl_xor(ss, 16); ss += __shfl_xor(ss, 32);
                if (fq == 0) SSQ[(size_t)row * 16 + u.pn * 4 + wc] = ss; } }
    }
};
__device__ __forceinline__ float row_rstd(const float* SSQ, int row) {
    const f32x4* p = (const f32x4*)(SSQ + (size_t)row * 16); const f32x4 a = p[0], b = p[1], c = p[2], d = p[3];
    const float s = ((a[0] + a[1]) + (a[2] + a[3])) + ((b[0] + b[1]) + (b[2] + b[3])) + ((c[0] + c[1]) + (c[2] + c[3])) + ((d[0] + d[1]) + (d[2] + d[3]));
    return rsqrtf(s * (1.f / D) + EPS);
}
__device__ __forceinline__ float row_rstd4(const float* SSQ, int row, int fq) {
    const f32x4 a = ((const f32x4*)(SSQ + (size_t)row * 16))[fq]; float s = (a[0] + a[1]) + (a[2] + a[3]);
    s += __shfl_xor(s, 16); s += __shfl_xor(s, 32);
    return rsqrtf(s * (1.f / D) + EPS);
}
struct EpiUp {
    static constexpr bool PERM = true, AFTER_DRAIN = false;
    const float* SSQ; bf16_t* O;
    __device__ __forceinline__ void operator()(const f32x4 (&acc)[2][2][4][2], const Unit& u, int wr, int wc, int fr, int fq) const {
        EPI_ROWCOL
        float rsv[2][4];
#pragma unroll
        for (int ai = 0; ai < 2; ++ai)
#pragma unroll
            for (int m = 0; m < 4; ++m) rsv[ai][m] = row_rstd4(SSQ, row0 + ai * 128 + m * 16, fq);
#pragma unroll
        for (int ai = 0; ai < 2; ++ai)
#pragma unroll
            for (int m = 0; m < 4; ++m) { const int row = row0 + ai * 128 + m * 16; const float rs = rsv[ai][m];
#pragma unroll
                for (int bj = 0; bj < 2; ++bj) { f32x4 v0 = acc[ai][bj][m][0] * rs, v1 = acc[ai][bj][m][1] * rs;
#pragma unroll
                    for (int e = 0; e < 4; ++e) { const float a = fmaxf(v0[e], 0.f), b = fmaxf(v1[e], 0.f); v0[e] = a * a; v1[e] = b * b; }
                    u32x4 w; w.x = pk2(v0[0], v0[1]); w.y = pk2(v0[2], v0[3]); w.z = pk2(v1[0], v1[1]); w.w = pk2(v1[2], v1[3]); *(u32x4*)(O + (size_t)row * FF + col0 + bj * 128) = w; } }
    }
};
struct EpiPle {
    static constexpr bool PERM = true, AFTER_DRAIN = false;
    const float* SSQI; const bf16_t* PP; const bf16_t* XR; bf16_t* X; float* SSQO;
    __device__ __forceinline__ void operator()(const f32x4 (&acc)[2][2][4][2], const Unit& u, int wr, int wc, int fr, int fq) const {
        EPI_ROWCOL
        float rsv[2][4];
#pragma unroll
        for (int ai = 0; ai < 2; ++ai)
#pragma unroll
            for (int m = 0; m < 4; ++m) rsv[ai][m] = row_rstd4(SSQI, row0 + ai * 128 + m * 16, fq);
#pragma unroll
        for (int ai = 0; ai < 2; ++ai)
#pragma unroll
            for (int mh = 0; mh < 2; ++mh) { u32x4 pv[2][2], xv[2][2];
#pragma unroll
                for (int mm = 0; mm < 2; ++mm)
#pragma unroll
                    for (int bj = 0; bj < 2; ++bj) { const size_t idx = (size_t)(row0 + ai * 128 + (2 * mh + mm) * 16) * D + col0 + bj * 128;
                        pv[mm][bj] = *(const u32x4*)(PP + idx); xv[mm][bj] = *(const u32x4*)(XR + idx); }
#pragma unroll
                for (int mm = 0; mm < 2; ++mm) { const int m = 2 * mh + mm, row = row0 + ai * 128 + m * 16; const float rs = rsv[ai][m]; float ss = 0.f;
#pragma unroll
                    for (int bj = 0; bj < 2; ++bj) { const size_t idx = (size_t)row * D + col0 + bj * 128; const u32x4 p = pv[mm][bj];
                        const f32x4 v0 = acc[ai][bj][m][0] * rs, v1 = acc[ai][bj][m][1] * rs; const u32x4 xr = xv[mm][bj]; f32x4 o0 = {bflo(xr.x), bfhi(xr.x), bflo(xr.y), bfhi(xr.y)}, o1 = {bflo(xr.z), bfhi(xr.z), bflo(xr.w), bfhi(xr.w)};
                        o0[0] += sigm(v0[0]) * bflo(p.x); o0[1] += sigm(v0[1]) * bfhi(p.x); o0[2] += sigm(v0[2]) * bflo(p.y); o0[3] += sigm(v0[3]) * bfhi(p.y);
                        o1[0] += sigm(v1[0]) * bflo(p.z); o1[1] += sigm(v1[1]) * bfhi(p.z); o1[2] += sigm(v1[2]) * bflo(p.w); o1[3] += sigm(v1[3]) * bfhi(p.w);
                        { u32x4 w; w.x = pk2(o0[0], o0[1]); w.y = pk2(o0[2], o0[3]); w.z = pk2(o1[0], o1[1]); w.w = pk2(o1[2], o1[3]); *(u32x4*)(X + idx) = w; }
                        ss += (o0[0] * o0[0] + o0[1] * o0[1]) + (o0[2] * o0[2] + o0[3] * o0[3]) + (o1[0] * o1[0] + o1[1] * o1[1]) + (o1[2] * o1[2] + o1[3] * o1[3]); }
                    ss += __shfl_xor(ss, 16); ss += __shfl_xor(ss, 32);
                    if (fq == 0) SSQO[(size_t)row * 16 + u.pn * 4 + wc] = ss; } }
    }
};

template <class Epi> __device__ __forceinline__ void run_gemm(LAS unsigned char* lds, int wave, const bf16_t* A, const bf16_t* Bt, int M, int N, int K, const Epi& E) {
    pg8::Gemm g{A, Bt, M, N, K}; pg8::StaticOrder S; S.init(M, N, (int)gridDim.x, (int)blockIdx.x);
    pg8::gemm_phase<Epi, pg8::StaticOrder, true, true>(lds, g, S, E, wave);
}

__device__ __forceinline__ void p0_transpose_item(const float* W, int ldw, int K, int nblk, bf16_t* WT, const float* ksc, LAS float* scr, int item, int lane) {
    const int kb = item / nblk, nb = item % nblk, k0 = 64 * kb, n0 = 32 * nb;
#pragma unroll 8
    for (int i = 0; i < 32; ++i) { const int kk = 2 * i + (lane >> 5); float v = W[(size_t)(k0 + kk) * ldw + n0 + (lane & 31)]; if (ksc) v *= ksc[k0 + kk]; scr[kk * 33 + (lane & 31)] = v; }
    asm volatile("s_waitcnt lgkmcnt(0)" ::: "memory");
    const int c = lane & 7;
#pragma unroll
    for (int j = 0; j < 4; ++j) { const int n = (lane >> 3) + 8 * j; const LAS float* s = scr + (8 * c) * 33 + n;
        u32x4 o; o.x = pk2(s[0 * 33], s[1 * 33]); o.y = pk2(s[2 * 33], s[3 * 33]); o.z = pk2(s[4 * 33], s[5 * 33]); o.w = pk2(s[6 * 33], s[7 * 33]);
        *(u32x4*)(WT + (size_t)(n0 + n) * K + k0 + 8 * c) = o; }
    asm volatile("s_waitcnt lgkmcnt(0)" ::: "memory");
}
__device__ __forceinline__ float logsigmoid(float z) { return fminf(z, 0.f) - log1pf(__expf(-fabsf(z))); }

struct Args { const float* in[18]; float* out; unsigned char* ws; int ph_lo, ph_hi; };

__device__ __forceinline__ void phase0(const Args& a, LAS unsigned char* lds, int wave) {
    const int lane = lane_id();
    unsigned char* ws = a.ws;
    LAS float* scr = (LAS float*)(lds + wave * 16384);
    const int gw = blockIdx.x * 8 + wave, NGW = gridDim.x * 8;
    if (blockIdx.x == 0 && wave == 0 && lane == 0) *(unsigned*)(ws + O_CTR) = 0u;
    constexpr int I_IN1 = 16 * 96, I_IN2 = 16 * 112, I_SQ = 16 * 32, I_UP = 16 * 128, I_DN = 64 * 32, I_P = 4 * 32;
    constexpr int NITEMS = I_IN1 + I_IN2 + 4 * I_SQ + I_UP + I_DN + I_P;
    const float* w_in = a.in[3];
    for (int it = gw; it < NITEMS; it += NGW) {
        int r = it;
        if (r < I_IN1) { p0_transpose_item(w_in, NIN, D, 96, (bf16_t*)(ws + O_WIN), nullptr, scr, r, lane); continue; } r -= I_IN1;
        if (r < I_IN2) { p0_transpose_item(w_in + 3080, NIN, D, 112, (bf16_t*)(ws + O_WIN) + (size_t)3072 * D, nullptr, scr, r, lane); continue; } r -= I_IN2;
        if (r < I_SQ) { p0_transpose_item(a.in[8], D, D, 32, (bf16_t*)(ws + O_WA), nullptr, scr, r, lane); continue; } r -= I_SQ;
        if (r < I_SQ) { p0_transpose_item(a.in[9], D, D, 32, (bf16_t*)(ws + O_WB), nullptr, scr, r, lane); continue; } r -= I_SQ;
        if (r < I_SQ) { p0_transpose_item(a.in[10], D, D, 32, (bf16_t*)(ws + O_WOUT), nullptr, scr, r, lane); continue; } r -= I_SQ;
        if (r < I_SQ) { p0_transpose_item(a.in[15], D, D, 32, (bf16_t*)(ws + O_WG), a.in[14], scr, r, lane); continue; } r -= I_SQ;
        if (r < I_UP) { p0_transpose_item(a.in[12], FF, D, 128, (bf16_t*)(ws + O_WUP), a.in[11], scr, r, lane); continue; } r -= I_UP;
        if (r < I_DN) { p0_transpose_item(a.in[13], D, FF, 32, (bf16_t*)(ws + O_WDN), nullptr, scr, r, lane); continue; } r -= I_DN;
        p0_transpose_item(a.in[16], D, PLE, 32, (bf16_t*)(ws + O_WP), nullptr, scr, r, lane);
    }
    const float* x = a.in[0]; const float* g = a.in[2]; const float* bif = a.in[5];
    __syncthreads();
    LAS float* wgT = (LAS float*)lds;
    { const int t = wave * 64 + lane;
#pragma unroll
      for (int i = 0; i < 2; ++i) { const int k = 2 * t + i; const f32x4* wr = (const f32x4*)(w_in + (size_t)k * NIN + 3072); const f32x4 w0 = wr[0], w1 = wr[1];
          wgT[0 * 1024 + k] = w0[0]; wgT[1 * 1024 + k] = w0[1]; wgT[2 * 1024 + k] = w0[2]; wgT[3 * 1024 + k] = w0[3]; wgT[4 * 1024 + k] = w1[0]; wgT[5 * 1024 + k] = w1[1]; wgT[6 * 1024 + k] = w1[2]; wgT[7 * 1024 + k] = w1[3]; } }
    __syncthreads();
    bf16_t* H = (bf16_t*)((unsigned char*)a.out + OO_H);
    float* gig = (float*)(ws + O_GIG); float* glf = (float*)(ws + O_GLF);
    f32x4 vv[2][4];
#define P0_LOAD(VV, row_) do { _Pragma("unroll") for (int k = 0; k < 2; ++k) { int r = (row_) + k * NGW; r = r < T ? r : T - 1; const f32x4* xr = (const f32x4*)(x + (size_t)r * D) + lane; \
            _Pragma("unroll") for (int j = 0; j < 4; ++j) VV[k][j] = xr[64 * j]; } } while (0)
    P0_LOAD(vv, gw);
    for (int rowp = gw; rowp < T; rowp += 2 * NGW) {
        f32x4 vn[2][4];
        P0_LOAD(vn, rowp + 2 * NGW);
#pragma unroll
        for (int k = 0; k < 2; ++k) { const int row = rowp + k * NGW; const f32x4* gr = (const f32x4*)g + lane;
        float s = 0.f;
#pragma unroll
        for (int j = 0; j < 4; ++j) { const f32x4 v = vv[k][j]; s += (v[0] * v[0] + v[1] * v[1]) + (v[2] * v[2] + v[3] * v[3]); }
        const float rstd = rsqrtf(wave_sum(s) * (1.f / D) + EPS);
        float g8[8];
#pragma unroll
        for (int e = 0; e < 8; ++e) g8[e] = 0.f;
        u32x2* o8 = (u32x2*)(H + (size_t)row * D) + lane;
#pragma unroll
        for (int j = 0; j < 4; ++j) { const f32x4 hv = vv[k][j] * rstd * gr[64 * j]; u32x2 o; o.x = pk2(hv[0], hv[1]); o.y = pk2(hv[2], hv[3]); o8[64 * j] = o;
#pragma unroll
            for (int c = 0; c < 8; ++c) { const f32x4 w4 = *(const LAS f32x4*)(wgT + c * 1024 + 4 * lane + 256 * j); g8[c] += (hv[0] * w4[0] + hv[1] * w4[1]) + (hv[2] * w4[2] + hv[3] * w4[3]); } }
#pragma unroll
        for (int e = 0; e < 8; ++e) g8[e] = wave_sum(g8[e]);
        if (lane == 0) { const int b = row / SEQ, s_ = row % SEQ;
#pragma unroll
            for (int hh = 0; hh < 4; ++hh) { gig[(size_t)(b * 4 + hh) * SEQ + s_] = g8[hh] + bif[hh]; glf[(size_t)(b * 4 + hh) * SEQ + s_] = logsigmoid(g8[4 + hh] + bif[4 + hh]); } }
        }
#pragma unroll
        for (int k = 0; k < 2; ++k)
#pragma unroll
            for (int j = 0; j < 4; ++j) vv[k][j] = vn[k][j];
    }
#undef P0_LOAD
}

__device__ __forceinline__ void gate_chunk(float lf, float ig, int lane, float& b, float& av, float& amax, float& pm) {
    float v = lf;
#pragma unroll
    for (int o = 1; o < 64; o <<= 1) { const float t = __shfl_up(v, o); if (lane >= o) v += t; }
    b = v; av = ig - v; float q = av;
#pragma unroll
    for (int o = 1; o < 64; o <<= 1) { const float t = __shfl_up(q, o); if (lane >= o) q = fmaxf(q, t); }
    pm = q; amax = wave_max(av);
}
__device__ __forceinline__ void phase2(const Args& a, LAS unsigned char* lds, int wave) {
    const int lane = lane_id();
    unsigned char* ws = a.ws;
    LAS unsigned* tile = (LAS unsigned*)(lds + wave * 16384);
    LAS unsigned short* tile16 = (LAS unsigned short*)tile;
    const int gw = blockIdx.x * 8 + wave, NGW = gridDim.x * 8;
    const bf16_t* QK = (const bf16_t*)(ws + O_QK); const bf16_t* VML = (const bf16_t*)(ws + O_VML); const bf16_t* VSW = (const bf16_t*)(ws + O_VSW);
    bf16_t* QKP = (bf16_t*)((unsigned char*)a.out + OO_QKP); bf16_t* VT = (bf16_t*)((unsigned char*)a.out + OO_VT);
    bf16_t* KT = (bf16_t*)(ws + O_KT); bf16_t* VTSW = (bf16_t*)(ws + O_VTSW);
    const float* gig = (const float*)(ws + O_GIG); const float* glf = (const float*)(ws + O_GLF);
    const float* cw = a.in[4];
    const int rsub = lane >> 3, cg8 = lane & 7;
    constexpr int N_QK = 512 * 16, N_VML = 512 * 16, N_VSW = 512 * 4, N_TILE = N_QK + N_VML + N_VSW, N_ALL = N_TILE + 16 * NCH;
    for (int it = gw; it < N_ALL; it += NGW) {
        if (it >= N_TILE) {
            const int q = it - N_TILE, bh = q / NCH, c = q % NCH; const size_t gi = (size_t)bh * SEQ + c * 64 + lane;
            float b, av, amax, pm; gate_chunk(glf[gi], gig[gi], lane, b, av, amax, pm);
            ((float*)(ws + O_GBC))[gi] = b; ((float*)(ws + O_GL))[gi] = b + pm;
            ((bf16_t*)(ws + O_GWH))[gi] = (bf16_t)(pk2(__expf(av - amax), 0.f) & 0xffffu);
            const float bl = rdlane(b, 63);
            if (lane == 0) { ((float*)(ws + O_CBL))[q] = bl; ((float*)(ws + O_CMW))[q] = bl + amax; ((float*)(ws + O_CAMAX))[q] = amax; }
            continue;
        }
        int kind, tt, ct;
        if (it < N_QK) { kind = 0; tt = it >> 4; ct = it & 15; } else if (it < N_QK + N_VML) { kind = 1; tt = (it - N_QK) >> 4; ct = (it - N_QK) & 15; } else { kind = 2; tt = (it - N_QK - N_VML) >> 2; ct = (it - N_QK - N_VML) & 3; }
        const int t0 = tt * 64, c0 = ct * 64, bb = t0 / SEQ, s0 = t0 % SEQ, c = c0 + 8 * cg8;
        if (kind == 0) {
            float w[4][8];
#pragma unroll
            for (int j = 0; j < 4; ++j) { const f32x4 w0 = *(const f32x4*)(cw + j * 1024 + c), w1 = *(const f32x4*)(cw + j * 1024 + c + 4);
                w[j][0] = w0[0]; w[j][1] = w0[1]; w[j][2] = w0[2]; w[j][3] = w0[3]; w[j][4] = w1[0]; w[j][5] = w1[1]; w[j][6] = w1[2]; w[j][7] = w1[3]; }
            const float qs = (c < 512) ? 0.08838834764831845f : 1.f;
            u32x4 xq[8][4];
#pragma unroll
            for (int i = 0; i < 8; ++i) { const int r = 8 * i + rsub, t = t0 + r, sp = s0 + r;
#pragma unroll
                for (int j = 0; j < 4; ++j) { const int back = (sp - 3 + j >= 0) ? 3 - j : 0; xq[i][j] = *(const u32x4*)(QK + (size_t)(t - back) * 1024 + c); } }
#pragma unroll
            for (int i = 0; i < 8; ++i) { const int r = 8 * i + rsub, t = t0 + r, sp = s0 + r;
                float acc8[8];
#pragma unroll
                for (int e = 0; e < 8; ++e) acc8[e] = 0.f;
#pragma unroll
                for (int j = 0; j < 4; ++j) { const float vz = (sp - 3 + j >= 0) ? 1.f : 0.f; const u32x4 xv = xq[i][j];
                        acc8[0] += vz * w[j][0] * bflo(xv.x); acc8[1] += vz * w[j][1] * bfhi(xv.x); acc8[2] += vz * w[j][2] * bflo(xv.y); acc8[3] += vz * w[j][3] * bfhi(xv.y);
                        acc8[4] += vz * w[j][4] * bflo(xv.z); acc8[5] += vz * w[j][5] * bfhi(xv.z); acc8[6] += vz * w[j][6] * bflo(xv.w); acc8[7] += vz * w[j][7] * bfhi(xv.w); }
#pragma unroll
                for (int e = 0; e < 8; ++e) acc8[e] = acc8[e] * sigm(acc8[e]) * qs;
                u32x4 o; o.x = pk2(acc8[0], acc8[1]); o.y = pk2(acc8[2], acc8[3]); o.z = pk2(acc8[4], acc8[5]); o.w = pk2(acc8[6], acc8[7]);
                *(u32x4*)(QKP + (size_t)t * 1024 + c) = o;
                if (c0 >= 512) { LAS unsigned* tp = tile + r * 33 + 4 * cg8; tp[0] = o.x; tp[1] = o.y; tp[2] = o.z; tp[3] = o.w; } }
            if (c0 < 512) continue;
        } else {
            float wh = 1.f;
            if (kind == 1) { const int bh = bb * 4 + (c0 >> 8); const size_t gi = (size_t)bh * SEQ + s0 + lane; float b, av, amax, pm; gate_chunk(glf[gi], gig[gi], lane, b, av, amax, pm); wh = __expf(av - amax); }
            const bf16_t* src = (kind == 1) ? VML : VSW; const int ld = (kind == 1) ? 1024 : 256;
#pragma unroll
            for (int i = 0; i < 8; ++i) { const int r = 8 * i + rsub; u32x4 o = *(const u32x4*)(src + (size_t)(t0 + r) * ld + c);
                const float sc = __shfl(wh, r);
                if (kind == 1) { o.x = pk2(bflo(o.x) * sc, bfhi(o.x) * sc); o.y = pk2(bflo(o.y) * sc, bfhi(o.y) * sc); o.z = pk2(bflo(o.z) * sc, bfhi(o.z) * sc); o.w = pk2(bflo(o.w) * sc, bfhi(o.w) * sc); }
                LAS unsigned* tp = tile + r * 33 + 4 * cg8; tp[0] = o.x; tp[1] = o.y; tp[2] = o.z; tp[3] = o.w; }
        }
        asm volatile("s_waitcnt lgkmcnt(0)" ::: "memory");
        bf16_t* dst; int CH, cb;
        if (kind == 0) { dst = KT; CH = 128; cb = c0 - 512; } else if (kind == 1) { dst = VT; CH = 256; cb = c0; } else { dst = VTSW; CH = 64; cb = c0; }
#pragma unroll
        for (int i = 0; i < 8; ++i) { const int ch = 8 * i + (lane >> 3), tg = lane & 7; const LAS unsigned short* sp = tile16 + (8 * tg) * 66 + ch;
            u32x4 o; o.x = (unsigned)sp[0] | ((unsigned)sp[66] << 16); o.y = (unsigned)sp[2 * 66] | ((unsigned)sp[3 * 66] << 16); o.z = (unsigned)sp[4 * 66] | ((unsigned)sp[5 * 66] << 16); o.w = (unsigned)sp[6 * 66] | ((unsigned)sp[7 * 66] << 16);
            const int chn = cb + ch, hb = bb * 4 + chn / CH, slot = (kind == 2) ? (s0 >> 6) : (((s0 >> 6) + 8 * hb) & 127);
            *(u32x4*)(dst + ((size_t)((hb * NCH + slot) * CH + (chn % CH)) << 6) + 8 * tg) = o; }
        asm volatile("s_waitcnt lgkmcnt(0)" ::: "memory");
    }
}

__device__ __forceinline__ void scan_block(const Args& a, LAS unsigned char* lds, int sb, int wave, int lane) {
    unsigned char* ws = a.ws;
    const int bh = sb / 9, k9 = sb - 9 * bh, fr = lane & 15, fq = lane >> 4;
    constexpr int STG = 128 * 144, SST0 = 4 * STG, TILE = 4352;
    if (wave < 2) {
        const int slice = (k9 < 8) ? 2 * k9 + wave : 16; const bool is_n = (slice == 16);
        const bf16_t* VT = (const bf16_t*)((unsigned char*)a.out + OO_VT); const bf16_t* GWH = (const bf16_t*)(ws + O_GWH);
        const bf16_t* pb = is_n ? GWH + (size_t)bh * SEQ + 8 * fq : VT + ((size_t)(bh * NCH * 256 + 16 * slice + fr) << 6) + 8 * fq;
        const int pbs = is_n ? 64 : 256 * 64;
        const float* cbl = (const float*)(ws + O_CBL) + bh * NCH; const float* cmw = (const float*)(ws + O_CMW) + bh * NCH;
        const float bl0 = cbl[lane], bl1 = cbl[64 + lane], mw0 = cmw[lane], mw1 = cmw[64 + lane];
        bf16x8 rb[12][2];
#define VB_LOAD(slot, cc) do { const bf16_t* _p = pb + (size_t)(is_n ? (cc) : (((cc) + 8 * bh) & 127)) * pbs; rb[slot][0] = ld8(_p); rb[slot][1] = ld8(_p + 32); } while (0)
#pragma unroll
        for (int p = 0; p < 12; ++p) VB_LOAD(p, p);
        if (is_n && wave == 0) { float* cmo = (float*)(ws + O_CM) + bh * NCH; float m = 0.f;
            for (int c = 0; c < NCH; ++c) { const float bl = (c < 64) ? rdlane(bl0, c & 63) : rdlane(bl1, c & 63), mw = (c < 64) ? rdlane(mw0, c & 63) : rdlane(mw1, c & 63); cmo[c] = m; m = fmaxf(bl + m, mw); } }
        f32x4 acc[8];
#pragma unroll
        for (int m = 0; m < 8; ++m) acc[m] = (f32x4){0.f, 0.f, 0.f, 0.f};
        float mst = 0.f;
#define CP_STEP(p, c) do { \
                LAS unsigned char* sst = lds + SST0 + (((p) & 1) * 2 + wave) * TILE; \
                _Pragma("unroll") for (int m = 0; m < 8; ++m) { u32x2 s0; s0.x = pk2(acc[m][0], acc[m][1]); s0.y = pk2(acc[m][2], acc[m][3]); *(LAS u32x2*)(sst + fr * 272 + 32 * m + 8 * fq) = s0; } \
                __syncthreads(); \
                const LAS unsigned char* ls = lds + ((p) & 3) * STG + fr * 144 + fq * 16; \
                bf16x8 af[8][2]; \
                _Pragma("unroll") for (int m = 0; m < 8; ++m) { af[m][0] = *(const LAS bf16x8*)(ls + m * 16 * 144); af[m][1] = *(const LAS bf16x8*)(ls + m * 16 * 144 + 64); } \
                const float bl = ((c) < 64) ? rdlane(bl0, (c) & 63) : rdlane(bl1, (c) & 63), mw = ((c) < 64) ? rdlane(mw0, (c) & 63) : rdlane(mw1, (c) & 63); \
                const float mn = fmaxf(bl + mst, mw), decay = __expf(bl + mst - mn), eta = __expf(mw - mn); mst = mn; \
                const f32x4 z = {0.f, 0.f, 0.f, 0.f}; \
                _Pragma("unroll") for (int m = 0; m < 8; ++m) { f32x4 t = mfma16(af[m][0], rb[p][0], z); t = mfma16(af[m][1], rb[p][1], t); acc[m] = acc[m] * decay + t * eta; } \
                { const int cl = ((c) + 12 < NCH) ? (c) + 12 : NCH - 1; VB_LOAD(p, cl); } } while (0)
        for (int c0 = 0; c0 < 120; c0 += 12) {
#pragma unroll
            for (int p = 0; p < 12; ++p) CP_STEP(p, c0 + p);
        }
#pragma unroll
        for (int p = 0; p < 8; ++p) CP_STEP(p, 120 + p);
#undef CP_STEP
#undef VB_LOAD
    } else if (wave < 6) {
        const bf16_t* KT = (const bf16_t*)(ws + O_KT);
        const int tid = (wave - 2) * 64 + lane;
        const bf16_t* pk = KT + ((size_t)(bh * NCH * 128) << 6) + tid * 8;
        LAS unsigned char* lw = lds + (tid >> 3) * 144 + (tid & 7) * 16;
        u32x4 kr[12][4];
#define KT_LOAD(set, cc) do { const size_t _o = (size_t)(((cc) + 8 * bh) & 127) * 8192; _Pragma("unroll") for (int _k = 0; _k < 4; ++_k) kr[set][_k] = *(const u32x4*)(pk + _o + _k * 2048); } while (0)
#define KT_WRITE(set, stg) do { _Pragma("unroll") for (int _k = 0; _k < 4; ++_k) *(LAS u32x4*)(lw + (stg) * STG + _k * 32 * 144) = kr[set][_k]; } while (0)
        KT_LOAD(0, 0); KT_LOAD(1, 1); KT_LOAD(2, 2);
        KT_WRITE(0, 0); KT_WRITE(1, 1); KT_WRITE(2, 2);
        KT_LOAD(3, 3); KT_LOAD(4, 4); KT_LOAD(5, 5); KT_LOAD(6, 6); KT_LOAD(7, 7); KT_LOAD(8, 8); KT_LOAD(9, 9); KT_LOAD(10, 10); KT_LOAD(11, 11); KT_LOAD(0, 12); KT_LOAD(1, 13);
#define LD_STEP(p, c) do { __syncthreads(); { const int cl = ((c) + 14 < NCH) ? (c) + 14 : NCH - 1; KT_LOAD(((p) + 2) % 12, cl); } KT_WRITE(((p) + 3) % 12, ((p) + 3) & 3); } while (0)
        for (int c0 = 0; c0 < 120; c0 += 12) {
#pragma unroll
            for (int p = 0; p < 12; ++p) LD_STEP(p, c0 + p);
        }
#pragma unroll
        for (int p = 0; p < 8; ++p) LD_STEP(p, 120 + p);
#undef LD_STEP
#undef KT_LOAD
#undef KT_WRITE
    } else {
        const int j = wave - 6;
        const int slice = (k9 < 8) ? 2 * k9 + j : 16; const bool live = (k9 < 8) || (j == 0);
        bf16_t* cst = (bf16_t*)(ws + O_CST) + (size_t)((bh * 17 + slice) * NCH) * 2048;
        for (int c = 0; c < NCH; ++c) {
            __syncthreads();
            if (live) { const LAS unsigned char* sst = lds + SST0 + ((c & 1) * 2 + j) * TILE;
                bf16_t* st = cst + (size_t)((c + 8 * bh + 5 * slice) & 127) * 2048;
#pragma unroll
                for (int k = 0; k < 4; ++k) { const int q = lane + 64 * k; *(u32x4*)(st + (size_t)(q >> 4) * 128 + (q & 15) * 8) = *(const LAS u32x4*)(sst + (q >> 4) * 272 + (q & 15) * 16); } }
        }
    }
    __syncthreads();
}

constexpr int SWA_KS = 0, SWA_VS = 272 * 144, SWA_VP = 576, SWA_NXT = SWA_VS + 64 * SWA_VP;
struct SwaPre { u32x4 kreg[5], vreg[5]; bf16x8 qf[4][2]; };
__device__ __forceinline__ void swa_issue(const Args& a, int bu, int wave, int lane, SwaPre& P) {
    unsigned char* ws = a.ws;
    const int qb = bu & 63, kvh = (bu >> 6) & 3, b = bu >> 8, fr = lane & 15, fq = lane >> 4, tid = wave * 64 + lane;
    const bf16_t* QSW = (const bf16_t*)(ws + O_QSW); const bf16_t* KSW = (const bf16_t*)(ws + O_KSW); const bf16_t* VTSW = (const bf16_t*)(ws + O_VTSW);
    const int KB = 128 * qb - 144;
#pragma unroll
    for (int it = 0; it < 5; ++it) { int i = tid + 512 * it; i = i < 2176 ? i : 2175; const int row = i >> 3, ch = i & 7; int kp = KB + row; kp = kp < 0 ? 0 : kp;
        P.kreg[it] = *(const u32x4*)(KSW + (size_t)(b * SEQ + kp) * 256 + kvh * 64 + 8 * ch); }
#pragma unroll
    for (int it = 0; it < 5; ++it) { int i = tid + 512 * it; i = i < 2176 ? i : 2175; const int hd = i / 34, ch = i - hd * 34; int sp = KB + 8 * ch; sp = sp < 0 ? 0 : sp;
        P.vreg[it] = *(const u32x4*)(VTSW + ((size_t)((((b * 4 + kvh) * NCH + (sp >> 6)) * 64 + hd)) << 6) + (sp & 63)); }
    const int tq = 128 * qb + 16 * wave + fr;
#pragma unroll
    for (int hh = 0; hh < 4; ++hh) { const bf16_t* qp = QSW + (size_t)(b * SEQ + tq) * 1024 + (4 * kvh + hh) * 64 + 8 * fq; P.qf[hh][0] = ld8(qp); P.qf[hh][1] = ld8(qp + 32); }
}
__device__ __forceinline__ void swa_commit(LAS unsigned char* lds, int bu, int wave, int lane, const SwaPre& P) {
    const int qb = bu & 63, tid = wave * 64 + lane, KB = 128 * qb - 144;
    const u32x4 zero4 = {0u, 0u, 0u, 0u};
#pragma unroll
    for (int it = 0; it < 5; ++it) { const int i = tid + 512 * it; if (i < 2176) { const int row = i >> 3, ch = i & 7; *(LAS u32x4*)(lds + SWA_KS + row * 144 + (ch ^ (4 * ((row >> 4) & 1))) * 16) = (KB + row >= 0) ? P.kreg[it] : zero4; } }
#pragma unroll
    for (int it = 0; it < 5; ++it) { const int i = tid + 512 * it; if (i < 2176) { const int hd = i / 34, ch = i - hd * 34; *(LAS u32x4*)(lds + SWA_VS + hd * SWA_VP + (ch ^ ((hd >> 4) & 3)) * 16) = (KB + 8 * ch >= 0) ? P.vreg[it] : zero4; } }
}
__device__ __forceinline__ void swa_compute(const Args& a, LAS unsigned char* lds, int bu, int wave, int lane, const bf16x8 (&qf)[4][2]) {
    unsigned char* ws = a.ws;
    const int qb = bu & 63, kvh = (bu >> 6) & 3, b = bu >> 8, fr = lane & 15, fq = lane >> 4;
    bf16_t* QSW = (bf16_t*)(ws + O_QSW);
    const int g = wave, t0 = 128 * qb + 16 * g, tq = t0 + fr, kb = t0 - 144;
    float sk[4];
#pragma unroll
    for (int hh = 0; hh < 4; ++hh) sk[hh] = a.in[7][4 * kvh + hh];
    const int krow = 8 * (fr >> 2) + (fr & 3);
    const LAS unsigned char* kbase = lds + SWA_KS + (16 * g + krow) * 144;
    const int kx0 = 4 * ((g + (krow >> 4)) & 1), kx1 = 4 * ((g + ((krow + 4) >> 4)) & 1);
    const LAS unsigned char* vbase = lds + SWA_VS;
    const int vpc = 2 * g + fq, vx = fr >> 2;
#pragma unroll
    for (int hh = 0; hh < 4; ++hh) {
        const bf16x8 q0 = qf[hh][0], q1 = qf[hh][1];
        const float sink = sk[hh];
        f32x4 st[10];
#pragma unroll
        for (int tau = 0; tau < 10; ++tau) { const int i = tau >> 1, e = tau & 1; const LAS unsigned char* kp = kbase + (32 * i + 4 * e) * 144; const int kx = e ? kx1 : kx0;
            f32x4 s = {0.f, 0.f, 0.f, 0.f}; s = mfma16(*(const LAS bf16x8*)(kp + ((fq ^ kx) * 16)), q0, s); s = mfma16(*(const LAS bf16x8*)(kp + (((fq + 4) ^ kx) * 16)), q1, s); st[tau] = s; }
        float mx = -1e30f;
#pragma unroll
        for (int tau = 0; tau < 10; ++tau) { const int i = tau >> 1, e = tau & 1;
#pragma unroll
            for (int r = 0; r < 4; ++r) { const int kp = kb + 32 * i + 8 * fq + 4 * e + r, df = tq - kp; const bool ok = (kp >= 0) && (df >= 0) && (df < 128);
                const float l = ok ? st[tau][r] * 0.125f : -1e30f; st[tau][r] = l; mx = fmaxf(mx, l); } }
        mx = fmaxf(mx, __shfl_xor(mx, 16)); mx = fmaxf(mx, __shfl_xor(mx, 32)); mx = fmaxf(mx, sink);
        float sum = 0.f;
#pragma unroll
        for (int tau = 0; tau < 10; ++tau)
#pragma unroll
            for (int r = 0; r < 4; ++r) { const float p = __expf(st[tau][r] - mx); st[tau][r] = p; sum += p; }
        sum += __shfl_xor(sum, 16); sum += __shfl_xor(sum, 32);
        const float inv = 1.f / (sum + __expf(sink - mx));
        bf16x8 pf[5];
#pragma unroll
        for (int i = 0; i < 5; ++i) { u32x4 w; w.x = pk2(st[2 * i][0], st[2 * i][1]); w.y = pk2(st[2 * i][2], st[2 * i][3]); w.z = pk2(st[2 * i + 1][0], st[2 * i + 1][1]); w.w = pk2(st[2 * i + 1][2], st[2 * i + 1][3]); pf[i] = __builtin_bit_cast(bf16x8, w); }
        f32x4 o[4];
#pragma unroll
        for (int mt = 0; mt < 4; ++mt) { const int hd = 16 * (fr >> 2) + 4 * mt + (fr & 3); const LAS unsigned char* vp = vbase + hd * SWA_VP;
            f32x4 s = {0.f, 0.f, 0.f, 0.f};
#pragma unroll
            for (int i = 0; i < 5; ++i) s = mfma16(*(const LAS bf16x8*)(vp + (((vpc + 4 * i) ^ vx) * 16)), pf[i], s);
            o[mt] = s * inv; }
        u32x4 w0, w1; w0.x = pk2(o[0][0], o[0][1]); w0.y = pk2(o[0][2], o[0][3]); w0.z = pk2(o[1][0], o[1][1]); w0.w = pk2(o[1][2], o[1][3]);
        w1.x = pk2(o[2][0], o[2][1]); w1.y = pk2(o[2][2], o[2][3]); w1.z = pk2(o[3][0], o[3][1]); w1.w = pk2(o[3][2], o[3][3]);
        bf16_t* op = QSW + (size_t)(b * SEQ + tq) * 1024 + (4 * kvh + hh) * 64 + 16 * fq;
        *(u32x4*)op = w0; *(u32x4*)(op + 8) = w1;
    }
}
__device__ __forceinline__ void phase3(const Args& a, LAS unsigned char* lds, int wave) {
    const int lane = lane_id();
#ifdef PROBE_MASK
    if (blockIdx.x == 0 && wave == 0 && lane == 0) ((unsigned long long*)(a.ws + O_TS))[11] = __builtin_amdgcn_s_memrealtime();
#endif
    if (blockIdx.x < 144) scan_block(a, lds, (int)blockIdx.x, wave, lane);
#ifdef PROBE_MASK
    if (blockIdx.x == 0 && wave == 0 && lane == 0) ((unsigned long long*)(a.ws + O_TS))[12] = __builtin_amdgcn_s_memrealtime();
#endif
    unsigned* ctr = (unsigned*)(a.ws + O_CTR);
    LAS unsigned* nxt = (LAS unsigned*)(lds + SWA_NXT);
    const bool lead = (wave == 0 && lane == 0);
    constexpr unsigned NU = NB * 4 * 64;
    unsigned mine = 0; if (lead) { mine = __hip_atomic_fetch_add(ctr, 1u, __ATOMIC_RELAXED, __HIP_MEMORY_SCOPE_AGENT); *nxt = mine; }
    __syncthreads();
    unsigned cur = *nxt;
    if (cur < NU) {
        if (lead) mine = __hip_atomic_fetch_add(ctr, 1u, __ATOMIC_RELAXED, __HIP_MEMORY_SCOPE_AGENT);
        SwaPre P; swa_issue(a, (int)cur, wave, lane, P);
        for (;;) {
            __syncthreads();
            if (lead) *nxt = mine;
            swa_commit(lds, (int)cur, wave, lane, P);
            bf16x8 qc[4][2];
#pragma unroll
            for (int hh = 0; hh < 4; ++hh) { qc[hh][0] = P.qf[hh][0]; qc[hh][1] = P.qf[hh][1]; }
            __syncthreads();
            const unsigned nx = *nxt;
            if (lead && nx < NU) mine = __hip_atomic_fetch_add(ctr, 1u, __ATOMIC_RELAXED, __HIP_MEMORY_SCOPE_AGENT);
            swa_issue(a, (int)(nx < NU ? nx : 0u), wave, lane, P);
            swa_compute(a, lds, (int)cur, wave, lane, qc);
            if (nx >= NU) break;
            cur = nx;
        }
    }
    __syncthreads();
}

__device__ __forceinline__ void p4_ptile(const bf16x8 (&kf)[4], const bf16x8 (&q)[4], float f, int tt, int st, int fr, int fq, LAS bf16_t* Pt) {
    f32x4 s = {0.f, 0.f, 0.f, 0.f};
#pragma unroll
    for (int ks = 0; ks < 4; ++ks) s = mfma16(kf[ks], q[ks], s);
    const int t = 16 * tt + fr, sb = 16 * st + 4 * fq;
    const float p0 = (sb + 0 <= t) ? s[0] * f : 0.f, p1 = (sb + 1 <= t) ? s[1] * f : 0.f, p2 = (sb + 2 <= t) ? s[2] * f : 0.f, p3 = (sb + 3 <= t) ? s[3] * f : 0.f;
    u32x2 o; o.x = pk2(p0, p1); o.y = pk2(p2, p3); *(LAS u32x2*)(Pt + t * 72 + sb) = o;
}
__device__ __forceinline__ void phase4(const Args& a, LAS unsigned char* lds, int wave) {
    const int lane = lane_id();
    unsigned char* ws = a.ws;
    { const f32x4* p = (const f32x4*)a.in[1]; u32x2* pbo = (u32x2*)(ws + O_PB); const int n = T * PLE / 4, stride = gridDim.x * 512;
        for (int i = blockIdx.x * 512 + wave * 64 + lane; i < n; i += 8 * stride) { f32x4 v[8];
#pragma unroll
            for (int k = 0; k < 8; ++k) { int idx = i + k * stride; idx = idx < n ? idx : n - 1; v[k] = p[idx]; }
#pragma unroll
            for (int k = 0; k < 8; ++k) { const int idx = i + k * stride; if (idx < n) { u32x2 o; o.x = pk2(v[k][0], v[k][1]); o.y = pk2(v[k][2], v[k][3]); pbo[idx] = o; } } } }
    const bf16_t* QKP = (const bf16_t*)((unsigned char*)a.out + OO_QKP); const bf16_t* VT = (const bf16_t*)((unsigned char*)a.out + OO_VT);
    const bf16_t* CST = (const bf16_t*)(ws + O_CST); const bf16_t* GWH = (const bf16_t*)(ws + O_GWH); bf16_t* OML = (bf16_t*)(ws + O_OML);
    const float* gbc = (const float*)(ws + O_GBC); const float* gL = (const float*)(ws + O_GL); const float* cm = (const float*)(ws + O_CM); const float* camax = (const float*)(ws + O_CAMAX);
    const float* gn = a.in[6];
    LAS bf16_t* Pt = (LAS bf16_t*)lds;
    LAS float* red = (LAS float*)(lds + 16384);
    LAS unsigned char* QS = lds + 20480; LAS unsigned char* KS = lds + 40960;
    const int fr = lane & 15, fq = lane >> 4, w = wave;
    u32x4 ypend[4]; size_t ytok = 0; int ycol = 0; bool have = false;
    u32x4 pq[2], pk_[2]; float pbt[2], pL[2], pb4[4], pL4[4], pmc = 0.f, pam = 0.f;
#define P4_PREF(un_) do { const int _bh = (un_) / NCH, _c = (un_) % NCH, _h = _bh & 3; const size_t _tok0 = (size_t)(_bh >> 2) * SEQ + _c * 64; pmc = cm[un_]; pam = camax[un_]; \
        _Pragma("unroll") for (int tt = 0; tt < 4; ++tt) { const size_t gi = (size_t)_bh * SEQ + _c * 64 + 16 * tt + fr; pb4[tt] = gbc[gi]; pL4[tt] = gL[gi]; } \
        _Pragma("unroll") for (int k2 = 0; k2 < 2; ++k2) { const int i = w * 64 + lane + 512 * k2, row = i >> 4, pc = i & 15; const bf16_t* src = QKP + (_tok0 + row) * 1024 + _h * 128 + 8 * pc; \
            pq[k2] = *(const u32x4*)src; pk_[k2] = *(const u32x4*)(src + 512); const size_t gi = (size_t)_bh * SEQ + _c * 64 + row; pbt[k2] = gbc[gi]; pL[k2] = gL[gi]; } } while (0)
    if ((int)blockIdx.x < 16 * NCH) P4_PREF((int)blockIdx.x);
    for (int un = blockIdx.x; un < 16 * NCH; un += gridDim.x) {
        const int bh = un / NCH, c = un % NCH, bb = bh >> 2, h = bh & 3; const size_t tok0 = (size_t)bb * SEQ + c * 64;
        const float m_c = pmc, amax = pam;
        float en[4];
#pragma unroll
        for (int tt = 0; tt < 4; ++tt) en[tt] = __expf(-fmaxf(pb4[tt] + m_c, pL4[tt]));
        u32x4 qpc[2], kpc[2]; float wrow[2];
#pragma unroll
        for (int k2 = 0; k2 < 2; ++k2) { qpc[k2] = pq[k2]; kpc[k2] = pk_[k2]; wrow[k2] = __expf(pbt[k2] + m_c - fmaxf(pbt[k2] + m_c, pL[k2])); }
        const int colh = h * 256 + 32 * w + 8 * fq;
        u32x4 ovv[4];
#pragma unroll
        for (int tt = 0; tt < 4; ++tt) ovv[tt] = *(const u32x4*)(OML + (tok0 + 16 * tt + fr) * 1024 + colh);
        bf16x8 ca[3][4], va[3][2];
#pragma unroll
        for (int e = 0; e < 3; ++e) { const int dvr = 32 * w + 8 * (fr >> 2) + 4 * e + (fr & 3); const int crow = (e < 2) ? dvr : 256 + fr;
            const bf16_t* cp = CST + ((size_t)((bh * 17 + (crow >> 4)) * NCH + ((c + 8 * bh + 5 * (crow >> 4)) & 127)) * 16 + (crow & 15)) * 128 + 8 * fq;
            const bf16_t* vp = (e < 2) ? VT + ((size_t)((bh * NCH + ((c + 8 * bh) & 127)) * 256 + dvr) << 6) + 8 * fq : GWH + (size_t)bh * SEQ + c * 64 + 8 * fq;
#pragma unroll
            for (int ks = 0; ks < 4; ++ks) ca[e][ks] = ld8(cp + 32 * ks);
            va[e][0] = ld8(vp); va[e][1] = ld8(vp + 32); }
        if (have) {
#pragma unroll
            for (int tt = 0; tt < 4; ++tt) *(u32x4*)(OML + (ytok + 16 * tt + fr) * 1024 + ycol) = ypend[tt]; }
#pragma unroll
        for (int k2 = 0; k2 < 2; ++k2) { const int i = w * 64 + lane + 512 * k2, row = i >> 4, pc = i & 15;
            *(LAS u32x4*)(QS + row * 288 + pc * 16) = __builtin_bit_cast(u32x4, scale8(__builtin_bit_cast(bf16x8, qpc[k2]), wrow[k2])); *(LAS u32x4*)(KS + row * 288 + pc * 16) = kpc[k2]; }
        __syncthreads();
        bf16x8 qt[4][4];
#pragma unroll
        for (int tt = 0; tt < 4; ++tt)
#pragma unroll
            for (int ks = 0; ks < 4; ++ks) qt[tt][ks] = *(const LAS bf16x8*)(QS + (16 * tt + fr) * 288 + 64 * ks + 16 * fq);
        { bf16x8 kf[4]; const float cf = __expf(amax - m_c);
#pragma unroll
          for (int ks = 0; ks < 4; ++ks) kf[ks] = *(const LAS bf16x8*)(KS + (16 * (w >> 1) + fr) * 288 + 64 * ks + 16 * fq);
          if (w & 1) { p4_ptile(kf, qt[2], cf, 2, w >> 1, fr, fq, Pt); p4_ptile(kf, qt[3], cf, 3, w >> 1, fr, fq, Pt); }
          else       { p4_ptile(kf, qt[0], cf, 0, w >> 1, fr, fq, Pt); p4_ptile(kf, qt[1], cf, 1, w >> 1, fr, fq, Pt); } }
        __syncthreads();
        f32x4 acc[3][4];
#pragma unroll
        for (int e = 0; e < 3; ++e) {
#pragma unroll
            for (int tt = 0; tt < 4; ++tt) { f32x4 s = {0.f, 0.f, 0.f, 0.f};
#pragma unroll
                for (int ks = 0; ks < 4; ++ks) s = mfma16(ca[e][ks], qt[tt][ks], s);
#pragma unroll
                for (int k2 = 0; k2 < 2; ++k2) s = mfma16(va[e][k2], *(const LAS bf16x8*)(Pt + (16 * tt + fr) * 72 + 32 * k2 + 8 * fq), s);
                acc[e][tt] = s; } }
        { const int unn = un + (int)gridDim.x; P4_PREF(unn < 16 * NCH ? unn : un); }
        float rs[4];
#pragma unroll
        for (int tt = 0; tt < 4; ++tt) { const float dn = __builtin_amdgcn_rcpf(fmaxf(fabsf(acc[2][tt][0]), en[tt])); float ss = 0.f;
#pragma unroll
            for (int e = 0; e < 2; ++e)
#pragma unroll
                for (int r = 0; r < 4; ++r) { const float hv = acc[e][tt][r] * dn; acc[e][tt][r] = hv; ss += hv * hv; }
            ss += __shfl_xor(ss, 16); ss += __shfl_xor(ss, 32);
            if (fq == 0) red[w * 64 + 16 * tt + fr] = ss; }
        __syncthreads();
#pragma unroll
        for (int tt = 0; tt < 4; ++tt) { float tot = 0.f;
#pragma unroll
            for (int ww = 0; ww < 8; ++ww) tot += red[ww * 64 + 16 * tt + fr];
            rs[tt] = rsqrtf(tot * (1.f / 256.f) + EPS); }
        const f32x4 g0 = *(const f32x4*)(gn + colh), g1 = *(const f32x4*)(gn + colh + 4);
#pragma unroll
        for (int tt = 0; tt < 4; ++tt) { const u32x4 ov = ovv[tt]; const float r_ = rs[tt]; u32x4 y;
            y.x = pk2(sigm(bflo(ov.x)) * g0[0] * acc[0][tt][0] * r_, sigm(bfhi(ov.x)) * g0[1] * acc[0][tt][1] * r_);
            y.y = pk2(sigm(bflo(ov.y)) * g0[2] * acc[0][tt][2] * r_, sigm(bfhi(ov.y)) * g0[3] * acc[0][tt][3] * r_);
            y.z = pk2(sigm(bflo(ov.z)) * g1[0] * acc[1][tt][0] * r_, sigm(bfhi(ov.z)) * g1[1] * acc[1][tt][1] * r_);
            y.w = pk2(sigm(bflo(ov.w)) * g1[2] * acc[1][tt][2] * r_, sigm(bfhi(ov.w)) * g1[3] * acc[1][tt][3] * r_);
            ypend[tt] = y; }
        ytok = tok0; ycol = colh; have = true;
    }
    if (have) {
#pragma unroll
        for (int tt = 0; tt < 4; ++tt) *(u32x4*)(OML + (ytok + 16 * tt + fr) * 1024 + ycol) = ypend[tt]; }
}

__device__ __forceinline__ void phase10(const Args& a, int wave) {
    const int lane = lane_id();
    const float* ssq = (const float*)(a.ws + O_SSQ3); const float* g = a.in[17]; const bf16_t* X3 = (const bf16_t*)(a.ws + O_X3B);
    const int gw = blockIdx.x * 8 + wave, NGW = gridDim.x * 8;
#ifdef PROBE_MASK
    long long probeK = 0; { const unsigned long long* ts = (const unsigned long long*)(a.ws + O_TS);
#pragma unroll
        for (int k = 0; k < 10; ++k) if ((PROBE_MASK >> k) & 1) probeK += (long long)(ts[k + 1] - ts[k]) / 10;
        if ((PROBE_MASK >> 10) & 1) probeK += (long long)(ts[12] - ts[11]) / 10; }
#endif
    const f32x4 g0 = *(const f32x4*)(g + 8 * lane), g1 = *(const f32x4*)(g + 8 * lane + 4), g2 = *(const f32x4*)(g + 512 + 8 * lane), g3 = *(const f32x4*)(g + 512 + 8 * lane + 4);
    u32x4 xa[4], xb[4]; float rs[4];
#define P10_LOAD(XA, XB, RS, row_) do { _Pragma("unroll") for (int k = 0; k < 4; ++k) { int r = (row_) + k * NGW; r = r < T ? r : T - 1; const bf16_t* xr = X3 + (size_t)r * D + 8 * lane; XA[k] = *(const u32x4*)xr; XB[k] = *(const u32x4*)(xr + 512); \
            const f32x4 p = ((const f32x4*)(ssq + (size_t)r * 16))[lane & 3]; float s = (p[0] + p[1]) + (p[2] + p[3]); s += __shfl_xor(s, 1); s += __shfl_xor(s, 2); RS[k] = rsqrtf(s * (1.f / D) + EPS); } } while (0)
    P10_LOAD(xa, xb, rs, gw);
    for (int row = gw; row < T; row += 4 * NGW) {
        u32x4 na[4], nb[4]; float rn[4];
        P10_LOAD(na, nb, rn, row + 4 * NGW);
#pragma unroll
        for (int k = 0; k < 4; ++k) { const int r = row + k * NGW; float* orow = a.out + (size_t)r * D + 8 * lane; const float q = rs[k];
            f32x4 o[4];
            o[0] = (f32x4){bflo(xa[k].x), bfhi(xa[k].x), bflo(xa[k].y), bfhi(xa[k].y)} * q * g0; o[1] = (f32x4){bflo(xa[k].z), bfhi(xa[k].z), bflo(xa[k].w), bfhi(xa[k].w)} * q * g1;
            o[2] = (f32x4){bflo(xb[k].x), bfhi(xb[k].x), bflo(xb[k].y), bfhi(xb[k].y)} * q * g2; o[3] = (f32x4){bflo(xb[k].z), bfhi(xb[k].z), bflo(xb[k].w), bfhi(xb[k].w)} * q * g3;
#ifdef PROBE_MASK
#pragma unroll
            for (int j = 0; j < 4; ++j) { const long long base_i = (long long)r * D + 8 * lane + (j >> 1) * 512 + (j & 1) * 4;
#pragma unroll
              for (int e2 = 0; e2 < 4; ++e2) if (base_i + e2 < probeK) o[j][e2] += 0.1f; }
#endif
            *(f32x4*)orow = o[0]; *(f32x4*)(orow + 4) = o[1]; *(f32x4*)(orow + 512) = o[2]; *(f32x4*)(orow + 516) = o[3]; }
#pragma unroll
        for (int k = 0; k < 4; ++k) { xa[k] = na[k]; xb[k] = nb[k]; rs[k] = rn[k]; }
    }
#undef P10_LOAD
}

#define XB_TMO      128
#define XB_XCNT(j)  (256  + 64 * (j))
#define XB_XSUB(j)  (1280 + 64 * (j))
#define XB_XGEN(j)  (2304 + 64 * (j))
#define XB_TOP      3328
#define XB_TOPGEN   3392
#define XCD_BAR_WORDS 3456
#define XB_SPIN_CAP (1u << 18)

__device__ __forceinline__ unsigned xb_ld(unsigned* p)              { return __hip_atomic_load(p, __ATOMIC_RELAXED, __HIP_MEMORY_SCOPE_AGENT); }
__device__ __forceinline__ unsigned xb_add(unsigned* p, unsigned v) { return __hip_atomic_fetch_add(p, v, __ATOMIC_RELAXED, __HIP_MEMORY_SCOPE_AGENT); }
__device__ __forceinline__ unsigned xb_xcc_id() { return (unsigned)__builtin_amdgcn_s_getreg((3 << 11) | 20) & 0xFu; }
#define XB_SPIN(cond, bar) do { unsigned _sp = 0; while (cond) { __builtin_amdgcn_s_sleep(1); \
    if ((++_sp & 255u) == 0u) { if (xb_ld(&(bar)[XB_TMO])) break; if (_sp > XB_SPIN_CAP) { atomicAdd(&(bar)[XB_TMO], 1u); break; } } } } while (0)

struct XcdBarrier {
    unsigned* bar; unsigned x;
    volatile LAS unsigned* st;
};

__device__ __forceinline__ XcdBarrier xcd_barrier_post(unsigned* bar, volatile LAS unsigned* st) {
    XcdBarrier b; b.bar = bar; b.x = xb_xcc_id(); b.st = st;
    if (threadIdx.x == 0) (void)xb_add(&bar[XB_XCNT(b.x)], 1u);
    return b;
}
__device__ __forceinline__ void xcd_barrier_complete(unsigned* bar, unsigned x, unsigned& nloc, unsigned& nx) {
    const unsigned G = gridDim.x * gridDim.y * gridDim.z;
    unsigned sum, cnt, mine, sp = 0u;
    for (;;) {
        sum = 0u; cnt = 0u; mine = 0u;
#pragma unroll
        for (unsigned j = 0; j < 16; ++j) { const unsigned c = xb_ld(&bar[XB_XCNT(j)]); sum += c; cnt += (c > 0u) ? 1u : 0u; mine = (j == x) ? c : mine; }
        if (sum == G) break;
        __builtin_amdgcn_s_sleep(1);
        if ((++sp & 255u) == 0u) { if (xb_ld(&bar[XB_TMO])) break; if (sp > XB_SPIN_CAP) { atomicAdd(&bar[XB_TMO], 1u); break; } }
    }
    nloc = mine > 0u ? mine : 1u; nx = cnt > 0u ? cnt : 1u;
}

__device__ __forceinline__ void xcd_barrier(const XcdBarrier& b, const bool lead) {
    asm volatile("s_waitcnt vmcnt(0)" ::: "memory");
    __syncthreads();
    if (lead) {
        unsigned* bar = b.bar;
        __builtin_amdgcn_s_waitcnt(0);
        unsigned nloc = b.st[0], nx = b.st[1];
        if (nloc == 0u) { xcd_barrier_complete(bar, b.x, nloc, nx); b.st[0] = nloc; b.st[1] = nx; }
        const unsigned old = xb_add(&bar[XB_XSUB(b.x)], 1u);
        const unsigned gen = old / nloc;
        if (old + 1u == (gen + 1u) * nloc) {
            __builtin_amdgcn_fence(__ATOMIC_RELEASE, "agent");
            asm volatile("s_waitcnt vmcnt(0)" ::: "memory");
            const unsigned og = xb_add(&bar[XB_TOP], 1u);
            const unsigned tg = og / nx;
            if (og + 1u == (tg + 1u) * nx) xb_add(&bar[XB_TOPGEN], 1u);
            else XB_SPIN(xb_ld(&bar[XB_TOPGEN]) == tg, bar);
            __builtin_amdgcn_fence(__ATOMIC_ACQUIRE, "agent");
            xb_add(&bar[XB_XGEN(b.x)], 1u);
            asm volatile("s_waitcnt vmcnt(0)" ::: "memory");
        } else {
            XB_SPIN(xb_ld(&bar[XB_XGEN(b.x)]) == gen, bar);
            __builtin_amdgcn_fence(__ATOMIC_ACQUIRE, "agent");
            asm volatile("s_waitcnt vmcnt(0)" ::: "memory");
        }
    }
    __syncthreads();
}

__device__ __forceinline__ void grid_bar(unsigned* bar, unsigned& nbar, int wave) {
    asm volatile("s_waitcnt vmcnt(0)" ::: "memory");
    __syncthreads();
    ++nbar;
    if (wave == 0 && lane_id() == 0) {
        __builtin_amdgcn_fence(__ATOMIC_RELEASE, "agent");
        asm volatile("s_waitcnt vmcnt(0)" ::: "memory");
        __hip_atomic_fetch_add(bar, 1u, __ATOMIC_RELAXED, __HIP_MEMORY_SCOPE_AGENT);
        const unsigned target = nbar * gridDim.x; unsigned sp = 0;
        while (__hip_atomic_load(bar, __ATOMIC_RELAXED, __HIP_MEMORY_SCOPE_AGENT) < target) { __builtin_amdgcn_s_sleep(2); if (++sp > (1u << 24)) break; }
        __builtin_amdgcn_fence(__ATOMIC_ACQUIRE, "agent");
        asm volatile("s_waitcnt vmcnt(0)" ::: "memory");
    }
    __syncthreads();
}

__global__ void __launch_bounds__(512, 2) mk_fwd(Args a) {
    extern __shared__ __attribute__((aligned(16))) unsigned char lds_raw[];
    LAS unsigned char* lds = (LAS unsigned char*)lds_raw;
    const int wave = __builtin_amdgcn_readfirstlane(threadIdx.x >> 6);
    unsigned char* ws = a.ws;
    const int lo = a.ph_lo, hi = a.ph_hi;
    unsigned nbar = 0; unsigned* bar = (unsigned*)(ws + O_BAR);
    volatile LAS unsigned* xst = (volatile LAS unsigned*)(lds + 131072 + 256);
    if (threadIdx.x == 0) { xst[0] = 0u; xst[1] = 0u; }
    __syncthreads();
    const XcdBarrier xb = xcd_barrier_post((unsigned*)(ws + O_XBAR), xst);
    if (lo == 0 && hi == NPHASE) {
        cg::this_grid().sync();
    }
#define IN(k) (lo <= (k) && (k) < hi)
#ifdef PROBE_MASK
#define STAMP(k) do { if (blockIdx.x == 0 && wave == 0 && lane_id() == 0) ((unsigned long long*)(ws + O_TS))[(k)] = __builtin_amdgcn_s_memrealtime(); } while (0)
#else
#define STAMP(k) do { } while (0)
#endif
#define SEAM(k) do { STAMP((k) + 1); if (IN(k) && IN((k) + 1)) xcd_barrier(xb, wave == 0 && lane_id() == 0); } while (0)
    STAMP(0);
    if (IN(0)) phase0(a, lds, wave);
    SEAM(0);
    if (IN(1)) { EpiSeg E{ws}; run_gemm(lds, wave, (const bf16_t*)((unsigned char*)a.out + OO_H), (const bf16_t*)(ws + O_WIN), T, NP1, D, E); }
    SEAM(1);
    if (IN(2)) phase2(a, lds, wave);
    SEAM(2);
    if (IN(3)) phase3(a, lds, wave);
    SEAM(3);
    if (IN(4)) phase4(a, lds, wave);
    SEAM(4);
    if (IN(5)) {
        { EpiGateA E{(const bf16_t*)(ws + O_GA), (bf16_t*)a.out}; run_gemm(lds, wave, (const bf16_t*)(ws + O_OML), (const bf16_t*)(ws + O_WA), T, D, D, E); }
        { EpiGateB E{(const bf16_t*)(ws + O_GB), (const bf16_t*)a.out, (bf16_t*)(ws + O_MERGED)}; run_gemm(lds, wave, (const bf16_t*)(ws + O_QSW), (const bf16_t*)(ws + O_WB), T, D, D, E); }
    }
    SEAM(5);
    if (IN(6)) { EpiRes<false> E{a.in[0], (bf16_t*)a.out, (float*)(ws + O_SSQ1)}; run_gemm(lds, wave, (const bf16_t*)(ws + O_MERGED), (const bf16_t*)(ws + O_WOUT), T, D, D, E); }
    SEAM(6);
    if (IN(7)) { EpiUp E{(const float*)(ws + O_SSQ1), (bf16_t*)(ws + O_ACT)}; run_gemm(lds, wave, (const bf16_t*)a.out, (const bf16_t*)(ws + O_WUP), T, FF, D, E); }
    SEAM(7);
    if (IN(8)) {
        { EpiRes<true> E{a.out, (bf16_t*)(ws + O_X2B), (float*)(ws + O_SSQ2)}; run_gemm(lds, wave, (const bf16_t*)(ws + O_ACT), (const bf16_t*)(ws + O_WDN), T, D, FF, E); }
        { EpiPlain E{(bf16_t*)(ws + O_PP), D}; run_gemm(lds, wave, (const bf16_t*)(ws + O_PB), (const bf16_t*)(ws + O_WP), T, D, PLE, E); }
    }
    SEAM(8);
    if (IN(9)) { EpiPle E{(const float*)(ws + O_SSQ2), (const bf16_t*)(ws + O_PP), (const bf16_t*)(ws + O_X2B), (bf16_t*)(ws + O_X3B), (float*)(ws + O_SSQ3)}; run_gemm(lds, wave, (const bf16_t*)(ws + O_X2B), (const bf16_t*)(ws + O_WG), T, D, D, E); }
    SEAM(9);
    if (IN(10)) phase10(a, wave);
#undef IN
#undef SEAM
}

extern "C" void kernel_launch(void* const* d_in, const int* in_sizes, int n_in, void* d_out, int out_size, void* d_ws, size_t ws_size, hipStream_t stream) {
    static int grid = 0;
    if (grid == 0) {
        if (n_in != 18 || out_size != T * D || ws_size < WS_NEED) { fprintf(stderr, "kernel_launch: unexpected shapes (n_in %d out %d ws %zu)\n", n_in, out_size, ws_size); grid = -1; return; }
        int dev = 0, cus = 0, per_cu = 0;
        if (hipGetDevice(&dev) != hipSuccess || hipDeviceGetAttribute(&cus, hipDeviceAttributeMultiprocessorCount, dev) != hipSuccess) { grid = -1; return; }
        if (hipFuncSetAttribute((const void*)mk_fwd, hipFuncAttributeMaxDynamicSharedMemorySize, LDS_BYTES) != hipSuccess) { fprintf(stderr, "kernel_launch: hipFuncSetAttribute failed\n"); grid = -1; return; }
        if (hipOccupancyMaxActiveBlocksPerMultiprocessor(&per_cu, (const void*)mk_fwd, 512, LDS_BYTES) != hipSuccess || per_cu < 1) per_cu = 1;
        (void)hipGetLastError();
        grid = cus;
    }
    if (grid < 0) return;
    if (hipMemsetAsync((char*)d_ws + O_XBAR, 0, 16384, stream) != hipSuccess) { fprintf(stderr, "kernel_launch: memset failed\n"); return; }
    Args a{};
    for (int i = 0; i < 18; ++i) a.in[i] = (const float*)d_in[i];
    a.out = (float*)d_out; a.ws = (unsigned char*)d_ws;
#if MK_N_LAUNCHES == 1
    a.ph_lo = 0; a.ph_hi = NPHASE;
    void* args[] = {&a};
    hipError_t e = hipLaunchCooperativeKernel((const void*)mk_fwd, dim3(grid), dim3(512), args, LDS_BYTES, stream);
    if (e != hipSuccess) fprintf(stderr, "cooperative launch failed: %s (grid %d)\n", hipGetErrorString(e), grid);
#else
    for (int p = 0; p < NPHASE; ++p) { a.ph_lo = p; a.ph_hi = p + 1; hipLaunchKernelGGL(mk_fwd, dim3(grid), dim3(512), LDS_BYTES, stream, a); }
#endif
}
```

```cpp
#include <hip/hip_runtime.h>
#include <hip/hip_cooperative_groups.h>
#include <cstdio>
#include <cstdint>
namespace cg = cooperative_groups;
namespace pg8 {
#define PG8_LAS __attribute__((address_space(3)))
typedef unsigned short bf16_t;
typedef short bf16x8 __attribute__((ext_vector_type(8)));
typedef float f32x4 __attribute__((ext_vector_type(4)));
typedef unsigned u32x4 __attribute__((ext_vector_type(4)));
constexpr int BM = 256, BK = 64, HALF = 128, HTB = HALF * BK * 2  , STAGE_BYTES = 8 * HTB, NXCD = 8, WGM = 8;

__host__ __device__ __forceinline__ int lds_byte(int r, int c) { const int st = (r >> 4) * 2 + (c >> 5), rr = r & 15, cc = c & 31, ob = rr * 64 + cc * 2; return st * 1024 + (ob ^ (((ob >> 9) & 1) << 5)); }
__host__ __device__ __forceinline__ void stage_rc(int b, int& R, int& C) { const int st = b / 1024, sb = b % 1024, swz = sb ^ (((sb >> 9) & 1) << 5); R = (st >> 1) * 16 + swz / 64; C = (st & 1) * 32 + (swz % 64) / 2; }
__host__ __device__ __forceinline__ int perm32(int rho) { const int n = rho >> 4, i = rho & 15; return 8 * (i >> 2) + 4 * n + (i & 3); }

struct Unit { int pm, pn; };
struct Gemm { const bf16_t* A; const bf16_t* Bt; int M, N, K; };

struct StaticOrder {
    int nM, nN, nwg, G, c;
    __host__ __device__ void init(int M, int N, int G_, int c_) { nM = M / BM; nN = N / BM; nwg = nM * nN; G = G_; c = c_; }
    __host__ __device__ bool next(int i, Unit& u) const {
        const long L = (long)i * G + c; if (L >= nwg) return false;
        int wgid = (int)L; { const int q = nwg / NXCD, r = nwg % NXCD, xcd = wgid % NXCD, off = wgid / NXCD; wgid = (xcd < r ? xcd * (q + 1) : r * (q + 1) + (xcd - r) * q) + off; }
        const int nig = WGM * nN, gid = wgid / nig, fm = gid * WGM, gsz = (nM - fm) < WGM ? (nM - fm) : WGM;
        u.pm = fm + ((wgid % nig) % gsz); u.pn = (wgid % nig) / gsz; return true;
    }
    __device__ __forceinline__ void a_ready(const Unit&) const {}
    __device__ __forceinline__ void done(const Unit&) const {}
};
__device__ __forceinline__ unsigned cvt_pk_bf16(float lo, float hi) { unsigned r; asm volatile("v_cvt_pk_bf16_f32 %0, %1, %2" : "=v"(r) : "v"(lo), "v"(hi)); return r; }
template <class Epi, class Sched, bool ALIGN_EPI = false, bool SP2 = false>
__device__ __forceinline__ void gemm_phase(PG8_LAS unsigned char* lds, const Gemm g, const Sched& S, const Epi& E, const int wid) {
    int lane; asm volatile("v_mbcnt_lo_u32_b32 %0, -1, 0\n\tv_mbcnt_hi_u32_b32 %0, -1, %0" : "=v"(lane));
    const int tid = wid * 64 + lane, wr = wid >> 2, wc = wid & 3, fr = lane & 15, fq = lane >> 4;
    const int K = g.K, nt = K / BK;
    unsigned voffA[2], voffB[2];
#pragma unroll
    for (int i = 0; i < 2; ++i) { int R, C; stage_rc(tid * 16 + i * 8192, R, C); const int Rb = Epi::PERM ? ((R & ~31) + perm32(R & 31)) : R;
        voffA[i] = (unsigned)(R * K + C) * 2u; voffB[i] = (unsigned)(Rb * K + C) * 2u; }
    const size_t kstep = (size_t)(BK * 2);
    const size_t hstep = (size_t)HALF * K * 2;
    const size_t tstep = 2 * hstep;
    const unsigned ldsw = (unsigned)wid * 1024u;
    const int aoff = lds_byte(wr * 64 + fr, fq * 8), boff = lds_byte(wc * 32 + fr, fq * 8);
#define PG8_SA(b, h) (((b) * 2 + (h)) * HTB)
#define PG8_SB(b, h) ((4 + (b) * 2 + (h)) * HTB)
#define PG8_STAGE(bufoff, gbase, voff) do { _Pragma("unroll") for (int _i = 0; _i < 2; ++_i) \
        __builtin_amdgcn_global_load_lds((const unsigned*)((const char*)(gbase) + (voff)[_i]), (PG8_LAS unsigned*)(lds + (bufoff) + ldsw + _i * 8192), 16, 0, 0); } while (0)
#define PG8_LDA(dst, b, h) do { _Pragma("unroll") for (int m = 0; m < 4; ++m) _Pragma("unroll") for (int k = 0; k < 2; ++k) dst[m][k] = *(const PG8_LAS bf16x8*)(lds + PG8_SA(b, h) + aoff + m * 2048 + k * 1024); } while (0)
#define PG8_LDB(dst, b, h) do { _Pragma("unroll") for (int n = 0; n < 2; ++n) _Pragma("unroll") for (int k = 0; k < 2; ++k) dst[n][k] = *(const PG8_LAS bf16x8*)(lds + PG8_SB(b, h) + boff + n * 2048 + k * 1024); } while (0)
#define PG8_MMA(ai, bj, At, Bt) do { __builtin_amdgcn_s_setprio(1); _Pragma("unroll") for (int m = 0; m < 4; ++m) _Pragma("unroll") for (int n = 0; n < 2; ++n) _Pragma("unroll") for (int k = 0; k < 2; ++k) \
        acc[ai][bj][m][n] = __builtin_amdgcn_mfma_f32_16x16x32_bf16(Bt[n][k], At[m][k], acc[ai][bj][m][n], 0, 0, 0); __builtin_amdgcn_s_setprio(0); } while (0)
#define PG8_WAIT_V(n) asm volatile("s_waitcnt vmcnt(" #n ")" ::: "memory")
#define PG8_WAIT_L(n) asm volatile("s_waitcnt lgkmcnt(" #n ")" ::: "memory")
#define PG8_BAR __builtin_amdgcn_s_barrier()
#define PG8_SCHED __builtin_amdgcn_sched_barrier(0)
    Unit cur, nxt; int ui = 0;
    if (!S.next(0, cur)) return;
    f32x4 acc[2][2][4][2];
#pragma unroll
    for (int a = 0; a < 2; ++a)
#pragma unroll
        for (int b = 0; b < 2; ++b)
#pragma unroll
            for (int m = 0; m < 4; ++m)
#pragma unroll
                for (int n = 0; n < 2; ++n) acc[a][b][m][n] = (f32x4){0.f, 0.f, 0.f, 0.f};
    bf16x8 At[4][2], B0[2][2], B1[2][2];
    const char* cA = (const char*)g.A + (size_t)cur.pm * tstep; const char* cB = (const char*)g.Bt + (size_t)cur.pn * tstep;
    S.a_ready(cur);
    if constexpr (SP2) {
        PG8_STAGE(PG8_SB(0, 0), cB, voffB); PG8_STAGE(PG8_SB(0, 1), cB + hstep, voffB); PG8_STAGE(PG8_SA(0, 0), cA, voffA); PG8_STAGE(PG8_SA(0, 1), cA + hstep, voffA);
        if (wr == 1) PG8_BAR;
        PG8_WAIT_V(2); PG8_BAR;
        PG8_STAGE(PG8_SB(1, 0), cB + kstep, voffB); PG8_STAGE(PG8_SA(1, 0), cA + kstep, voffA); PG8_STAGE(PG8_SB(1, 1), cB + hstep + kstep, voffB);
        PG8_WAIT_V(6); PG8_BAR;
    } else {
        PG8_STAGE(PG8_SB(0, 0), cB, voffB); PG8_STAGE(PG8_SA(0, 0), cA, voffA); PG8_STAGE(PG8_SB(0, 1), cB + hstep, voffB); PG8_STAGE(PG8_SA(0, 1), cA + hstep, voffA);
        if (wr == 1) PG8_BAR;
        PG8_WAIT_V(4); PG8_BAR;
        PG8_STAGE(PG8_SB(1, 0), cB + kstep, voffB); PG8_STAGE(PG8_SA(1, 0), cA + kstep, voffA); PG8_STAGE(PG8_SB(1, 1), cB + hstep + kstep, voffB);
        PG8_WAIT_V(6); PG8_BAR;
    }
    for (;;) {
        const bool has_next = S.next(ui + 1, nxt);
        const char* nA = has_next ? (const char*)g.A + (size_t)nxt.pm * tstep : cA; const char* nB = has_next ? (const char*)g.Bt + (size_t)nxt.pn * tstep : cB;
        for (int t = 0; t < nt; t += 2) {
            const bool last = (t == nt - 2);
            const char* a1 = cA + (size_t)(t + 1) * kstep;
            const char* a2 = last ? nA : cA + (size_t)(t + 2) * kstep; const char* b2 = last ? nB : cB + (size_t)(t + 2) * kstep;
            const char* a3 = a2 + kstep; const char* b3 = b2 + kstep;
            if (last && has_next) S.a_ready(nxt);
            if constexpr (SP2) {
            PG8_LDB(B0, 0, 0); PG8_LDB(B1, 0, 1); PG8_SCHED; PG8_LDA(At, 0, 0); PG8_STAGE(PG8_SA(1, 1), a1 + hstep, voffA);
            PG8_WAIT_V(8); PG8_WAIT_L(0); PG8_BAR; PG8_MMA(0, 0, At, B0); PG8_MMA(0, 1, At, B1); PG8_BAR; PG8_SCHED;
            PG8_LDA(At, 0, 1); PG8_STAGE(PG8_SB(0, 0), b2, voffB); PG8_STAGE(PG8_SB(0, 1), b2 + hstep, voffB); PG8_STAGE(PG8_SA(0, 0), a2, voffA);
            PG8_WAIT_V(8); PG8_WAIT_L(0); PG8_BAR; PG8_MMA(1, 0, At, B0); PG8_MMA(1, 1, At, B1); PG8_BAR; PG8_SCHED;
            PG8_LDB(B0, 1, 0); PG8_LDB(B1, 1, 1); PG8_SCHED; PG8_LDA(At, 1, 0); PG8_STAGE(PG8_SA(0, 1), a2 + hstep, voffA);
            PG8_WAIT_V(8); PG8_WAIT_L(0); PG8_BAR; PG8_MMA(0, 0, At, B0); PG8_MMA(0, 1, At, B1); PG8_BAR; PG8_SCHED;
            PG8_LDA(At, 1, 1); PG8_STAGE(PG8_SB(1, 0), b3, voffB); PG8_STAGE(PG8_SB(1, 1), b3 + hstep, voffB); PG8_STAGE(PG8_SA(1, 0), a3, voffA);
            PG8_WAIT_V(8); PG8_WAIT_L(0); PG8_BAR; PG8_MMA(1, 0, At, B0); PG8_MMA(1, 1, At, B1); PG8_BAR; PG8_SCHED;
            } else {
            PG8_LDB(B0, 0, 0); PG8_SCHED; PG8_LDA(At, 0, 0); PG8_STAGE(PG8_SA(1, 1), a1 + hstep, voffA);
            PG8_WAIT_L(8); PG8_BAR; PG8_WAIT_L(0); PG8_MMA(0, 0, At, B0); PG8_BAR; PG8_SCHED;
            PG8_LDB(B1, 0, 1); PG8_STAGE(PG8_SB(0, 0), b2, voffB);
            PG8_BAR; PG8_WAIT_L(0); PG8_MMA(0, 1, At, B1); PG8_BAR;
            PG8_LDA(At, 0, 1); PG8_STAGE(PG8_SA(0, 0), a2, voffA);
            PG8_BAR; PG8_WAIT_L(0); PG8_MMA(1, 0, At, B0); PG8_BAR; PG8_SCHED;
            PG8_STAGE(PG8_SB(0, 1), b2 + hstep, voffB);
            PG8_WAIT_V(6); PG8_BAR; PG8_MMA(1, 1, At, B1); PG8_BAR;
            PG8_LDB(B0, 1, 0); PG8_SCHED; PG8_LDA(At, 1, 0); PG8_STAGE(PG8_SA(0, 1), a2 + hstep, voffA);
            PG8_WAIT_L(8); PG8_BAR; PG8_WAIT_L(0); PG8_MMA(0, 0, At, B0); PG8_BAR; PG8_SCHED;
            PG8_LDB(B1, 1, 1); PG8_STAGE(PG8_SB(1, 0), b3, voffB);
            PG8_BAR; PG8_WAIT_L(0); PG8_MMA(0, 1, At, B1); PG8_BAR;
            PG8_LDA(At, 1, 1); PG8_STAGE(PG8_SA(1, 0), a3, voffA);
            PG8_BAR; PG8_WAIT_L(0); PG8_MMA(1, 0, At, B0); PG8_BAR; PG8_SCHED;
            PG8_STAGE(PG8_SB(1, 1), b3 + hstep, voffB);
            PG8_WAIT_V(6); PG8_BAR; PG8_MMA(1, 1, At, B1); PG8_BAR;
            }
        }
        if constexpr (ALIGN_EPI) { if (wr == 0) PG8_BAR; }
        if constexpr (!Epi::AFTER_DRAIN) { E(acc, cur, wr, wc, fr, fq); S.done(cur); }
        if (!has_next) break;
#pragma unroll
        for (int a = 0; a < 2; ++a)
#pragma unroll
            for (int b = 0; b < 2; ++b)
#pragma unroll
                for (int m = 0; m < 4; ++m)
#pragma unroll
                    for (int n = 0; n < 2; ++n) acc[a][b][m][n] = (f32x4){0.f, 0.f, 0.f, 0.f};
        cur = nxt; cA = nA; cB = nB; ++ui;
        if constexpr (ALIGN_EPI) { if (wr == 1) PG8_BAR; }
    }
    PG8_WAIT_V(0);
    if constexpr (!ALIGN_EPI) { if (wr == 0) PG8_BAR; }
    PG8_BAR;
    if constexpr (Epi::AFTER_DRAIN) { E.fused(acc, cur, wr, wc, fr, fq, lds, wid, lane); S.done(cur); }
#undef PG8_SA
#undef PG8_SB
#undef PG8_STAGE
#undef PG8_LDA
#undef PG8_LDB
#undef PG8_MMA
#undef PG8_WAIT_V
#undef PG8_WAIT_L
#undef PG8_BAR
#undef PG8_SCHED
}
}

#ifndef MK_N_LAUNCHES
#define MK_N_LAUNCHES 1
#endif
constexpr int NB = 4, SEQ = 8192, T = NB * SEQ, D = 1024, NIN = 6664, NP1 = 6656, FF = 4096, PLE = 256;
constexpr int NCH = SEQ / 64;
constexpr int CROWS = 272;
constexpr float EPS = 1e-6f;
constexpr int NPHASE = 11;
typedef pg8::bf16_t bf16_t;
typedef pg8::bf16x8 bf16x8;
typedef pg8::f32x4 f32x4;
typedef pg8::u32x4 u32x4;
typedef unsigned u32x2 __attribute__((ext_vector_type(2)));
#define LAS __attribute__((address_space(3)))

constexpr size_t MiB = 1u << 20;
constexpr size_t O_WIN = 0, O_WA = 13 * MiB, O_WB = 15 * MiB, O_WOUT = 17 * MiB, O_WG = 19 * MiB, O_WUP = 21 * MiB, O_WDN = 29 * MiB, O_WP = 37 * MiB;
constexpr size_t O_GWH = 37 * MiB + 512 * 1024, O_CBL = O_GWH + 256 * 1024, O_CMW = O_CBL + 8192, O_CAMAX = O_CMW + 8192, O_CM = O_CAMAX + 8192, O_CTR = O_CM + 8192, O_BAR = O_CTR + 256, O_TS = O_BAR + 256, O_DUMMY = O_TS + 1024, O_XBAR = 39 * MiB;
constexpr size_t O_QK = 40 * MiB, O_VML = 104 * MiB, O_VSW = 168 * MiB, O_KSW = 184 * MiB, O_OML = 200 * MiB, O_QSW = 264 * MiB, O_GA = 328 * MiB, O_GB = 392 * MiB;
constexpr size_t O_KT = 456 * MiB, O_VTSW = 488 * MiB, O_SSQ1 = 504 * MiB, O_SSQ2 = 506 * MiB, O_SSQ3 = 508 * MiB;
constexpr size_t O_GIG = 510 * MiB, O_GLF = O_GIG + 512 * 1024, O_GBC = 511 * MiB, O_GL = O_GBC + 512 * 1024;
constexpr size_t O_CST = 40 * MiB;
constexpr size_t O_MERGED = 40 * MiB, O_X1B = 104 * MiB, O_ACT = 200 * MiB, O_X2B = 40 * MiB, O_PB = 456 * MiB, O_PP = 104 * MiB, O_X3B = 200 * MiB;
constexpr size_t WS_NEED = 512 * MiB;
constexpr size_t OO_H = 0, OO_QKP = 0, OO_VT = 64 * MiB;
constexpr int LDS_BYTES = 147456;

__device__ __forceinline__ int lane_id() { int l; asm volatile("v_mbcnt_lo_u32_b32 %0, -1, 0\n\tv_mbcnt_hi_u32_b32 %0, -1, %0" : "=v"(l)); return l; }
__device__ __forceinline__ unsigned pk2(float lo, float hi) { return pg8::cvt_pk_bf16(lo, hi); }
__device__ __forceinline__ float bflo(unsigned w) { return __builtin_bit_cast(float, w << 16); }
__device__ __forceinline__ float bfhi(unsigned w) { return __builtin_bit_cast(float, w & 0xffff0000u); }
__device__ __forceinline__ float sigm(float x) { return __builtin_amdgcn_rcpf(1.f + __expf(-x)); }
__device__ __forceinline__ float wave_sum(float v) {
#pragma unroll
    for (int o = 1; o < 64; o <<= 1) v += __shfl_xor(v, o);
    return v;
}
__device__ __forceinline__ float wave_max(float v) {
#pragma unroll
    for (int o = 1; o < 64; o <<= 1) v = fmaxf(v, __shfl_xor(v, o));
    return v;
}
__device__ __forceinline__ bf16x8 ld8(const bf16_t* p) { return *(const bf16x8*)p; }
__device__ __forceinline__ f32x4 mfma16(bf16x8 a, bf16x8 b, f32x4 c) { return __builtin_amdgcn_mfma_f32_16x16x32_bf16(a, b, c, 0, 0, 0); }
__device__ __forceinline__ bf16x8 scale8(bf16x8 v, float s) {
    u32x4 u = __builtin_bit_cast(u32x4, v), o;
    o.x = pk2(bflo(u.x) * s, bfhi(u.x) * s); o.y = pk2(bflo(u.y) * s, bfhi(u.y) * s); o.z = pk2(bflo(u.z) * s, bfhi(u.z) * s); o.w = pk2(bflo(u.w) * s, bfhi(u.w) * s);
    return __builtin_bit_cast(bf16x8, o);
}
__device__ __forceinline__ size_t tpos(int row, int s) { return (size_t)row * SEQ + (size_t)(((((s >> 6) + row) & 127) << 6) + (s & 63)); }
__device__ __forceinline__ void st16_nt(void* p, u32x4 v) { asm volatile("global_store_dwordx4 %0, %1, off nt" :: "v"(p), "v"(v) : "memory"); }
__device__ __forceinline__ float rdlane(float v, int l) { return __builtin_bit_cast(float, __builtin_amdgcn_readlane(__builtin_bit_cast(int, v), l)); }

#define EPI_LOOP_BEGIN const int row0 = u.pm * 256 + wr * 64 + fr, col0 = u.pn * 256 + wc * 32 + 8 * fq; \
    _Pragma("unroll") for (int ai = 0; ai < 2; ++ai) _Pragma("unroll") for (int m = 0; m < 4; ++m) { const int row = row0 + ai * 128 + m * 16;
#define EPI_LOOP_END }
typedef pg8::Unit Unit;

struct EpiSeg {
    static constexpr bool PERM = true, AFTER_DRAIN = false;
    unsigned char* ws;
    __device__ __forceinline__ void operator()(const f32x4 (&acc)[2][2][4][2], const Unit& u, int wr, int wc, int fr, int fq) const {
        const int pn = u.pn; size_t off; int ldc, ct;
        if (pn < 4) { off = O_QK; ldc = 1024; ct = pn; } else if (pn < 8) { off = O_VML; ldc = 1024; ct = pn - 4; } else if (pn < 12) { off = O_OML; ldc = 1024; ct = pn - 8; }
        else if (pn < 16) { off = O_QSW; ldc = 1024; ct = pn - 12; } else if (pn < 17) { off = O_KSW; ldc = 256; ct = 0; } else if (pn < 18) { off = O_VSW; ldc = 256; ct = 0; }
        else if (pn < 22) { off = O_GA; ldc = 1024; ct = pn - 18; } else { off = O_GB; ldc = 1024; ct = pn - 22; }
        bf16_t* base = (bf16_t*)(ws + off) + ct * 256 + wc * 32 + 8 * fq;
        const int row0 = u.pm * 256 + wr * 64 + fr;
#pragma unroll
        for (int ai = 0; ai < 2; ++ai)
#pragma unroll
            for (int m = 0; m < 4; ++m) { bf16_t* rowp = base + (size_t)(row0 + ai * 128 + m * 16) * ldc;
#pragma unroll
                for (int bj = 0; bj < 2; ++bj) { const f32x4 v0 = acc[ai][bj][m][0], v1 = acc[ai][bj][m][1]; u32x4 w;
                    w.x = pk2(v0[0], v0[1]); w.y = pk2(v0[2], v0[3]); w.z = pk2(v1[0], v1[1]); w.w = pk2(v1[2], v1[3]); *(u32x4*)(rowp + bj * 128) = w; } }
    }
};
struct EpiPlain {
    static constexpr bool PERM = true, AFTER_DRAIN = false;
    bf16_t* O; int ldc;
    __device__ __forceinline__ void operator()(const f32x4 (&acc)[2][2][4][2], const Unit& u, int wr, int wc, int fr, int fq) const {
        EPI_LOOP_BEGIN
#pragma unroll
            for (int bj = 0; bj < 2; ++bj) { const f32x4 v0 = acc[ai][bj][m][0], v1 = acc[ai][bj][m][1]; u32x4 w;
                w.x = pk2(v0[0], v0[1]); w.y = pk2(v0[2], v0[3]); w.z = pk2(v1[0], v1[1]); w.w = pk2(v1[2], v1[3]); *(u32x4*)(O + (size_t)row * ldc + col0 + bj * 128) = w; }
        EPI_LOOP_END
    }
};
#define EPI_ROWCOL const int row0 = u.pm * 256 + wr * 64 + fr, col0 = u.pn * 256 + wc * 32 + 8 * fq;
struct EpiGateA {
    static constexpr bool PERM = true, AFTER_DRAIN = false;
    const bf16_t* G; bf16_t* M1;
    __device__ __forceinline__ void operator()(const f32x4 (&acc)[2][2][4][2], const Unit& u, int wr, int wc, int fr, int fq) const {
        EPI_ROWCOL
#pragma unroll
        for (int ai = 0; ai < 2; ++ai)
#pragma unroll
          for (int mh = 0; mh < 2; ++mh) { u32x4 g[2][2];
#pragma unroll
            for (int mm = 0; mm < 2; ++mm)
#pragma unroll
                for (int bj = 0; bj < 2; ++bj) g[mm][bj] = *(const u32x4*)(G + (size_t)(row0 + ai * 128 + (2 * mh + mm) * 16) * D + col0 + bj * 128);
#pragma unroll
            for (int mm = 0; mm < 2; ++mm)
#pragma unroll
                for (int bj = 0; bj < 2; ++bj) { const int m = 2 * mh + mm; const size_t idx = (size_t)(row0 + ai * 128 + m * 16) * D + col0 + bj * 128; const u32x4 gv = g[mm][bj];
                    const f32x4 v0 = acc[ai][bj][m][0], v1 = acc[ai][bj][m][1]; f32x4 o0, o1;
                    o0[0] = sigm(bflo(gv.x)) * v0[0]; o0[1] = sigm(bfhi(gv.x)) * v0[1]; o0[2] = sigm(bflo(gv.y)) * v0[2]; o0[3] = sigm(bfhi(gv.y)) * v0[3];
                    o1[0] = sigm(bflo(gv.z)) * v1[0]; o1[1] = sigm(bfhi(gv.z)) * v1[1]; o1[2] = sigm(bflo(gv.w)) * v1[2]; o1[3] = sigm(bfhi(gv.w)) * v1[3];
                    u32x4 w; w.x = pk2(o0[0], o0[1]); w.y = pk2(o0[2], o0[3]); w.z = pk2(o1[0], o1[1]); w.w = pk2(o1[2], o1[3]); *(u32x4*)(M1 + idx) = w; } }
    }
};
struct EpiGateB {
    static constexpr bool PERM = true, AFTER_DRAIN = false;
    const bf16_t* G; const bf16_t* M1; bf16_t* O;
    __device__ __forceinline__ void operator()(const f32x4 (&acc)[2][2][4][2], const Unit& u, int wr, int wc, int fr, int fq) const {
        EPI_ROWCOL
#pragma unroll
        for (int ai = 0; ai < 2; ++ai)
#pragma unroll
            for (int mh = 0; mh < 2; ++mh) { u32x4 g[2][2], am[2][2];
#pragma unroll
                for (int mm = 0; mm < 2; ++mm)
#pragma unroll
                    for (int bj = 0; bj < 2; ++bj) { const size_t idx = (size_t)(row0 + ai * 128 + (2 * mh + mm) * 16) * D + col0 + bj * 128;
                        g[mm][bj] = *(const u32x4*)(G + idx); am[mm][bj] = *(const u32x4*)(M1 + idx); }
#pragma unroll
                for (int mm = 0; mm < 2; ++mm)
#pragma unroll
                    for (int bj = 0; bj < 2; ++bj) { const int m = 2 * mh + mm; const size_t idx = (size_t)(row0 + ai * 128 + m * 16) * D + col0 + bj * 128; const u32x4 gv = g[mm][bj];
                        const f32x4 v0 = acc[ai][bj][m][0], v1 = acc[ai][bj][m][1]; const u32x4 mv = am[mm][bj]; const f32x4 b0 = {bflo(mv.x), bfhi(mv.x), bflo(mv.y), bfhi(mv.y)}, b1 = {bflo(mv.z), bfhi(mv.z), bflo(mv.w), bfhi(mv.w)}; u32x4 w;
                        w.x = pk2(b0[0] + sigm(bflo(gv.x)) * v0[0], b0[1] + sigm(bfhi(gv.x)) * v0[1]); w.y = pk2(b0[2] + sigm(bflo(gv.y)) * v0[2], b0[3] + sigm(bfhi(gv.y)) * v0[3]);
                        w.z = pk2(b1[0] + sigm(bflo(gv.z)) * v1[0], b1[1] + sigm(bfhi(gv.z)) * v1[1]); w.w = pk2(b1[2] + sigm(bflo(gv.w)) * v1[2], b1[3] + sigm(bfhi(gv.w)) * v1[3]);
                        *(u32x4*)(O + idx) = w; } }
    }
};
template <bool XBF> struct EpiRes {
    static constexpr bool PERM = true, AFTER_DRAIN = false;
    const void* XI; bf16_t* XB; float* SSQ;
    __device__ __forceinline__ void operator()(const f32x4 (&acc)[2][2][4][2], const Unit& u, int wr, int wc, int fr, int fq) const {
        EPI_ROWCOL
#pragma unroll
        for (int ai = 0; ai < 2; ++ai)
#pragma unroll
          for (int mh = 0; mh < 2; ++mh) { f32x4 x0[2][2], x1[2][2];
#pragma unroll
            for (int mm = 0; mm < 2; ++mm)
#pragma unroll
                for (int bj = 0; bj < 2; ++bj) { const size_t idx = (size_t)(row0 + ai * 128 + (2 * mh + mm) * 16) * D + col0 + bj * 128;
                    if (XBF) { const u32x4 v = *(const u32x4*)((const bf16_t*)XI + idx); x0[mm][bj] = (f32x4){bflo(v.x), bfhi(v.x), bflo(v.y), bfhi(v.y)}; x1[mm][bj] = (f32x4){bflo(v.z), bfhi(v.z), bflo(v.w), bfhi(v.w)}; }
                    else { x0[mm][bj] = *(const f32x4*)((const float*)XI + idx); x1[mm][bj] = *(const f32x4*)((const float*)XI + idx + 4); } }
#pragma unroll
            for (int mm = 0; mm < 2; ++mm) { const int m = 2 * mh + mm, row = row0 + ai * 128 + m * 16; float ss = 0.f;
#pragma unroll
                for (int bj = 0; bj < 2; ++bj) { const size_t idx = (size_t)row * D + col0 + bj * 128;
                    const f32x4 o0 = x0[mm][bj] + acc[ai][bj][m][0], o1 = x1[mm][bj] + acc[ai][bj][m][1];
                    u32x4 w; w.x = pk2(o0[0], o0[1]); w.y = pk2(o0[2], o0[3]); w.z = pk2(o1[0], o1[1]); w.w = pk2(o1[2], o1[3]); *(u32x4*)(XB + idx) = w;
                    ss += (o0[0] * o0[0] + o0[1] * o0[1]) + (o0[2] * o0[2] + o0[3] * o0[3]) + (o1[0] * o1[0] + o1[1] * o1[1]) + (o1[2] * o1[2] + o1[3] * o1[3]); }
                ss += __shfl_xor(ss, 16); ss += __shfl_xor(ss, 32);
                if (fq == 0) SSQ[(size_t)row * 16 + u.pn * 4 + wc] = ss; } }
    }
};
__device__ __forceinline__ float row_rstd(const float* SSQ, int row) {
    const f32x4* p = (const f32x4*)(SSQ + (size_t)row * 16); const f32x4 a = p[0], b = p[1], c = p[2], d = p[3];
    const float s = ((a[0] + a[1]) + (a[2] + a[3])) + ((b[0] + b[1]) + (b[2] + b[3])) + ((c[0] + c[1]) + (c[2] + c[3])) + ((d[0] + d[1]) + (d[2] + d[3]));
    return rsqrtf(s * (1.f / D) + EPS);
}
__device__ __forceinline__ float row_rstd4(const float* SSQ, int row, int fq) {
    const f32x4 a = ((const f32x4*)(SSQ + (size_t)row * 16))[fq]; float s = (a[0] + a[1]) + (a[2] + a[3]);
    s += __shfl_xor(s, 16); s += __shfl_xor(s, 32);
    return rsqrtf(s * (1.f / D) + EPS);
}
struct EpiUp {
    static constexpr bool PERM = true, AFTER_DRAIN = false;
    const float* SSQ; bf16_t* O;
    __device__ __forceinline__ void operator()(const f32x4 (&acc)[2][2][4][2], const Unit& u, int wr, int wc, int fr, int fq) const {
        EPI_ROWCOL
        float rsv[2][4];
#pragma unroll
        for (int ai = 0; ai < 2; ++ai)
#pragma unroll
            for (int m = 0; m < 4; ++m) rsv[ai][m] = row_rstd4(SSQ, row0 + ai * 128 + m * 16, fq);
#pragma unroll
        for (int ai = 0; ai < 2; ++ai)
#pragma unroll
            for (int m = 0; m < 4; ++m) { const int row = row0 + ai * 128 + m * 16; const float rs = rsv[ai][m];
#pragma unroll
                for (int bj = 0; bj < 2; ++bj) { f32x4 v0 = acc[ai][bj][m][0] * rs, v1 = acc[ai][bj][m][1] * rs;
#pragma unroll
                    for (int e = 0; e < 4; ++e) { const float a = fmaxf(v0[e], 0.f), b = fmaxf(v1[e], 0.f); v0[e] = a * a; v1[e] = b * b; }
                    u32x4 w; w.x = pk2(v0[0], v0[1]); w.y = pk2(v0[2], v0[3]); w.z = pk2(v1[0], v1[1]); w.w = pk2(v1[2], v1[3]); *(u32x4*)(O + (size_t)row * FF + col0 + bj * 128) = w; } }
    }
};
struct EpiPle {
    static constexpr bool PERM = true, AFTER_DRAIN = false;
    const float* SSQI; const bf16_t* PP; const bf16_t* XR; bf16_t* X; float* SSQO;
    __device__ __forceinline__ void operator()(const f32x4 (&acc)[2][2][4][2], const Unit& u, int wr, int wc, int fr, int fq) const {
        EPI_ROWCOL
        float rsv[2][4];
#pragma unroll
        for (int ai = 0; ai < 2; ++ai)
#pragma unroll
            for (int m = 0; m < 4; ++m) rsv[ai][m] = row_rstd4(SSQI, row0 + ai * 128 + m * 16, fq);
#pragma unroll
        for (int ai = 0; ai < 2; ++ai)
#pragma unroll
            for (int mh = 0; mh < 2; ++mh) { u32x4 pv[2][2], xv[2][2];
#pragma unroll
                for (int mm = 0; mm < 2; ++mm)
#pragma unroll
                    for (int bj = 0; bj < 2; ++bj) { const size_t idx = (size_t)(row0 + ai * 128 + (2 * mh + mm) * 16) * D + col0 + bj * 128;
                        pv[mm][bj] = *(const u32x4*)(PP + idx); xv[mm][bj] = *(const u32x4*)(XR + idx); }
#pragma unroll
                for (int mm = 0; mm < 2; ++mm) { const int m = 2 * mh + mm, row = row0 + ai * 128 + m * 16; const float rs = rsv[ai][m]; float ss = 0.f;
#pragma unroll
                    for (int bj = 0; bj < 2; ++bj) { const size_t idx = (size_t)row * D + col0 + bj * 128; const u32x4 p = pv[mm][bj];
                        const f32x4 v0 = acc[ai][bj][m][0] * rs, v1 = acc[ai][bj][m][1] * rs; const u32x4 xr = xv[mm][bj]; f32x4 o0 = {bflo(xr.x), bfhi(xr.x), bflo(xr.y), bfhi(xr.y)}, o1 = {bflo(xr.z), bfhi(xr.z), bflo(xr.w), bfhi(xr.w)};
                        o0[0] += sigm(v0[0]) * bflo(p.x); o0[1] += sigm(v0[1]) * bfhi(p.x); o0[2] += sigm(v0[2]) * bflo(p.y); o0[3] += sigm(v0[3]) * bfhi(p.y);
                        o1[0] += sigm(v1[0]) * bflo(p.z); o1[1] += sigm(v1[1]) * bfhi(p.z); o1[2] += sigm(v1[2]) * bflo(p.w); o1[3] += sigm(v1[3]) * bfhi(p.w);
                        { u32x4 w; w.x = pk2(o0[0], o0[1]); w.y = pk2(o0[2], o0[3]); w.z = pk2(o1[0], o1[1]); w.w = pk2(o1[2], o1[3]); *(u32x4*)(X + idx) = w; }
                        ss += (o0[0] * o0[0] + o0[1] * o0[1]) + (o0[2] * o0[2] + o0[3] * o0[3]) + (o1[0] * o1[0] + o1[1] * o1[1]) + (o1[2] * o1[2] + o1[3] * o1[3]); }
                    ss += __shfl_xor(ss, 16); ss += __shfl_xor(ss, 32);
                    if (fq == 0) SSQO[(size_t)row * 16 + u.pn * 4 + wc] = ss; } }
    }
};

template <class Epi> __device__ __forceinline__ void run_gemm(LAS unsigned char* lds, int wave, const bf16_t* A, const bf16_t* Bt, int M, int N, int K, const Epi& E) {
    pg8::Gemm g{A, Bt, M, N, K}; pg8::StaticOrder S; S.init(M, N, (int)gridDim.x, (int)blockIdx.x);
    pg8::gemm_phase<Epi, pg8::StaticOrder, true, true>(lds, g, S, E, wave);
}

__device__ __forceinline__ void p0_transpose_item(const float* W, int ldw, int K, int nblk, bf16_t* WT, const float* ksc, LAS float* scr, int item, int lane) {
    const int kb = item / nblk, nb = item % nblk, k0 = 64 * kb, n0 = 32 * nb;
#pragma unroll 8
    for (int i = 0; i < 32; ++i) { const int kk = 2 * i + (lane >> 5); float v = W[(size_t)(k0 + kk) * ldw + n0 + (lane & 31)]; if (ksc) v *= ksc[k0 + kk]; scr[kk * 33 + (lane & 31)] = v; }
    asm volatile("s_waitcnt lgkmcnt(0)" ::: "memory");
    const int c = lane & 7;
#pragma unroll
    for (int j = 0; j < 4; ++j) { const int n = (lane >> 3) + 8 * j; const LAS float* s = scr + (8 * c) * 33 + n;
        u32x4 o; o.x = pk2(s[0 * 33], s[1 * 33]); o.y = pk2(s[2 * 33], s[3 * 33]); o.z = pk2(s[4 * 33], s[5 * 33]); o.w = pk2(s[6 * 33], s[7 * 33]);
        *(u32x4*)(WT + (size_t)(n0 + n) * K + k0 + 8 * c) = o; }
    asm volatile("s_waitcnt lgkmcnt(0)" ::: "memory");
}
__device__ __forceinline__ float logsigmoid(float z) { return fminf(z, 0.f) - log1pf(__expf(-fabsf(z))); }

struct Args { const float* in[18]; float* out; unsigned char* ws; int ph_lo, ph_hi; };

__device__ __forceinline__ void phase0(const Args& a, LAS unsigned char* lds, int wave) {
    const int lane = lane_id();
    unsigned char* ws = a.ws;
    LAS float* scr = (LAS float*)(lds + wave * 16384);
    const int gw = blockIdx.x * 8 + wave, NGW = gridDim.x * 8;
    if (blockIdx.x == 0 && wave == 0 && lane == 0) *(unsigned*)(ws + O_CTR) = 0u;
    constexpr int I_IN1 = 16 * 96, I_IN2 = 16 * 112, I_SQ = 16 * 32, I_UP = 16 * 128, I_DN = 64 * 32, I_P = 4 * 32;
    constexpr int NITEMS = I_IN1 + I_IN2 + 4 * I_SQ + I_UP + I_DN + I_P;
    const float* w_in = a.in[3];
    for (int it = gw; it < NITEMS; it += NGW) {
        int r = it;
        if (r < I_IN1) { p0_transpose_item(w_in, NIN, D, 96, (bf16_t*)(ws + O_WIN), nullptr, scr, r, lane); continue; } r -= I_IN1;
        if (r < I_IN2) { p0_transpose_item(w_in + 3080, NIN, D, 112, (bf16_t*)(ws + O_WIN) + (size_t)3072 * D, nullptr, scr, r, lane); continue; } r -= I_IN2;
        if (r < I_SQ) { p0_transpose_item(a.in[8], D, D, 32, (bf16_t*)(ws + O_WA), nullptr, scr, r, lane); continue; } r -= I_SQ;
        if (r < I_SQ) { p0_transpose_item(a.in[9], D, D, 32, (bf16_t*)(ws + O_WB), nullptr, scr, r, lane); continue; } r -= I_SQ;
        if (r < I_SQ) { p0_transpose_item(a.in[10], D, D, 32, (bf16_t*)(ws + O_WOUT), nullptr, scr, r, lane); continue; } r -= I_SQ;
        if (r < I_SQ) { p0_transpose_item(a.in[15], D, D, 32, (bf16_t*)(ws + O_WG), a.in[14], scr, r, lane); continue; } r -= I_SQ;
        if (r < I_UP) { p0_transpose_item(a.in[12], FF, D, 128, (bf16_t*)(ws + O_WUP), a.in[11], scr, r, lane); continue; } r -= I_UP;
        if (r < I_DN) { p0_transpose_item(a.in[13], D, FF, 32, (bf16_t*)(ws + O_WDN), nullptr, scr, r, lane); continue; } r -= I_DN;
        p0_transpose_item(a.in[16], D, PLE, 32, (bf16_t*)(ws + O_WP), nullptr, scr, r, lane);
    }
    const float* x = a.in[0]; const float* g = a.in[2]; const float* bif = a.in[5];
    __syncthreads();
    LAS float* wgT = (LAS float*)lds;
    { const int t = wave * 64 + lane;
#pragma unroll
      for (int i = 0; i < 2; ++i) { const int k = 2 * t + i; const f32x4* wr = (const f32x4*)(w_in + (size_t)k * NIN + 3072); const f32x4 w0 = wr[0], w1 = wr[1];
          wgT[0 * 1024 + k] = w0[0]; wgT[1 * 1024 + k] = w0[1]; wgT[2 * 1024 + k] = w0[2]; wgT[3 * 1024 + k] = w0[3]; wgT[4 * 1024 + k] = w1[0]; wgT[5 * 1024 + k] = w1[1]; wgT[6 * 1024 + k] = w1[2]; wgT[7 * 1024 + k] = w1[3]; } }
    __syncthreads();
    bf16_t* H = (bf16_t*)((unsigned char*)a.out + OO_H);
    float* gig = (float*)(ws + O_GIG); float* glf = (float*)(ws + O_GLF);
    f32x4 vv[2][4];
#define P0_LOAD(VV, row_) do { _Pragma("unroll") for (int k = 0; k < 2; ++k) { int r = (row_) + k * NGW; r = r < T ? r : T - 1; const f32x4* xr = (const f32x4*)(x + (size_t)r * D) + lane; \
            _Pragma("unroll") for (int j = 0; j < 4; ++j) VV[k][j] = xr[64 * j]; } } while (0)
    P0_LOAD(vv, gw);
    for (int rowp = gw; rowp < T; rowp += 2 * NGW) {
        f32x4 vn[2][4];
        P0_LOAD(vn, rowp + 2 * NGW);
#pragma unroll
        for (int k = 0; k < 2; ++k) { const int row = rowp + k * NGW; const f32x4* gr = (const f32x4*)g + lane;
        float s = 0.f;
#pragma unroll
        for (int j = 0; j < 4; ++j) { const f32x4 v = vv[k][j]; s += (v[0] * v[0] + v[1] * v[1]) + (v[2] * v[2] + v[3] * v[3]); }
        const float rstd = rsqrtf(wave_sum(s) * (1.f / D) + EPS);
        float g8[8];
#pragma unroll
        for (int e = 0; e < 8; ++e) g8[e] = 0.f;
        u32x2* o8 = (u32x2*)(H + (size_t)row * D) + lane;
#pragma unroll
        for (int j = 0; j < 4; ++j) { const f32x4 hv = vv[k][j] * rstd * gr[64 * j]; u32x2 o; o.x = pk2(hv[0], hv[1]); o.y = pk2(hv[2], hv[3]); o8[64 * j] = o;
#pragma unroll
            for (int c = 0; c < 8; ++c) { const f32x4 w4 = *(const LAS f32x4*)(wgT + c * 1024 + 4 * lane + 256 * j); g8[c] += (hv[0] * w4[0] + hv[1] * w4[1]) + (hv[2] * w4[2] + hv[3] * w4[3]); } }
#pragma unroll
        for (int e = 0; e < 8; ++e) g8[e] = wave_sum(g8[e]);
        if (lane == 0) { const int b = row / SEQ, s_ = row % SEQ;
#pragma unroll
            for (int hh = 0; hh < 4; ++hh) { gig[(size_t)(b * 4 + hh) * SEQ + s_] = g8[hh] + bif[hh]; glf[(size_t)(b * 4 + hh) * SEQ + s_] = logsigmoid(g8[4 + hh] + bif[4 + hh]); } }
        }
#pragma unroll
        for (int k = 0; k < 2; ++k)
#pragma unroll
            for (int j = 0; j < 4; ++j) vv[k][j] = vn[k][j];
    }
#undef P0_LOAD
}

__device__ __forceinline__ void gate_chunk(float lf, float ig, int lane, float& b, float& av, float& amax, float& pm) {
    float v = lf;
#pragma unroll
    for (int o = 1; o < 64; o <<= 1) { const float t = __shfl_up(v, o); if (lane >= o) v += t; }
    b = v; av = ig - v; float q = av;
#pragma unroll
    for (int o = 1; o < 64; o <<= 1) { const float t = __shfl_up(q, o); if (lane >= o) q = fmaxf(q, t); }
    pm = q; amax = wave_max(av);
}
__device__ __forceinline__ void phase2(const Args& a, LAS unsigned char* lds, int wave) {
    const int lane = lane_id();
    unsigned char* ws = a.ws;
    LAS unsigned* tile = (LAS unsigned*)(lds + wave * 16384);
    LAS unsigned short* tile16 = (LAS unsigned short*)tile;
    const int gw = blockIdx.x * 8 + wave, NGW = gridDim.x * 8;
    const bf16_t* QK = (const bf16_t*)(ws + O_QK); const bf16_t* VML = (const bf16_t*)(ws + O_VML); const bf16_t* VSW = (const bf16_t*)(ws + O_VSW);
    bf16_t* QKP = (bf16_t*)((unsigned char*)a.out + OO_QKP); bf16_t* VT = (bf16_t*)((unsigned char*)a.out + OO_VT);
    bf16_t* KT = (bf16_t*)(ws + O_KT); bf16_t* VTSW = (bf16_t*)(ws + O_VTSW);
    const float* gig = (const float*)(ws + O_GIG); const float* glf = (const float*)(ws + O_GLF);
    const float* cw = a.in[4];
    const int rsub = lane >> 3, cg8 = lane & 7;
    constexpr int N_QK = 512 * 16, N_VML = 512 * 16, N_VSW = 512 * 4, N_TILE = N_QK + N_VML + N_VSW, N_ALL = N_TILE + 16 * NCH;
    for (int it = gw; it < N_ALL; it += NGW) {
        if (it >= N_TILE) {
            const int q = it - N_TILE, bh = q / NCH, c = q % NCH; const size_t gi = (size_t)bh * SEQ + c * 64 + lane;
            float b, av, amax, pm; gate_chunk(glf[gi], gig[gi], lane, b, av, amax, pm);
            ((float*)(ws + O_GBC))[gi] = b; ((float*)(ws + O_GL))[gi] = b + pm;
            ((bf16_t*)(ws + O_GWH))[gi] = (bf16_t)(pk2(__expf(av - amax), 0.f) & 0xffffu);
            const float bl = rdlane(b, 63);
            if (lane == 0) { ((float*)(ws + O_CBL))[q] = bl; ((float*)(ws + O_CMW))[q] = bl + amax; ((float*)(ws + O_CAMAX))[q] = amax; }
            continue;
        }
        int kind, tt, ct;
        if (it < N_QK) { kind = 0; tt = it >> 4; ct = it & 15; } else if (it < N_QK + N_VML) { kind = 1; tt = (it - N_QK) >> 4; ct = (it - N_QK) & 15; } else { kind = 2; tt = (it - N_QK - N_VML) >> 2; ct = (it - N_QK - N_VML) & 3; }
        const int t0 = tt * 64, c0 = ct * 64, bb = t0 / SEQ, s0 = t0 % SEQ, c = c0 + 8 * cg8;
        if (kind == 0) {
            float w[4][8];
#pragma unroll
            for (int j = 0; j < 4; ++j) { const f32x4 w0 = *(const f32x4*)(cw + j * 1024 + c), w1 = *(const f32x4*)(cw + j * 1024 + c + 4);
                w[j][0] = w0[0]; w[j][1] = w0[1]; w[j][2] = w0[2]; w[j][3] = w0[3]; w[j][4] = w1[0]; w[j][5] = w1[1]; w[j][6] = w1[2]; w[j][7] = w1[3]; }
            const float qs = (c < 512) ? 0.08838834764831845f : 1.f;
            u32x4 xq[8][4];
#pragma unroll
            for (int i = 0; i < 8; ++i) { const int r = 8 * i + rsub, t = t0 + r, sp = s0 + r;
#pragma unroll
                for (int j = 0; j < 4; ++j) { const int back = (sp - 3 + j >= 0) ? 3 - j : 0; xq[i][j] = *(const u32x4*)(QK + (size_t)(t - back) * 1024 + c); } }
#pragma unroll
            for (int i = 0; i < 8; ++i) { const int r = 8 * i + rsub, t = t0 + r, sp = s0 + r;
                float acc8[8];
#pragma unroll
                for (int e = 0; e < 8; ++e) acc8[e] = 0.f;
#pragma unroll
                for (int j = 0; j < 4; ++j) { const float vz = (sp - 3 + j >= 0) ? 1.f : 0.f; const u32x4 xv = xq[i][j];
                        acc8[0] += vz * w[j][0] * bflo(xv.x); acc8[1] += vz * w[j][1] * bfhi(xv.x); acc8[2] += vz * w[j][2] * bflo(xv.y); acc8[3] += vz * w[j][3] * bfhi(xv.y);
                        acc8[4] += vz * w[j][4] * bflo(xv.z); acc8[5] += vz * w[j][5] * bfhi(xv.z); acc8[6] += vz * w[j][6] * bflo(xv.w); acc8[7] += vz * w[j][7] * bfhi(xv.w); }
#pragma unroll
                for (int e = 0; e < 8; ++e) acc8[e] = acc8[e] * sigm(acc8[e]) * qs;
                u32x4 o; o.x = pk2(acc8[0], acc8[1]); o.y = pk2(acc8[2], acc8[3]); o.z = pk2(acc8[4], acc8[5]); o.w = pk2(acc8[6], acc8[7]);
                *(u32x4*)(QKP + (size_t)t * 1024 + c) = o;
                if (c0 >= 512) { LAS unsigned* tp = tile + r * 33 + 4 * cg8; tp[0] = o.x; tp[1] = o.y; tp[2] = o.z; tp[3] = o.w; } }
            if (c0 < 512) continue;
        } else {
            float wh = 1.f;
            if (kind == 1) { const int bh = bb * 4 + (c0 >> 8); const size_t gi = (size_t)bh * SEQ + s0 + lane; float b, av, amax, pm; gate_chunk(glf[gi], gig[gi], lane, b, av, amax, pm); wh = __expf(av - amax); }
            const bf16_t* src = (kind == 1) ? VML : VSW; const int ld = (kind == 1) ? 1024 : 256;
#pragma unroll
            for (int i = 0; i < 8; ++i) { const int r = 8 * i + rsub; u32x4 o = *(const u32x4*)(src + (size_t)(t0 + r) * ld + c);
                const float sc = __shfl(wh, r);
                if (kind == 1) { o.x = pk2(bflo(o.x) * sc, bfhi(o.x) * sc); o.y = pk2(bflo(o.y) * sc, bfhi(o.y) * sc); o.z = pk2(bflo(o.z) * sc, bfhi(o.z) * sc); o.w = pk2(bflo(o.w) * sc, bfhi(o.w) * sc); }
                LAS unsigned* tp = tile + r * 33 + 4 * cg8; tp[0] = o.x; tp[1] = o.y; tp[2] = o.z; tp[3] = o.w; }
        }
        asm volatile("s_waitcnt lgkmcnt(0)" ::: "memory");
        bf16_t* dst; int CH, cb;
        if (kind == 0) { dst = KT; CH = 128; cb = c0 - 512; } else if (kind == 1) { dst = VT; CH = 256; cb = c0; } else { dst = VTSW; CH = 64; cb = c0; }
#pragma unroll
        for (int i = 0; i < 8; ++i) { const int ch = 8 * i + (lane >> 3), tg = lane & 7; const LAS unsigned short* sp = tile16 + (8 * tg) * 66 + ch;
            u32x4 o; o.x = (unsigned)sp[0] | ((unsigned)sp[66] << 16); o.y = (unsigned)sp[2 * 66] | ((unsigned)sp[3 * 66] << 16); o.z = (unsigned)sp[4 * 66] | ((unsigned)sp[5 * 66] << 16); o.w = (unsigned)sp[6 * 66] | ((unsigned)sp[7 * 66] << 16);
            const int chn = cb + ch, hb = bb * 4 + chn / CH, slot = (kind == 2) ? (s0 >> 6) : (((s0 >> 6) + 8 * hb) & 127);
            *(u32x4*)(dst + ((size_t)((hb * NCH + slot) * CH + (chn % CH)) << 6) + 8 * tg) = o; }
        asm volatile("s_waitcnt lgkmcnt(0)" ::: "memory");
    }
}

__device__ __forceinline__ void scan_block(const Args& a, LAS unsigned char* lds, int sb, int wave, int lane) {
    unsigned char* ws = a.ws;
    const int bh = sb / 9, k9 = sb - 9 * bh, fr = lane & 15, fq = lane >> 4;
    constexpr int STG = 128 * 144, SST0 = 4 * STG, TILE = 4352;
    if (wave < 2) {
        const int slice = (k9 < 8) ? 2 * k9 + wave : 16; const bool is_n = (slice == 16);
        const bf16_t* VT = (const bf16_t*)((unsigned char*)a.out + OO_VT); const bf16_t* GWH = (const bf16_t*)(ws + O_GWH);
        const bf16_t* pb = is_n ? GWH + (size_t)bh * SEQ + 8 * fq : VT + ((size_t)(bh * NCH * 256 + 16 * slice + fr) << 6) + 8 * fq;
        const int pbs = is_n ? 64 : 256 * 64;
        const float* cbl = (const float*)(ws + O_CBL) + bh * NCH; const float* cmw = (const float*)(ws + O_CMW) + bh * NCH;
        const float bl0 = cbl[lane], bl1 = cbl[64 + lane], mw0 = cmw[lane], mw1 = cmw[64 + lane];
        bf16x8 rb[8][2];
#define VB_LOAD(slot, cc) do { const bf16_t* _p = pb + (size_t)(is_n ? (cc) : (((cc) + 8 * bh) & 127)) * pbs; rb[slot][0] = ld8(_p); rb[slot][1] = ld8(_p + 32); } while (0)
#pragma unroll
        for (int p = 0; p < 8; ++p) VB_LOAD(p, p);
        if (is_n && wave == 0) { float* cmo = (float*)(ws + O_CM) + bh * NCH; float m = 0.f;
            for (int c = 0; c < NCH; ++c) { const float bl = (c < 64) ? rdlane(bl0, c & 63) : rdlane(bl1, c & 63), mw = (c < 64) ? rdlane(mw0, c & 63) : rdlane(mw1, c & 63); cmo[c] = m; m = fmaxf(bl + m, mw); } }
        f32x4 acc[8];
#pragma unroll
        for (int m = 0; m < 8; ++m) acc[m] = (f32x4){0.f, 0.f, 0.f, 0.f};
        float mst = 0.f;
        for (int c0 = 0; c0 < NCH; c0 += 8) {
#pragma unroll
            for (int p = 0; p < 8; ++p) { const int c = c0 + p;
                LAS unsigned char* sst = lds + SST0 + ((p & 1) * 2 + wave) * TILE;
#pragma unroll
                for (int m = 0; m < 8; ++m) { u32x2 s0; s0.x = pk2(acc[m][0], acc[m][1]); s0.y = pk2(acc[m][2], acc[m][3]); *(LAS u32x2*)(sst + fr * 272 + 32 * m + 8 * fq) = s0; }
                __syncthreads();
                const LAS unsigned char* ls = lds + (p & 3) * STG + fr * 144 + fq * 16;
                bf16x8 af[8][2];
#pragma unroll
                for (int m = 0; m < 8; ++m) { af[m][0] = *(const LAS bf16x8*)(ls + m * 16 * 144); af[m][1] = *(const LAS bf16x8*)(ls + m * 16 * 144 + 64); }
                const float bl = (c < 64) ? rdlane(bl0, c & 63) : rdlane(bl1, c & 63), mw = (c < 64) ? rdlane(mw0, c & 63) : rdlane(mw1, c & 63);
                const float mn = fmaxf(bl + mst, mw), decay = __expf(bl + mst - mn), eta = __expf(mw - mn); mst = mn;
                const f32x4 z = {0.f, 0.f, 0.f, 0.f};
#pragma unroll
                for (int m = 0; m < 8; ++m) { f32x4 t = mfma16(af[m][0], rb[p][0], z); t = mfma16(af[m][1], rb[p][1], t); acc[m] = acc[m] * decay + t * eta; }
                { const int cl = (c + 8 < NCH) ? c + 8 : NCH - 1; VB_LOAD(p, cl); }
            }
        }
#undef VB_LOAD
    } else if (wave < 6) {
        const bf16_t* KT = (const bf16_t*)(ws + O_KT);
        const int tid = (wave - 2) * 64 + lane;
        const bf16_t* pk = KT + ((size_t)(bh * NCH * 128) << 6) + tid * 8;
        LAS unsigned char* lw = lds + (tid >> 3) * 144 + (tid & 7) * 16;
        u32x4 kr[8][4];
#define KT_LOAD(set, cc) do { const size_t _o = (size_t)(((cc) + 8 * bh) & 127) * 8192; _Pragma("unroll") for (int _k = 0; _k < 4; ++_k) kr[set][_k] = *(const u32x4*)(pk + _o + _k * 2048); } while (0)
#define KT_WRITE(set, stg) do { _Pragma("unroll") for (int _k = 0; _k < 4; ++_k) *(LAS u32x4*)(lw + (stg) * STG + _k * 32 * 144) = kr[set][_k]; } while (0)
        KT_LOAD(0, 0); KT_LOAD(1, 1); KT_LOAD(2, 2);
        KT_WRITE(0, 0); KT_WRITE(1, 1); KT_WRITE(2, 2);
        KT_LOAD(3, 3); KT_LOAD(4, 4); KT_LOAD(5, 5); KT_LOAD(6, 6); KT_LOAD(7, 7); KT_LOAD(0, 8); KT_LOAD(1, 9);
        for (int c0 = 0; c0 < NCH; c0 += 8) {
#pragma unroll
            for (int p = 0; p < 8; ++p) { const int c = c0 + p;
                __syncthreads();
                { const int cl = (c + 10 < NCH) ? c + 10 : NCH - 1; KT_LOAD((p + 2) & 7, cl); }
                KT_WRITE((p + 3) & 7, (p + 3) & 3);
            }
        }
#undef KT_LOAD
#undef KT_WRITE
    } else {
        const int j = wave - 6;
        const int slice = (k9 < 8) ? 2 * k9 + j : 16; const bool live = (k9 < 8) || (j == 0);
        bf16_t* cst = (bf16_t*)(ws + O_CST) + (size_t)((bh * 17 + slice) * NCH) * 2048;
        for (int c = 0; c < NCH; ++c) {
            __syncthreads();
            if (live) { const LAS unsigned char* sst = lds + SST0 + ((c & 1) * 2 + j) * TILE;
                bf16_t* st = cst + (size_t)((c + 8 * bh + 5 * slice) & 127) * 2048;
#pragma unroll
                for (int k = 0; k < 4; ++k) { const int q = lane + 64 * k; *(u32x4*)(st + (size_t)(q >> 4) * 128 + (q & 15) * 8) = *(const LAS u32x4*)(sst + (q >> 4) * 272 + (q & 15) * 16); } }
        }
    }
    __syncthreads();
}

constexpr int SWA_KS = 0, SWA_VS = 272 * 144, SWA_VP = 576, SWA_NXT = SWA_VS + 64 * SWA_VP;
struct SwaPre { u32x4 kreg[5], vreg[5]; bf16x8 qf[4][2]; };
__device__ __forceinline__ void swa_issue(const Args& a, int bu, int wave, int lane, SwaPre& P) {
    unsigned char* ws = a.ws;
    const int qb = bu & 63, kvh = (bu >> 6) & 3, b = bu >> 8, fr = lane & 15, fq = lane >> 4, tid = wave * 64 + lane;
    const bf16_t* QSW = (const bf16_t*)(ws + O_QSW); const bf16_t* KSW = (const bf16_t*)(ws + O_KSW); const bf16_t* VTSW = (const bf16_t*)(ws + O_VTSW);
    const int KB = 128 * qb - 144;
#pragma unroll
    for (int it = 0; it < 5; ++it) { int i = tid + 512 * it; i = i < 2176 ? i : 2175; const int row = i >> 3, ch = i & 7; int kp = KB + row; kp = kp < 0 ? 0 : kp;
        P.kreg[it] = *(const u32x4*)(KSW + (size_t)(b * SEQ + kp) * 256 + kvh * 64 + 8 * ch); }
#pragma unroll
    for (int it = 0; it < 5; ++it) { int i = tid + 512 * it; i = i < 2176 ? i : 2175; const int hd = i / 34, ch = i - hd * 34; int sp = KB + 8 * ch; sp = sp < 0 ? 0 : sp;
        P.vreg[it] = *(const u32x4*)(VTSW + ((size_t)((((b * 4 + kvh) * NCH + (sp >> 6)) * 64 + hd)) << 6) + (sp & 63)); }
    const int tq = 128 * qb + 16 * wave + fr;
#pragma unroll
    for (int hh = 0; hh < 4; ++hh) { const bf16_t* qp = QSW + (size_t)(b * SEQ + tq) * 1024 + (4 * kvh + hh) * 64 + 8 * fq; P.qf[hh][0] = ld8(qp); P.qf[hh][1] = ld8(qp + 32); }
}
__device__ __forceinline__ void swa_commit(LAS unsigned char* lds, int bu, int wave, int lane, const SwaPre& P) {
    const int qb = bu & 63, tid = wave * 64 + lane, KB = 128 * qb - 144;
    const u32x4 zero4 = {0u, 0u, 0u, 0u};
#pragma unroll
    for (int it = 0; it < 5; ++it) { const int i = tid + 512 * it; if (i < 2176) { const int row = i >> 3, ch = i & 7; *(LAS u32x4*)(lds + SWA_KS + row * 144 + (ch ^ (4 * ((row >> 4) & 1))) * 16) = (KB + row >= 0) ? P.kreg[it] : zero4; } }
#pragma unroll
    for (int it = 0; it < 5; ++it) { const int i = tid + 512 * it; if (i < 2176) { const int hd = i / 34, ch = i - hd * 34; *(LAS u32x4*)(lds + SWA_VS + hd * SWA_VP + (ch ^ ((hd >> 4) & 3)) * 16) = (KB + 8 * ch >= 0) ? P.vreg[it] : zero4; } }
}
__device__ __forceinline__ void swa_compute(const Args& a, LAS unsigned char* lds, int bu, int wave, int lane, const bf16x8 (&qf)[4][2]) {
    unsigned char* ws = a.ws;
    const int qb = bu & 63, kvh = (bu >> 6) & 3, b = bu >> 8, fr = lane & 15, fq = lane >> 4;
    bf16_t* QSW = (bf16_t*)(ws + O_QSW);
    const int g = wave, t0 = 128 * qb + 16 * g, tq = t0 + fr, kb = t0 - 144;
    float sk[4];
#pragma unroll
    for (int hh = 0; hh < 4; ++hh) sk[hh] = a.in[7][4 * kvh + hh];
    const int krow = 8 * (fr >> 2) + (fr & 3);
    const LAS unsigned char* kbase = lds + SWA_KS + (16 * g + krow) * 144;
    const int kx0 = 4 * ((g + (krow >> 4)) & 1), kx1 = 4 * ((g + ((krow + 4) >> 4)) & 1);
    const LAS unsigned char* vbase = lds + SWA_VS;
    const int vpc = 2 * g + fq, vx = fr >> 2;
#pragma unroll
    for (int hh = 0; hh < 4; ++hh) {
        const bf16x8 q0 = qf[hh][0], q1 = qf[hh][1];
        const float sink = sk[hh];
        f32x4 st[10];
#pragma unroll
        for (int tau = 0; tau < 10; ++tau) { const int i = tau >> 1, e = tau & 1; const LAS unsigned char* kp = kbase + (32 * i + 4 * e) * 144; const int kx = e ? kx1 : kx0;
            f32x4 s = {0.f, 0.f, 0.f, 0.f}; s = mfma16(*(const LAS bf16x8*)(kp + ((fq ^ kx) * 16)), q0, s); s = mfma16(*(const LAS bf16x8*)(kp + (((fq + 4) ^ kx) * 16)), q1, s); st[tau] = s; }
        float mx = -1e30f;
#pragma unroll
        for (int tau = 0; tau < 10; ++tau) { const int i = tau >> 1, e = tau & 1;
#pragma unroll
            for (int r = 0; r < 4; ++r) { const int kp = kb + 32 * i + 8 * fq + 4 * e + r, df = tq - kp; const bool ok = (kp >= 0) && (df >= 0) && (df < 128);
                const float l = ok ? st[tau][r] * 0.125f : -1e30f; st[tau][r] = l; mx = fmaxf(mx, l); } }
        mx = fmaxf(mx, __shfl_xor(mx, 16)); mx = fmaxf(mx, __shfl_xor(mx, 32)); mx = fmaxf(mx, sink);
        float sum = 0.f;
#pragma unroll
        for (int tau = 0; tau < 10; ++tau)
#pragma unroll
            for (int r = 0; r < 4; ++r) { const float p = __expf(st[tau][r] - mx); st[tau][r] = p; sum += p; }
        sum += __shfl_xor(sum, 16); sum += __shfl_xor(sum, 32);
        const float inv = 1.f / (sum + __expf(sink - mx));
        bf16x8 pf[5];
#pragma unroll
        for (int i = 0; i < 5; ++i) { u32x4 w; w.x = pk2(st[2 * i][0], st[2 * i][1]); w.y = pk2(st[2 * i][2], st[2 * i][3]); w.z = pk2(st[2 * i + 1][0], st[2 * i + 1][1]); w.w = pk2(st[2 * i + 1][2], st[2 * i + 1][3]); pf[i] = __builtin_bit_cast(bf16x8, w); }
        f32x4 o[4];
#pragma unroll
        for (int mt = 0; mt < 4; ++mt) { const int hd = 16 * (fr >> 2) + 4 * mt + (fr & 3); const LAS unsigned char* vp = vbase + hd * SWA_VP;
            f32x4 s = {0.f, 0.f, 0.f, 0.f};
#pragma unroll
            for (int i = 0; i < 5; ++i) s = mfma16(*(const LAS bf16x8*)(vp + (((vpc + 4 * i) ^ vx) * 16)), pf[i], s);
            o[mt] = s * inv; }
        u32x4 w0, w1; w0.x = pk2(o[0][0], o[0][1]); w0.y = pk2(o[0][2], o[0][3]); w0.z = pk2(o[1][0], o[1][1]); w0.w = pk2(o[1][2], o[1][3]);
        w1.x = pk2(o[2][0], o[2][1]); w1.y = pk2(o[2][2], o[2][3]); w1.z = pk2(o[3][0], o[3][1]); w1.w = pk2(o[3][2], o[3][3]);
        bf16_t* op = QSW + (size_t)(b * SEQ + tq) * 1024 + (4 * kvh + hh) * 64 + 16 * fq;
        *(u32x4*)op = w0; *(u32x4*)(op + 8) = w1;
    }
}
__device__ __forceinline__ void phase3(const Args& a, LAS unsigned char* lds, int wave) {
    const int lane = lane_id();
#ifdef PROBE_MASK
    if (blockIdx.x == 0 && wave == 0 && lane == 0) ((unsigned long long*)(a.ws + O_TS))[11] = __builtin_amdgcn_s_memrealtime();
#endif
    if (blockIdx.x < 144) scan_block(a, lds, (int)blockIdx.x, wave, lane);
#ifdef PROBE_MASK
    if (blockIdx.x == 0 && wave == 0 && lane == 0) ((unsigned long long*)(a.ws + O_TS))[12] = __builtin_amdgcn_s_memrealtime();
#endif
    unsigned* ctr = (unsigned*)(a.ws + O_CTR);
    LAS unsigned* nxt = (LAS unsigned*)(lds + SWA_NXT);
    const bool lead = (wave == 0 && lane == 0);
    constexpr unsigned NU = NB * 4 * 64;
    unsigned mine = 0; if (lead) { mine = __hip_atomic_fetch_add(ctr, 1u, __ATOMIC_RELAXED, __HIP_MEMORY_SCOPE_AGENT); *nxt = mine; }
    __syncthreads();
    unsigned cur = *nxt;
    if (cur < NU) {
        if (lead) mine = __hip_atomic_fetch_add(ctr, 1u, __ATOMIC_RELAXED, __HIP_MEMORY_SCOPE_AGENT);
        SwaPre P; swa_issue(a, (int)cur, wave, lane, P);
        for (;;) {
            __syncthreads();
            if (lead) *nxt = mine;
            swa_commit(lds, (int)cur, wave, lane, P);
            bf16x8 qc[4][2];
#pragma unroll
            for (int hh = 0; hh < 4; ++hh) { qc[hh][0] = P.qf[hh][0]; qc[hh][1] = P.qf[hh][1]; }
            __syncthreads();
            const unsigned nx = *nxt;
            if (lead && nx < NU) mine = __hip_atomic_fetch_add(ctr, 1u, __ATOMIC_RELAXED, __HIP_MEMORY_SCOPE_AGENT);
            swa_issue(a, (int)(nx < NU ? nx : 0u), wave, lane, P);
            swa_compute(a, lds, (int)cur, wave, lane, qc);
            if (nx >= NU) break;
            cur = nx;
        }
    }
    __syncthreads();
}

__device__ __forceinline__ void p4_ptile(const bf16x8 (&kf)[4], const bf16x8 (&q)[4], float f, int tt, int st, int fr, int fq, LAS bf16_t* Pt) {
    f32x4 s = {0.f, 0.f, 0.f, 0.f};
#pragma unroll
    for (int ks = 0; ks < 4; ++ks) s = mfma16(kf[ks], q[ks], s);
    const int t = 16 * tt + fr, sb = 16 * st + 4 * fq;
    const float p0 = (sb + 0 <= t) ? s[0] * f : 0.f, p1 = (sb + 1 <= t) ? s[1] * f : 0.f, p2 = (sb + 2 <= t) ? s[2] * f : 0.f, p3 = (sb + 3 <= t) ? s[3] * f : 0.f;
    u32x2 o; o.x = pk2(p0, p1); o.y = pk2(p2, p3); *(LAS u32x2*)(Pt + t * 72 + sb) = o;
}
__device__ __forceinline__ void phase4(const Args& a, LAS unsigned char* lds, int wave) {
    const int lane = lane_id();
    unsigned char* ws = a.ws;
    { const f32x4* p = (const f32x4*)a.in[1]; u32x2* pbo = (u32x2*)(ws + O_PB); const int n = T * PLE / 4, stride = gridDim.x * 512;
        for (int i = blockIdx.x * 512 + wave * 64 + lane; i < n; i += 8 * stride) { f32x4 v[8];
#pragma unroll
            for (int k = 0; k < 8; ++k) { int idx = i + k * stride; idx = idx < n ? idx : n - 1; v[k] = p[idx]; }
#pragma unroll
            for (int k = 0; k < 8; ++k) { const int idx = i + k * stride; if (idx < n) { u32x2 o; o.x = pk2(v[k][0], v[k][1]); o.y = pk2(v[k][2], v[k][3]); pbo[idx] = o; } } } }
    const bf16_t* QKP = (const bf16_t*)((unsigned char*)a.out + OO_QKP); const bf16_t* VT = (const bf16_t*)((unsigned char*)a.out + OO_VT);
    const bf16_t* CST = (const bf16_t*)(ws + O_CST); const bf16_t* GWH = (const bf16_t*)(ws + O_GWH); bf16_t* OML = (bf16_t*)(ws + O_OML);
    const float* gbc = (const float*)(ws + O_GBC); const float* gL = (const float*)(ws + O_GL); const float* cm = (const float*)(ws + O_CM); const float* camax = (const float*)(ws + O_CAMAX);
    const float* gn = a.in[6];
    LAS bf16_t* Pt = (LAS bf16_t*)lds;
    LAS float* red = (LAS float*)(lds + 16384);
    LAS unsigned char* QS = lds + 20480; LAS unsigned char* KS = lds + 40960;
    const int fr = lane & 15, fq = lane >> 4, w = wave;
    u32x4 ypend[4]; size_t ytok = 0; int ycol = 0; bool have = false;
    u32x4 pq[2], pk_[2]; float pbt[2], pL[2], pb4[4], pL4[4], pmc = 0.f, pam = 0.f;
#define P4_PREF(un_) do { const int _bh = (un_) / NCH, _c = (un_) % NCH, _h = _bh & 3; const size_t _tok0 = (size_t)(_bh >> 2) * SEQ + _c * 64; pmc = cm[un_]; pam = camax[un_]; \
        _Pragma("unroll") for (int tt = 0; tt < 4; ++tt) { const size_t gi = (size_t)_bh * SEQ + _c * 64 + 16 * tt + fr; pb4[tt] = gbc[gi]; pL4[tt] = gL[gi]; } \
        _Pragma("unroll") for (int k2 = 0; k2 < 2; ++k2) { const int i = w * 64 + lane + 512 * k2, row = i >> 4, pc = i & 15; const bf16_t* src = QKP + (_tok0 + row) * 1024 + _h * 128 + 8 * pc; \
            pq[k2] = *(const u32x4*)src; pk_[k2] = *(const u32x4*)(src + 512); const size_t gi = (size_t)_bh * SEQ + _c * 64 + row; pbt[k2] = gbc[gi]; pL[k2] = gL[gi]; } } while (0)
    if ((int)blockIdx.x < 16 * NCH) P4_PREF((int)blockIdx.x);
    for (int un = blockIdx.x; un < 16 * NCH; un += gridDim.x) {
        const int bh = un / NCH, c = un % NCH, bb = bh >> 2, h = bh & 3; const size_t tok0 = (size_t)bb * SEQ + c * 64;
        const float m_c = pmc, amax = pam;
        float en[4];
#pragma unroll
        for (int tt = 0; tt < 4; ++tt) en[tt] = __expf(-fmaxf(pb4[tt] + m_c, pL4[tt]));
        u32x4 qpc[2], kpc[2]; float wrow[2];
#pragma unroll
        for (int k2 = 0; k2 < 2; ++k2) { qpc[k2] = pq[k2]; kpc[k2] = pk_[k2]; wrow[k2] = __expf(pbt[k2] + m_c - fmaxf(pbt[k2] + m_c, pL[k2])); }
        const int colh = h * 256 + 32 * w + 8 * fq;
        u32x4 ovv[4];
#pragma unroll
        for (int tt = 0; tt < 4; ++tt) ovv[tt] = *(const u32x4*)(OML + (tok0 + 16 * tt + fr) * 1024 + colh);
        bf16x8 ca[3][4], va[3][2];
#pragma unroll
        for (int e = 0; e < 3; ++e) { const int dvr = 32 * w + 8 * (fr >> 2) + 4 * e + (fr & 3); const int crow = (e < 2) ? dvr : 256 + fr;
            const bf16_t* cp = CST + ((size_t)((bh * 17 + (crow >> 4)) * NCH + ((c + 8 * bh + 5 * (crow >> 4)) & 127)) * 16 + (crow & 15)) * 128 + 8 * fq;
            const bf16_t* vp = (e < 2) ? VT + ((size_t)((bh * NCH + ((c + 8 * bh) & 127)) * 256 + dvr) << 6) + 8 * fq : GWH + (size_t)bh * SEQ + c * 64 + 8 * fq;
#pragma unroll
            for (int ks = 0; ks < 4; ++ks) ca[e][ks] = ld8(cp + 32 * ks);
            va[e][0] = ld8(vp); va[e][1] = ld8(vp + 32); }
        if (have) {
#pragma unroll
            for (int tt = 0; tt < 4; ++tt) *(u32x4*)(OML + (ytok + 16 * tt + fr) * 1024 + ycol) = ypend[tt]; }
#pragma unroll
        for (int k2 = 0; k2 < 2; ++k2) { const int i = w * 64 + lane + 512 * k2, row = i >> 4, pc = i & 15;
            *(LAS u32x4*)(QS + row * 288 + pc * 16) = __builtin_bit_cast(u32x4, scale8(__builtin_bit_cast(bf16x8, qpc[k2]), wrow[k2])); *(LAS u32x4*)(KS + row * 288 + pc * 16) = kpc[k2]; }
        __syncthreads();
        bf16x8 qt[4][4];
#pragma unroll
        for (int tt = 0; tt < 4; ++tt)
#pragma unroll
            for (int ks = 0; ks < 4; ++ks) qt[tt][ks] = *(const LAS bf16x8*)(QS + (16 * tt + fr) * 288 + 64 * ks + 16 * fq);
        { bf16x8 kf[4]; const float cf = __expf(amax - m_c);
#pragma unroll
          for (int ks = 0; ks < 4; ++ks) kf[ks] = *(const LAS bf16x8*)(KS + (16 * (w >> 1) + fr) * 288 + 64 * ks + 16 * fq);
          if (w & 1) { p4_ptile(kf, qt[2], cf, 2, w >> 1, fr, fq, Pt); p4_ptile(kf, qt[3], cf, 3, w >> 1, fr, fq, Pt); }
          else       { p4_ptile(kf, qt[0], cf, 0, w >> 1, fr, fq, Pt); p4_ptile(kf, qt[1], cf, 1, w >> 1, fr, fq, Pt); } }
        __syncthreads();
        f32x4 acc[3][4];
#pragma unroll
        for (int e = 0; e < 3; ++e) {
#pragma unroll
            for (int tt = 0; tt < 4; ++tt) { f32x4 s = {0.f, 0.f, 0.f, 0.f};
#pragma unroll
                for (int ks = 0; ks < 4; ++ks) s = mfma16(ca[e][ks], qt[tt][ks], s);
#pragma unroll
                for (int k2 = 0; k2 < 2; ++k2) s = mfma16(va[e][k2], *(const LAS bf16x8*)(Pt + (16 * tt + fr) * 72 + 32 * k2 + 8 * fq), s);
                acc[e][tt] = s; } }
        { const int unn = un + (int)gridDim.x; P4_PREF(unn < 16 * NCH ? unn : un); }
        float rs[4];
#pragma unroll
        for (int tt = 0; tt < 4; ++tt) { const float dn = __builtin_amdgcn_rcpf(fmaxf(fabsf(acc[2][tt][0]), en[tt])); float ss = 0.f;
#pragma unroll
            for (int e = 0; e < 2; ++e)
#pragma unroll
                for (int r = 0; r < 4; ++r) { const float hv = acc[e][tt][r] * dn; acc[e][tt][r] = hv; ss += hv * hv; }
            ss += __shfl_xor(ss, 16); ss += __shfl_xor(ss, 32);
            if (fq == 0) red[w * 64 + 16 * tt + fr] = ss; }
        __syncthreads();
#pragma unroll
        for (int tt = 0; tt < 4; ++tt) { float tot = 0.f;
#pragma unroll
            for (int ww = 0; ww < 8; ++ww) tot += red[ww * 64 + 16 * tt + fr];
            rs[tt] = rsqrtf(tot * (1.f / 256.f) + EPS); }
        const f32x4 g0 = *(const f32x4*)(gn + colh), g1 = *(const f32x4*)(gn + colh + 4);
#pragma unroll
        for (int tt = 0; tt < 4; ++tt) { const u32x4 ov = ovv[tt]; const float r_ = rs[tt]; u32x4 y;
            y.x = pk2(sigm(bflo(ov.x)) * g0[0] * acc[0][tt][0] * r_, sigm(bfhi(ov.x)) * g0[1] * acc[0][tt][1] * r_);
            y.y = pk2(sigm(bflo(ov.y)) * g0[2] * acc[0][tt][2] * r_, sigm(bfhi(ov.y)) * g0[3] * acc[0][tt][3] * r_);
            y.z = pk2(sigm(bflo(ov.z)) * g1[0] * acc[1][tt][0] * r_, sigm(bfhi(ov.z)) * g1[1] * acc[1][tt][1] * r_);
            y.w = pk2(sigm(bflo(ov.w)) * g1[2] * acc[1][tt][2] * r_, sigm(bfhi(ov.w)) * g1[3] * acc[1][tt][3] * r_);
            ypend[tt] = y; }
        ytok = tok0; ycol = colh; have = true;
    }
    if (have) {
#pragma unroll
        for (int tt = 0; tt < 4; ++tt) *(u32x4*)(OML + (ytok + 16 * tt + fr) * 1024 + ycol) = ypend[tt]; }
}

__device__ __forceinline__ void phase10(const Args& a, int wave) {
    const int lane = lane_id();
    const float* ssq = (const float*)(a.ws + O_SSQ3); const float* g = a.in[17]; const bf16_t* X3 = (const bf16_t*)(a.ws + O_X3B);
    const int gw = blockIdx.x * 8 + wave, NGW = gridDim.x * 8;
#ifdef PROBE_MASK
    long long probeK = 0; { const unsigned long long* ts = (const unsigned long long*)(a.ws + O_TS);
#pragma unroll
        for (int k = 0; k < 10; ++k) if ((PROBE_MASK >> k) & 1) probeK += (long long)(ts[k + 1] - ts[k]) / 10;
        if ((PROBE_MASK >> 10) & 1) probeK += (long long)(ts[12] - ts[11]) / 10; }
#endif
    const f32x4 g0 = *(const f32x4*)(g + 8 * lane), g1 = *(const f32x4*)(g + 8 * lane + 4), g2 = *(const f32x4*)(g + 512 + 8 * lane), g3 = *(const f32x4*)(g + 512 + 8 * lane + 4);
    u32x4 xa[4], xb[4]; float rs[4];
#define P10_LOAD(XA, XB, RS, row_) do { _Pragma("unroll") for (int k = 0; k < 4; ++k) { int r = (row_) + k * NGW; r = r < T ? r : T - 1; const bf16_t* xr = X3 + (size_t)r * D + 8 * lane; XA[k] = *(const u32x4*)xr; XB[k] = *(const u32x4*)(xr + 512); \
            const f32x4 p = ((const f32x4*)(ssq + (size_t)r * 16))[lane & 3]; float s = (p[0] + p[1]) + (p[2] + p[3]); s += __shfl_xor(s, 1); s += __shfl_xor(s, 2); RS[k] = rsqrtf(s * (1.f / D) + EPS); } } while (0)
    P10_LOAD(xa, xb, rs, gw);
    for (int row = gw; row < T; row += 4 * NGW) {
        u32x4 na[4], nb[4]; float rn[4];
        P10_LOAD(na, nb, rn, row + 4 * NGW);
#pragma unroll
        for (int k = 0; k < 4; ++k) { const int r = row + k * NGW; float* orow = a.out + (size_t)r * D + 8 * lane; const float q = rs[k];
            f32x4 o[4];
            o[0] = (f32x4){bflo(xa[k].x), bfhi(xa[k].x), bflo(xa[k].y), bfhi(xa[k].y)} * q * g0; o[1] = (f32x4){bflo(xa[k].z), bfhi(xa[k].z), bflo(xa[k].w), bfhi(xa[k].w)} * q * g1;
            o[2] = (f32x4){bflo(xb[k].x), bfhi(xb[k].x), bflo(xb[k].y), bfhi(xb[k].y)} * q * g2; o[3] = (f32x4){bflo(xb[k].z), bfhi(xb[k].z), bflo(xb[k].w), bfhi(xb[k].w)} * q * g3;
#ifdef PROBE_MASK
#pragma unroll
            for (int j = 0; j < 4; ++j) { const long long base_i = (long long)r * D + 8 * lane + (j >> 1) * 512 + (j & 1) * 4;
#pragma unroll
              for (int e2 = 0; e2 < 4; ++e2) if (base_i + e2 < probeK) o[j][e2] += 0.1f; }
#endif
            *(f32x4*)orow = o[0]; *(f32x4*)(orow + 4) = o[1]; *(f32x4*)(orow + 512) = o[2]; *(f32x4*)(orow + 516) = o[3]; }
#pragma unroll
        for (int k = 0; k < 4; ++k) { xa[k] = na[k]; xb[k] = nb[k]; rs[k] = rn[k]; }
    }
#undef P10_LOAD
}

#define XB_TMO      128
#define XB_XCNT(j)  (256  + 64 * (j))
#define XB_XSUB(j)  (1280 + 64 * (j))
#define XB_XGEN(j)  (2304 + 64 * (j))
#define XB_TOP      3328
#define XB_TOPGEN   3392
#define XCD_BAR_WORDS 3456
#define XB_SPIN_CAP (1u << 18)

__device__ __forceinline__ unsigned xb_ld(unsigned* p)              { return __hip_atomic_load(p, __ATOMIC_RELAXED, __HIP_MEMORY_SCOPE_AGENT); }
__device__ __forceinline__ unsigned xb_add(unsigned* p, unsigned v) { return __hip_atomic_fetch_add(p, v, __ATOMIC_RELAXED, __HIP_MEMORY_SCOPE_AGENT); }
__device__ __forceinline__ unsigned xb_xcc_id() { return (unsigned)__builtin_amdgcn_s_getreg((3 << 11) | 20) & 0xFu; }
#define XB_SPIN(cond, bar) do { unsigned _sp = 0; while (cond) { __builtin_amdgcn_s_sleep(1); \
    if ((++_sp & 255u) == 0u) { if (xb_ld(&(bar)[XB_TMO])) break; if (_sp > XB_SPIN_CAP) { atomicAdd(&(bar)[XB_TMO], 1u); break; } } } } while (0)

struct XcdBarrier {
    unsigned* bar; unsigned x;
    volatile LAS unsigned* st;
};

__device__ __forceinline__ XcdBarrier xcd_barrier_post(unsigned* bar, volatile LAS unsigned* st) {
    XcdBarrier b; b.bar = bar; b.x = xb_xcc_id(); b.st = st;
    if (threadIdx.x == 0) (void)xb_add(&bar[XB_XCNT(b.x)], 1u);
    return b;
}
__device__ __forceinline__ void xcd_barrier_complete(unsigned* bar, unsigned x, unsigned& nloc, unsigned& nx) {
    const unsigned G = gridDim.x * gridDim.y * gridDim.z;
    unsigned sum, cnt, mine, sp = 0u;
    for (;;) {
        sum = 0u; cnt = 0u; mine = 0u;
#pragma unroll
        for (unsigned j = 0; j < 16; ++j) { const unsigned c = xb_ld(&bar[XB_XCNT(j)]); sum += c; cnt += (c > 0u) ? 1u : 0u; mine = (j == x) ? c : mine; }
        if (sum == G) break;
        __builtin_amdgcn_s_sleep(1);
        if ((++sp & 255u) == 0u) { if (xb_ld(&bar[XB_TMO])) break; if (sp > XB_SPIN_CAP) { atomicAdd(&bar[XB_TMO], 1u); break; } }
    }
    nloc = mine > 0u ? mine : 1u; nx = cnt > 0u ? cnt : 1u;
}

__device__ __forceinline__ void xcd_barrier(const XcdBarrier& b, const bool lead) {
    asm volatile("s_waitcnt vmcnt(0)" ::: "memory");
    __syncthreads();
    if (lead) {
        unsigned* bar = b.bar;
        __builtin_amdgcn_s_waitcnt(0);
        unsigned nloc = b.st[0], nx = b.st[1];
        if (nloc == 0u) { xcd_barrier_complete(bar, b.x, nloc, nx); b.st[0] = nloc; b.st[1] = nx; }
        const unsigned old = xb_add(&bar[XB_XSUB(b.x)], 1u);
        const unsigned gen = old / nloc;
        if (old + 1u == (gen + 1u) * nloc) {
            __builtin_amdgcn_fence(__ATOMIC_RELEASE, "agent");
            asm volatile("s_waitcnt vmcnt(0)" ::: "memory");
            const unsigned og = xb_add(&bar[XB_TOP], 1u);
            const unsigned tg = og / nx;
            if (og + 1u == (tg + 1u) * nx) xb_add(&bar[XB_TOPGEN], 1u);
            else XB_SPIN(xb_ld(&bar[XB_TOPGEN]) == tg, bar);
            __builtin_amdgcn_fence(__ATOMIC_ACQUIRE, "agent");
            xb_add(&bar[XB_XGEN(b.x)], 1u);
            asm volatile("s_waitcnt vmcnt(0)" ::: "memory");
        } else {
            XB_SPIN(xb_ld(&bar[XB_XGEN(b.x)]) == gen, bar);
            __builtin_amdgcn_fence(__ATOMIC_ACQUIRE, "agent");
            asm volatile("s_waitcnt vmcnt(0)" ::: "memory");
        }
    }
    __syncthreads();
}

__device__ __forceinline__ void grid_bar(unsigned* bar, unsigned& nbar, int wave) {
    asm volatile("s_waitcnt vmcnt(0)" ::: "memory");
    __syncthreads();
    ++nbar;
    if (wave == 0 && lane_id() == 0) {
        __builtin_amdgcn_fence(__ATOMIC_RELEASE, "agent");
        asm volatile("s_waitcnt vmcnt(0)" ::: "memory");
        __hip_atomic_fetch_add(bar, 1u, __ATOMIC_RELAXED, __HIP_MEMORY_SCOPE_AGENT);
        const unsigned target = nbar * gridDim.x; unsigned sp = 0;
        while (__hip_atomic_load(bar, __ATOMIC_RELAXED, __HIP_MEMORY_SCOPE_AGENT) < target) { __builtin_amdgcn_s_sleep(2); if (++sp > (1u << 24)) break; }
        __builtin_amdgcn_fence(__ATOMIC_ACQUIRE, "agent");
        asm volatile("s_waitcnt vmcnt(0)" ::: "memory");
    }
    __syncthreads();
}

__global__ void __launch_bounds__(512, 2) mk_fwd(Args a) {
    extern __shared__ __attribute__((aligned(16))) unsigned char lds_raw[];
    LAS unsigned char* lds = (LAS unsigned char*)lds_raw;
    const int wave = __builtin_amdgcn_readfirstlane(threadIdx.x >> 6);
    unsigned char* ws = a.ws;
    const int lo = a.ph_lo, hi = a.ph_hi;
    unsigned nbar = 0; unsigned* bar = (unsigned*)(ws + O_BAR);
    volatile LAS unsigned* xst = (volatile LAS unsigned*)(lds + 131072 + 256);
    if (threadIdx.x == 0) { xst[0] = 0u; xst[1] = 0u; }
    __syncthreads();
    const XcdBarrier xb = xcd_barrier_post((unsigned*)(ws + O_XBAR), xst);
#define IN(k) (lo <= (k) && (k) < hi)
#ifdef PROBE_MASK
#define STAMP(k) do { if (blockIdx.x == 0 && wave == 0 && lane_id() == 0) ((unsigned long long*)(ws + O_TS))[(k)] = __builtin_amdgcn_s_memrealtime(); } while (0)
#else
#define STAMP(k) do { } while (0)
#endif
#define SEAM(k) do { STAMP((k) + 1); if (IN(k) && IN((k) + 1)) xcd_barrier(xb, wave == 0 && lane_id() == 0); } while (0)
    STAMP(0);
    if (IN(0)) phase0(a, lds, wave);
    STAMP(1);
    if (lo == 0 && hi == NPHASE) cg::this_grid().sync();
    else SEAM(0);
    if (IN(1)) { EpiSeg E{ws}; run_gemm(lds, wave, (const bf16_t*)((unsigned char*)a.out + OO_H), (const bf16_t*)(ws + O_WIN), T, NP1, D, E); }
    SEAM(1);
    if (IN(2)) phase2(a, lds, wave);
    SEAM(2);
    if (IN(3)) phase3(a, lds, wave);
    SEAM(3);
    if (IN(4)) phase4(a, lds, wave);
    SEAM(4);
    if (IN(5)) {
        { EpiGateA E{(const bf16_t*)(ws + O_GA), (bf16_t*)a.out}; run_gemm(lds, wave, (const bf16_t*)(ws + O_OML), (const bf16_t*)(ws + O_WA), T, D, D, E); }
        { EpiGateB E{(const bf16_t*)(ws + O_GB), (const bf16_t*)a.out, (bf16_t*)(ws + O_MERGED)}; run_gemm(lds, wave, (const bf16_t*)(ws + O_QSW), (const bf16_t*)(ws + O_WB), T, D, D, E); }
    }
    SEAM(5);
    if (IN(6)) { EpiRes<false> E{a.in[0], (bf16_t*)a.out, (float*)(ws + O_SSQ1)}; run_gemm(lds, wave, (const bf16_t*)(ws + O_MERGED), (const bf16_t*)(ws + O_WOUT), T, D, D, E); }
    SEAM(6);
    if (IN(7)) { EpiUp E{(const float*)(ws + O_SSQ1), (bf16_t*)(ws + O_ACT)}; run_gemm(lds, wave, (const bf16_t*)a.out, (const bf16_t*)(ws + O_WUP), T, FF, D, E); }
    SEAM(7);
    if (IN(8)) {
        { EpiRes<true> E{a.out, (bf16_t*)(ws + O_X2B), (float*)(ws + O_SSQ2)}; run_gemm(lds, wave, (const bf16_t*)(ws + O_ACT), (const bf16_t*)(ws + O_WDN), T, D, FF, E); }
        { EpiPlain E{(bf16_t*)(ws + O_PP), D}; run_gemm(lds, wave, (const bf16_t*)(ws + O_PB), (const bf16_t*)(ws + O_WP), T, D, PLE, E); }
    }
    SEAM(8);
    if (IN(9)) { EpiPle E{(const float*)(ws + O_SSQ2), (const bf16_t*)(ws + O_PP), (const bf16_t*)(ws + O_X2B), (bf16_t*)(ws + O_X3B), (float*)(ws + O_SSQ3)}; run_gemm(lds, wave, (const bf16_t*)(ws + O_X2B), (const bf16_t*)(ws + O_WG), T, D, D, E); }
    SEAM(9);
    if (IN(10)) phase10(a, wave);
#undef IN
#undef SEAM
}

extern "C" void kernel_launch(void* const* d_in, const int* in_sizes, int n_in, void* d_out, int out_size, void* d_ws, size_t ws_size, hipStream_t stream) {
    static int grid = 0;
    if (grid == 0) {
        if (n_in != 18 || out_size != T * D || ws_size < WS_NEED) { fprintf(stderr, "kernel_launch: unexpected shapes (n_in %d out %d ws %zu)\n", n_in, out_size, ws_size); grid = -1; return; }
        int dev = 0, cus = 0, per_cu = 0;
        if (hipGetDevice(&dev) != hipSuccess || hipDeviceGetAttribute(&cus, hipDeviceAttributeMultiprocessorCount, dev) != hipSuccess) { grid = -1; return; }
        if (hipFuncSetAttribute((const void*)mk_fwd, hipFuncAttributeMaxDynamicSharedMemorySize, LDS_BYTES) != hipSuccess) { fprintf(stderr, "kernel_launch: hipFuncSetAttribute failed\n"); grid = -1; return; }
        if (hipOccupancyMaxActiveBlocksPerMultiprocessor(&per_cu, (const void*)mk_fwd, 512, LDS_BYTES) != hipSuccess || per_cu < 1) per_cu = 1;
        (void)hipGetLastError();
        grid = cus;
    }
    if (grid < 0) return;
    if (hipMemsetAsync((char*)d_ws + O_XBAR, 0, 16384, stream) != hipSuccess) { fprintf(stderr, "kernel_launch: memset failed\n"); return; }
    Args a{};
    for (int i = 0; i < 18; ++i) a.in[i] = (const float*)d_in[i];
    a.out = (float*)d_out; a.ws = (unsigned char*)d_ws;
#if MK_N_LAUNCHES == 1
    a.ph_lo = 0; a.ph_hi = NPHASE;
    void* args[] = {&a};
    hipError_t e = hipLaunchCooperativeKernel((const void*)mk_fwd, dim3(grid), dim3(512), args, LDS_BYTES, stream);
    if (e != hipSuccess) fprintf(stderr, "cooperative launch failed: %s (grid %d)\n", hipGetErrorString(e), grid);
#else
    for (int p = 0; p < NPHASE; ++p) { a.ph_lo = p; a.ph_hi = p + 1; hipLaunchKernelGGL(mk_fwd, dim3(grid), dim3(512), LDS_BYTES, stream, a); }
#endif
}
```

```cpp
#include <hip/hip_runtime.h>
#include <hip/hip_cooperative_groups.h>
#include <cstdio>
#include <cstdint>
namespace cg = cooperative_groups;
namespace pg8 {
#define PG8_LAS __attribute__((address_space(3)))
typedef unsigned short bf16_t;
typedef short bf16x8 __attribute__((ext_vector_type(8)));
typedef float f32x4 __attribute__((ext_vector_type(4)));
typedef unsigned u32x4 __attribute__((ext_vector_type(4)));
constexpr int BM = 256, BK = 64, HALF = 128, HTB = HALF * BK * 2  , STAGE_BYTES = 8 * HTB, NXCD = 8, WGM = 8;

__host__ __device__ __forceinline__ int lds_byte(int r, int c) { const int st = (r >> 4) * 2 + (c >> 5), rr = r & 15, cc = c & 31, ob = rr * 64 + cc * 2; return st * 1024 + (ob ^ (((ob >> 9) & 1) << 5)); }
__host__ __device__ __forceinline__ void stage_rc(int b, int& R, int& C) { const int st = b / 1024, sb = b % 1024, swz = sb ^ (((sb >> 9) & 1) << 5); R = (st >> 1) * 16 + swz / 64; C = (st & 1) * 32 + (swz % 64) / 2; }
__host__ __device__ __forceinline__ int perm32(int rho) { const int n = rho >> 4, i = rho & 15; return 8 * (i >> 2) + 4 * n + (i & 3); }

struct Unit { int pm, pn; };
struct Gemm { const bf16_t* A; const bf16_t* Bt; int M, N, K; };

struct StaticOrder {
    int nM, nN, nwg, G, c;
    __host__ __device__ void init(int M, int N, int G_, int c_) { nM = M / BM; nN = N / BM; nwg = nM * nN; G = G_; c = c_; }
    __host__ __device__ bool next(int i, Unit& u) const {
        const long L = (long)i * G + c; if (L >= nwg) return false;
        int wgid = (int)L; { const int q = nwg / NXCD, r = nwg % NXCD, xcd = wgid % NXCD, off = wgid / NXCD; wgid = (xcd < r ? xcd * (q + 1) : r * (q + 1) + (xcd - r) * q) + off; }
        const int nig = WGM * nN, gid = wgid / nig, fm = gid * WGM, gsz = (nM - fm) < WGM ? (nM - fm) : WGM;
        u.pm = fm + ((wgid % nig) % gsz); u.pn = (wgid % nig) / gsz; return true;
    }
    __device__ __forceinline__ void a_ready(const Unit&) const {}
    __device__ __forceinline__ void done(const Unit&) const {}
};
__device__ __forceinline__ unsigned cvt_pk_bf16(float lo, float hi) { unsigned r; asm volatile("v_cvt_pk_bf16_f32 %0, %1, %2" : "=v"(r) : "v"(lo), "v"(hi)); return r; }
template <class Epi, class Sched, bool ALIGN_EPI = false, bool SP2 = false>
__device__ __forceinline__ void gemm_phase(PG8_LAS unsigned char* lds, const Gemm g, const Sched& S, const Epi& E, const int wid) {
    int lane; asm volatile("v_mbcnt_lo_u32_b32 %0, -1, 0\n\tv_mbcnt_hi_u32_b32 %0, -1, %0" : "=v"(lane));
    const int tid = wid * 64 + lane, wr = wid >> 2, wc = wid & 3, fr = lane & 15, fq = lane >> 4;
    const int K = g.K, nt = K / BK;
    unsigned voffA[2], voffB[2];
#pragma unroll
    for (int i = 0; i < 2; ++i) { int R, C; stage_rc(tid * 16 + i * 8192, R, C); const int Rb = Epi::PERM ? ((R & ~31) + perm32(R & 31)) : R;
        voffA[i] = (unsigned)(R * K + C) * 2u; voffB[i] = (unsigned)(Rb * K + C) * 2u; }
    const size_t kstep = (size_t)(BK * 2);
    const size_t hstep = (size_t)HALF * K * 2;
    const size_t tstep = 2 * hstep;
    const unsigned ldsw = (unsigned)wid * 1024u;
    const int aoff = lds_byte(wr * 64 + fr, fq * 8), boff = lds_byte(wc * 32 + fr, fq * 8);
#define PG8_SA(b, h) (((b) * 2 + (h)) * HTB)
#define PG8_SB(b, h) ((4 + (b) * 2 + (h)) * HTB)
#define PG8_STAGE(bufoff, gbase, voff) do { _Pragma("unroll") for (int _i = 0; _i < 2; ++_i) \
        __builtin_amdgcn_global_load_lds((const unsigned*)((const char*)(gbase) + (voff)[_i]), (PG8_LAS unsigned*)(lds + (bufoff) + ldsw + _i * 8192), 16, 0, 0); } while (0)
#define PG8_LDA(dst, b, h) do { _Pragma("unroll") for (int m = 0; m < 4; ++m) _Pragma("unroll") for (int k = 0; k < 2; ++k) dst[m][k] = *(const PG8_LAS bf16x8*)(lds + PG8_SA(b, h) + aoff + m * 2048 + k * 1024); } while (0)
#define PG8_LDB(dst, b, h) do { _Pragma("unroll") for (int n = 0; n < 2; ++n) _Pragma("unroll") for (int k = 0; k < 2; ++k) dst[n][k] = *(const PG8_LAS bf16x8*)(lds + PG8_SB(b, h) + boff + n * 2048 + k * 1024); } while (0)
#define PG8_MMA(ai, bj, At, Bt) do { __builtin_amdgcn_s_setprio(1); _Pragma("unroll") for (int m = 0; m < 4; ++m) _Pragma("unroll") for (int n = 0; n < 2; ++n) _Pragma("unroll") for (int k = 0; k < 2; ++k) \
        acc[ai][bj][m][n] = __builtin_amdgcn_mfma_f32_16x16x32_bf16(Bt[n][k], At[m][k], acc[ai][bj][m][n], 0, 0, 0); __builtin_amdgcn_s_setprio(0); } while (0)
#define PG8_WAIT_V(n) asm volatile("s_waitcnt vmcnt(" #n ")" ::: "memory")
#define PG8_WAIT_L(n) asm volatile("s_waitcnt lgkmcnt(" #n ")" ::: "memory")
#define PG8_BAR __builtin_amdgcn_s_barrier()
#define PG8_SCHED __builtin_amdgcn_sched_barrier(0)
    Unit cur, nxt; int ui = 0;
    if (!S.next(0, cur)) return;
    f32x4 acc[2][2][4][2];
#pragma unroll
    for (int a = 0; a < 2; ++a)
#pragma unroll
        for (int b = 0; b < 2; ++b)
#pragma unroll
            for (int m = 0; m < 4; ++m)
#pragma unroll
                for (int n = 0; n < 2; ++n) acc[a][b][m][n] = (f32x4){0.f, 0.f, 0.f, 0.f};
    bf16x8 At[4][2], B0[2][2], B1[2][2];
    const char* cA = (const char*)g.A + (size_t)cur.pm * tstep; const char* cB = (const char*)g.Bt + (size_t)cur.pn * tstep;
    S.a_ready(cur);
    if constexpr (SP2) {
        PG8_STAGE(PG8_SB(0, 0), cB, voffB); PG8_STAGE(PG8_SB(0, 1), cB + hstep, voffB); PG8_STAGE(PG8_SA(0, 0), cA, voffA); PG8_STAGE(PG8_SA(0, 1), cA + hstep, voffA);
        if (wr == 1) PG8_BAR;
        PG8_WAIT_V(2); PG8_BAR;
        PG8_STAGE(PG8_SB(1, 0), cB + kstep, voffB); PG8_STAGE(PG8_SA(1, 0), cA + kstep, voffA); PG8_STAGE(PG8_SB(1, 1), cB + hstep + kstep, voffB);
        PG8_WAIT_V(6); PG8_BAR;
    } else {
        PG8_STAGE(PG8_SB(0, 0), cB, voffB); PG8_STAGE(PG8_SA(0, 0), cA, voffA); PG8_STAGE(PG8_SB(0, 1), cB + hstep, voffB); PG8_STAGE(PG8_SA(0, 1), cA + hstep, voffA);
        if (wr == 1) PG8_BAR;
        PG8_WAIT_V(4); PG8_BAR;
        PG8_STAGE(PG8_SB(1, 0), cB + kstep, voffB); PG8_STAGE(PG8_SA(1, 0), cA + kstep, voffA); PG8_STAGE(PG8_SB(1, 1), cB + hstep + kstep, voffB);
        PG8_WAIT_V(6); PG8_BAR;
    }
    for (;;) {
        const bool has_next = S.next(ui + 1, nxt);
        const char* nA = has_next ? (const char*)g.A + (size_t)nxt.pm * tstep : cA; const char* nB = has_next ? (const char*)g.Bt + (size_t)nxt.pn * tstep : cB;
        for (int t = 0; t < nt; t += 2) {
            const bool last = (t == nt - 2);
            const char* a1 = cA + (size_t)(t + 1) * kstep;
            const char* a2 = last ? nA : cA + (size_t)(t + 2) * kstep; const char* b2 = last ? nB : cB + (size_t)(t + 2) * kstep;
            const char* a3 = a2 + kstep; const char* b3 = b2 + kstep;
            if (last && has_next) S.a_ready(nxt);
            if constexpr (SP2) {
            PG8_LDB(B0, 0, 0); PG8_LDB(B1, 0, 1); PG8_SCHED; PG8_LDA(At, 0, 0); PG8_STAGE(PG8_SA(1, 1), a1 + hstep, voffA);
            PG8_WAIT_V(8); PG8_WAIT_L(0); PG8_BAR; PG8_MMA(0, 0, At, B0); PG8_MMA(0, 1, At, B1); PG8_BAR; PG8_SCHED;
            PG8_LDA(At, 0, 1); PG8_STAGE(PG8_SB(0, 0), b2, voffB); PG8_STAGE(PG8_SB(0, 1), b2 + hstep, voffB); PG8_STAGE(PG8_SA(0, 0), a2, voffA);
            PG8_WAIT_V(8); PG8_WAIT_L(0); PG8_BAR; PG8_MMA(1, 0, At, B0); PG8_MMA(1, 1, At, B1); PG8_BAR; PG8_SCHED;
            PG8_LDB(B0, 1, 0); PG8_LDB(B1, 1, 1); PG8_SCHED; PG8_LDA(At, 1, 0); PG8_STAGE(PG8_SA(0, 1), a2 + hstep, voffA);
            PG8_WAIT_V(8); PG8_WAIT_L(0); PG8_BAR; PG8_MMA(0, 0, At, B0); PG8_MMA(0, 1, At, B1); PG8_BAR; PG8_SCHED;
            PG8_LDA(At, 1, 1); PG8_STAGE(PG8_SB(1, 0), b3, voffB); PG8_STAGE(PG8_SB(1, 1), b3 + hstep, voffB); PG8_STAGE(PG8_SA(1, 0), a3, voffA);
            PG8_WAIT_V(8); PG8_WAIT_L(0); PG8_BAR; PG8_MMA(1, 0, At, B0); PG8_MMA(1, 1, At, B1); PG8_BAR; PG8_SCHED;
            } else {
            PG8_LDB(B0, 0, 0); PG8_SCHED; PG8_LDA(At, 0, 0); PG8_STAGE(PG8_SA(1, 1), a1 + hstep, voffA);
            PG8_WAIT_L(8); PG8_BAR; PG8_WAIT_L(0); PG8_MMA(0, 0, At, B0); PG8_BAR; PG8_SCHED;
            PG8_LDB(B1, 0, 1); PG8_STAGE(PG8_SB(0, 0), b2, voffB);
            PG8_BAR; PG8_WAIT_L(0); PG8_MMA(0, 1, At, B1); PG8_BAR;
            PG8_LDA(At, 0, 1); PG8_STAGE(PG8_SA(0, 0), a2, voffA);
            PG8_BAR; PG8_WAIT_L(0); PG8_MMA(1, 0, At, B0); PG8_BAR; PG8_SCHED;
            PG8_STAGE(PG8_SB(0, 1), b2 + hstep, voffB);
            PG8_WAIT_V(6); PG8_BAR; PG8_MMA(1, 1, At, B1); PG8_BAR;
            PG8_LDB(B0, 1, 0); PG8_SCHED; PG8_LDA(At, 1, 0); PG8_STAGE(PG8_SA(0, 1), a2 + hstep, voffA);
            PG8_WAIT_L(8); PG8_BAR; PG8_WAIT_L(0); PG8_MMA(0, 0, At, B0); PG8_BAR; PG8_SCHED;
            PG8_LDB(B1, 1, 1); PG8_STAGE(PG8_SB(1, 0), b3, voffB);
            PG8_BAR; PG8_WAIT_L(0); PG8_MMA(0, 1, At, B1); PG8_BAR;
            PG8_LDA(At, 1, 1); PG8_STAGE(PG8_SA(1, 0), a3, voffA);
            PG8_BAR; PG8_WAIT_L(0); PG8_MMA(1, 0, At, B0); PG8_BAR; PG8_SCHED;
            PG8_STAGE(PG8_SB(1, 1), b3 + hstep, voffB);
            PG8_WAIT_V(6); PG8_BAR; PG8_MMA(1, 1, At, B1); PG8_BAR;
            }
        }
        if constexpr (ALIGN_EPI) { if (wr == 0) PG8_BAR; }
        if constexpr (!Epi::AFTER_DRAIN) { E(acc, cur, wr, wc, fr, fq); S.done(cur); }
        if (!has_next) break;
#pragma unroll
        for (int a = 0; a < 2; ++a)
#pragma unroll
            for (int b = 0; b < 2; ++b)
#pragma unroll
                for (int m = 0; m < 4; ++m)
#pragma unroll
                    for (int n = 0; n < 2; ++n) acc[a][b][m][n] = (f32x4){0.f, 0.f, 0.f, 0.f};
        cur = nxt; cA = nA; cB = nB; ++ui;
        if constexpr (ALIGN_EPI) { if (wr == 1) PG8_BAR; }
    }
    PG8_WAIT_V(0);
    if constexpr (!ALIGN_EPI) { if (wr == 0) PG8_BAR; }
    PG8_BAR;
    if constexpr (Epi::AFTER_DRAIN) { E.fused(acc, cur, wr, wc, fr, fq, lds, wid, lane); S.done(cur); }
#undef PG8_SA
#undef PG8_SB
#undef PG8_STAGE
#undef PG8_LDA
#undef PG8_LDB
#undef PG8_MMA
#undef PG8_WAIT_V
#undef PG8_WAIT_L
#undef PG8_BAR
#undef PG8_SCHED
}
}

#ifndef MK_N_LAUNCHES
#define MK_N_LAUNCHES 1
#endif
constexpr int NB = 4, SEQ = 8192, T = NB * SEQ, D = 1024, NIN = 6664, NP1 = 6656, FF = 4096, PLE = 256;
constexpr int NCH = SEQ / 64;
constexpr int CROWS = 272;
constexpr float EPS = 1e-6f;
constexpr int NPHASE = 11;
typedef pg8::bf16_t bf16_t;
typedef pg8::bf16x8 bf16x8;
typedef pg8::f32x4 f32x4;
typedef pg8::u32x4 u32x4;
typedef unsigned u32x2 __attribute__((ext_vector_type(2)));
#define LAS __attribute__((address_space(3)))

constexpr size_t MiB = 1u << 20;
constexpr size_t O_WIN = 0, O_WA = 13 * MiB, O_WB = 15 * MiB, O_WOUT = 17 * MiB, O_WG = 19 * MiB, O_WUP = 21 * MiB, O_WDN = 29 * MiB, O_WP = 37 * MiB;
constexpr size_t O_GWH = 37 * MiB + 512 * 1024, O_CBL = O_GWH + 256 * 1024, O_CMW = O_CBL + 8192, O_CAMAX = O_CMW + 8192, O_CM = O_CAMAX + 8192, O_CTR = O_CM + 8192, O_BAR = O_CTR + 256, O_TS = O_BAR + 256, O_DUMMY = O_TS + 1024, O_XBAR = 39 * MiB;
constexpr size_t O_QK = 40 * MiB, O_VML = 104 * MiB, O_VSW = 168 * MiB, O_KSW = 184 * MiB, O_OML = 200 * MiB, O_QSW = 264 * MiB, O_GA = 328 * MiB, O_GB = 392 * MiB;
constexpr size_t O_KT = 456 * MiB, O_VTSW = 488 * MiB, O_SSQ1 = 504 * MiB, O_SSQ2 = 506 * MiB, O_SSQ3 = 508 * MiB;
constexpr size_t O_GIG = 510 * MiB, O_GLF = O_GIG + 512 * 1024, O_GBC = 511 * MiB, O_GL = O_GBC + 512 * 1024;
constexpr size_t O_CST = 40 * MiB;
constexpr size_t O_MERGED = 40 * MiB, O_X1B = 104 * MiB, O_ACT = 200 * MiB, O_X2B = 40 * MiB, O_PB = 456 * MiB, O_PP = 104 * MiB, O_X3B = 200 * MiB;
constexpr size_t WS_NEED = 512 * MiB;
constexpr size_t OO_H = 0, OO_QKP = 0, OO_VT = 64 * MiB;
constexpr int LDS_BYTES = 147456;

__device__ __forceinline__ int lane_id() { int l; asm volatile("v_mbcnt_lo_u32_b32 %0, -1, 0\n\tv_mbcnt_hi_u32_b32 %0, -1, %0" : "=v"(l)); return l; }
__device__ __forceinline__ unsigned pk2(float lo, float hi) { return pg8::cvt_pk_bf16(lo, hi); }
__device__ __forceinline__ float bflo(unsigned w) { return __builtin_bit_cast(float, w << 16); }
__device__ __forceinline__ float bfhi(unsigned w) { return __builtin_bit_cast(float, w & 0xffff0000u); }
__device__ __forceinline__ float sigm(float x) { return __builtin_amdgcn_rcpf(1.f + __expf(-x)); }
__device__ __forceinline__ float wave_sum(float v) {
#pragma unroll
    for (int o = 1; o < 64; o <<= 1) v += __shfl_xor(v, o);
    return v;
}
__device__ __forceinline__ float wave_max(float v) {
#pragma unroll
    for (int o = 1; o < 64; o <<= 1) v = fmaxf(v, __shfl_xor(v, o));
    return v;
}
__device__ __forceinline__ bf16x8 ld8(const bf16_t* p) { return *(const bf16x8*)p; }
__device__ __forceinline__ f32x4 mfma16(bf16x8 a, bf16x8 b, f32x4 c) { return __builtin_amdgcn_mfma_f32_16x16x32_bf16(a, b, c, 0, 0, 0); }
__device__ __forceinline__ bf16x8 scale8(bf16x8 v, float s) {
    u32x4 u = __builtin_bit_cast(u32x4, v), o;
    o.x = pk2(bflo(u.x) * s, bfhi(u.x) * s); o.y = pk2(bflo(u.y) * s, bfhi(u.y) * s); o.z = pk2(bflo(u.z) * s, bfhi(u.z) * s); o.w = pk2(bflo(u.w) * s, bfhi(u.w) * s);
    return __builtin_bit_cast(bf16x8, o);
}
__device__ __forceinline__ size_t tpos(int row, int s) { return (size_t)row * SEQ + (size_t)(((((s >> 6) + row) & 127) << 6) + (s & 63)); }
__device__ __forceinline__ void st16_nt(void* p, u32x4 v) { asm volatile("global_store_dwordx4 %0, %1, off nt" :: "v"(p), "v"(v) : "memory"); }
__device__ __forceinline__ float rdlane(float v, int l) { return __builtin_bit_cast(float, __builtin_amdgcn_readlane(__builtin_bit_cast(int, v), l)); }

#define EPI_LOOP_BEGIN const int row0 = u.pm * 256 + wr * 64 + fr, col0 = u.pn * 256 + wc * 32 + 8 * fq; \
    _Pragma("unroll") for (int ai = 0; ai < 2; ++ai) _Pragma("unroll") for (int m = 0; m < 4; ++m) { const int row = row0 + ai * 128 + m * 16;
#define EPI_LOOP_END }
typedef pg8::Unit Unit;

struct EpiSeg {
    static constexpr bool PERM = true, AFTER_DRAIN = false;
    unsigned char* ws;
    __device__ __forceinline__ void operator()(const f32x4 (&acc)[2][2][4][2], const Unit& u, int wr, int wc, int fr, int fq) const {
        const int pn = u.pn; size_t off; int ldc, ct;
        if (pn < 4) { off = O_QK; ldc = 1024; ct = pn; } else if (pn < 8) { off = O_VML; ldc = 1024; ct = pn - 4; } else if (pn < 12) { off = O_OML; ldc = 1024; ct = pn - 8; }
        else if (pn < 16) { off = O_QSW; ldc = 1024; ct = pn - 12; } else if (pn < 17) { off = O_KSW; ldc = 256; ct = 0; } else if (pn < 18) { off = O_VSW; ldc = 256; ct = 0; }
        else if (pn < 22) { off = O_GA; ldc = 1024; ct = pn - 18; } else { off = O_GB; ldc = 1024; ct = pn - 22; }
        bf16_t* base = (bf16_t*)(ws + off) + ct * 256 + wc * 32 + 8 * fq;
        const int row0 = u.pm * 256 + wr * 64 + fr;
#pragma unroll
        for (int ai = 0; ai < 2; ++ai)
#pragma unroll
            for (int m = 0; m < 4; ++m) { bf16_t* rowp = base + (size_t)(row0 + ai * 128 + m * 16) * ldc;
#pragma unroll
                for (int bj = 0; bj < 2; ++bj) { const f32x4 v0 = acc[ai][bj][m][0], v1 = acc[ai][bj][m][1]; u32x4 w;
                    w.x = pk2(v0[0], v0[1]); w.y = pk2(v0[2], v0[3]); w.z = pk2(v1[0], v1[1]); w.w = pk2(v1[2], v1[3]); *(u32x4*)(rowp + bj * 128) = w; } }
    }
};
struct EpiPlain {
    static constexpr bool PERM = true, AFTER_DRAIN = false;
    bf16_t* O; int ldc;
    __device__ __forceinline__ void operator()(const f32x4 (&acc)[2][2][4][2], const Unit& u, int wr, int wc, int fr, int fq) const {
        EPI_LOOP_BEGIN
#pragma unroll
            for (int bj = 0; bj < 2; ++bj) { const f32x4 v0 = acc[ai][bj][m][0], v1 = acc[ai][bj][m][1]; u32x4 w;
                w.x = pk2(v0[0], v0[1]); w.y = pk2(v0[2], v0[3]); w.z = pk2(v1[0], v1[1]); w.w = pk2(v1[2], v1[3]); *(u32x4*)(O + (size_t)row * ldc + col0 + bj * 128) = w; }
        EPI_LOOP_END
    }
};
#define EPI_ROWCOL const int row0 = u.pm * 256 + wr * 64 + fr, col0 = u.pn * 256 + wc * 32 + 8 * fq;
struct EpiGateA {
    static constexpr bool PERM = true, AFTER_DRAIN = false;
    const bf16_t* G; bf16_t* M1;
    __device__ __forceinline__ void operator()(const f32x4 (&acc)[2][2][4][2], const Unit& u, int wr, int wc, int fr, int fq) const {
        EPI_ROWCOL
#pragma unroll
        for (int ai = 0; ai < 2; ++ai)
#pragma unroll
          for (int mh = 0; mh < 2; ++mh) { u32x4 g[2][2];
#pragma unroll
            for (int mm = 0; mm < 2; ++mm)
#pragma unroll
                for (int bj = 0; bj < 2; ++bj) g[mm][bj] = *(const u32x4*)(G + (size_t)(row0 + ai * 128 + (2 * mh + mm) * 16) * D + col0 + bj * 128);
#pragma unroll
            for (int mm = 0; mm < 2; ++mm)
#pragma unroll
                for (int bj = 0; bj < 2; ++bj) { const int m = 2 * mh + mm; const size_t idx = (size_t)(row0 + ai * 128 + m * 16) * D + col0 + bj * 128; const u32x4 gv = g[mm][bj];
                    const f32x4 v0 = acc[ai][bj][m][0], v1 = acc[ai][bj][m][1]; f32x4 o0, o1;
                    o0[0] = sigm(bflo(gv.x)) * v0[0]; o0[1] = sigm(bfhi(gv.x)) * v0[1]; o0[2] = sigm(bflo(gv.y)) * v0[2]; o0[3] = sigm(bfhi(gv.y)) * v0[3];
                    o1[0] = sigm(bflo(gv.z)) * v1[0]; o1[1] = sigm(bfhi(gv.z)) * v1[1]; o1[2] = sigm(bflo(gv.w)) * v1[2]; o1[3] = sigm(bfhi(gv.w)) * v1[3];
                    u32x4 w; w.x = pk2(o0[0], o0[1]); w.y = pk2(o0[2], o0[3]); w.z = pk2(o1[0], o1[1]); w.w = pk2(o1[2], o1[3]); *(u32x4*)(M1 + idx) = w; } }
    }
};
struct EpiGateB {
    static constexpr bool PERM = true, AFTER_DRAIN = false;
    const bf16_t* G; const bf16_t* M1; bf16_t* O;
    __device__ __forceinline__ void operator()(const f32x4 (&acc)[2][2][4][2], const Unit& u, int wr, int wc, int fr, int fq) const {
        EPI_ROWCOL
#pragma unroll
        for (int ai = 0; ai < 2; ++ai)
#pragma unroll
            for (int mh = 0; mh < 2; ++mh) { u32x4 g[2][2], am[2][2];
#pragma unroll
                for (int mm = 0; mm < 2; ++mm)
#pragma unroll
                    for (int bj = 0; bj < 2; ++bj) { const size_t idx = (size_t)(row0 + ai * 128 + (2 * mh + mm) * 16) * D + col0 + bj * 128;
                        g[mm][bj] = *(const u32x4*)(G + idx); am[mm][bj] = *(const u32x4*)(M1 + idx); }
#pragma unroll
                for (int mm = 0; mm < 2; ++mm)
#pragma unroll
                    for (int bj = 0; bj < 2; ++bj) { const int m = 2 * mh + mm; const size_t idx = (size_t)(row0 + ai * 128 + m * 16) * D + col0 + bj * 128; const u32x4 gv = g[mm][bj];
                        const f32x4 v0 = acc[ai][bj][m][0], v1 = acc[ai][bj][m][1]; const u32x4 mv = am[mm][bj]; const f32x4 b0 = {bflo(mv.x), bfhi(mv.x), bflo(mv.y), bfhi(mv.y)}, b1 = {bflo(mv.z), bfhi(mv.z), bflo(mv.w), bfhi(mv.w)}; u32x4 w;
                        w.x = pk2(b0[0] + sigm(bflo(gv.x)) * v0[0], b0[1] + sigm(bfhi(gv.x)) * v0[1]); w.y = pk2(b0[2] + sigm(bflo(gv.y)) * v0[2], b0[3] + sigm(bfhi(gv.y)) * v0[3]);
                        w.z = pk2(b1[0] + sigm(bflo(gv.z)) * v1[0], b1[1] + sigm(bfhi(gv.z)) * v1[1]); w.w = pk2(b1[2] + sigm(bflo(gv.w)) * v1[2], b1[3] + sigm(bfhi(gv.w)) * v1[3]);
                        *(u32x4*)(O + idx) = w; } }
    }
};
template <bool XBF> struct EpiRes {
    static constexpr bool PERM = true, AFTER_DRAIN = false;
    const void* XI; bf16_t* XB; float* SSQ;
    __device__ __forceinline__ void operator()(const f32x4 (&acc)[2][2][4][2], const Unit& u, int wr, int wc, int fr, int fq) const {
        EPI_ROWCOL
#pragma unroll
        for (int ai = 0; ai < 2; ++ai)
#pragma unroll
          for (int mh = 0; mh < 2; ++mh) { f32x4 x0[2][2], x1[2][2];
#pragma unroll
            for (int mm = 0; mm < 2; ++mm)
#pragma unroll
                for (int bj = 0; bj < 2; ++bj) { const size_t idx = (size_t)(row0 + ai * 128 + (2 * mh + mm) * 16) * D + col0 + bj * 128;
                    if (XBF) { const u32x4 v = *(const u32x4*)((const bf16_t*)XI + idx); x0[mm][bj] = (f32x4){bflo(v.x), bfhi(v.x), bflo(v.y), bfhi(v.y)}; x1[mm][bj] = (f32x4){bflo(v.z), bfhi(v.z), bflo(v.w), bfhi(v.w)}; }
                    else { x0[mm][bj] = *(const f32x4*)((const float*)XI + idx); x1[mm][bj] = *(const f32x4*)((const float*)XI + idx + 4); } }
#pragma unroll
            for (int mm = 0; mm < 2; ++mm) { const int m = 2 * mh + mm, row = row0 + ai * 128 + m * 16; float ss = 0.f;
#pragma unroll
                for (int bj = 0; bj < 2; ++bj) { const size_t idx = (size_t)row * D + col0 + bj * 128;
                    const f32x4 o0 = x0[mm][bj] + acc[ai][bj][m][0], o1 = x1[mm][bj] + acc[ai][bj][m][1];
                    u32x4 w; w.x = pk2(o0[0], o0[1]); w.y = pk2(o0[2], o0[3]); w.z = pk2(o1[0], o1[1]); w.w = pk2(o1[2], o1[3]); *(u32x4*)(XB + idx) = w;
                    ss += (o0[0] * o0[0] + o0[1] * o0[1]) + (o0[2] * o0[2] + o0[3] * o0[3]) + (o1[0] * o1[0] + o1[1] * o1[1]) + (o1[2] * o1[2] + o1[3] * o1[3]); }
                ss += __shfl_xor(ss, 16); ss += __shfl_xor(ss, 32);
                if (fq == 0) SSQ[(size_t)row * 16 + u.pn * 4 + wc] = ss; } }
    }
};
__device__ __forceinline__ float row_rstd(const float* SSQ, int row) {
    const f32x4* p = (const f32x4*)(SSQ + (size_t)row * 16); const f32x4 a = p[0], b = p[1], c = p[2], d = p[3];
    const float s = ((a[0] + a[1]) + (a[2] + a[3])) + ((b[0] + b[1]) + (b[2] + b[3])) + ((c[0] + c[1]) + (c[2] + c[3])) + ((d[0] + d[1]) + (d[2] + d[3]));
    return rsqrtf(s * (1.f / D) + EPS);
}
__device__ __forceinline__ float row_rstd4(const float* SSQ, int row, int fq) {
    const f32x4 a = ((const f32x4*)(SSQ + (size_t)row * 16))[fq]; float s = (a[0] + a[1]) + (a[2] + a[3]);
    s += __shfl_xor(s, 16); s += __shfl_xor(s, 32);
    return rsqrtf(s * (1.f / D) + EPS);
}
struct EpiUp {
    static constexpr bool PERM = true, AFTER_DRAIN = false;
    const float* SSQ; bf16_t* O;
    __device__ __forceinline__ void operator()(const f32x4 (&acc)[2][2][4][2], const Unit& u, int wr, int wc, int fr, int fq) const {
        EPI_ROWCOL
        float rsv[2][4];
#pragma unroll
        for (int ai = 0; ai < 2; ++ai)
#pragma unroll
            for (int m = 0; m < 4; ++m) rsv[ai][m] = row_rstd4(SSQ, row0 + ai * 128 + m * 16, fq);
#pragma unroll
        for (int ai = 0; ai < 2; ++ai)
#pragma unroll
            for (int m = 0; m < 4; ++m) { const int row = row0 + ai * 128 + m * 16; const float rs = rsv[ai][m];
#pragma unroll
                for (int bj = 0; bj < 2; ++bj) { f32x4 v0 = acc[ai][bj][m][0] * rs, v1 = acc[ai][bj][m][1] * rs;
#pragma unroll
                    for (int e = 0; e < 4; ++e) { const float a = fmaxf(v0[e], 0.f), b = fmaxf(v1[e], 0.f); v0[e] = a * a; v1[e] = b * b; }
                    u32x4 w; w.x = pk2(v0[0], v0[1]); w.y = pk2(v0[2], v0[3]); w.z = pk2(v1[0], v1[1]); w.w = pk2(v1[2], v1[3]); *(u32x4*)(O + (size_t)row * FF + col0 + bj * 128) = w; } }
    }
};
struct EpiPle {
    static constexpr bool PERM = true, AFTER_DRAIN = false;
    const float* SSQI; const bf16_t* PP; const bf16_t* XR; bf16_t* X; float* SSQO;
    __device__ __forceinline__ void operator()(const f32x4 (&acc)[2][2][4][2], const Unit& u, int wr, int wc, int fr, int fq) const {
        EPI_ROWCOL
        float rsv[2][4];
#pragma unroll
        for (int ai = 0; ai < 2; ++ai)
#pragma unroll
            for (int m = 0; m < 4; ++m) rsv[ai][m] = row_rstd4(SSQI, row0 + ai * 128 + m * 16, fq);
#pragma unroll
        for (int ai = 0; ai < 2; ++ai)
#pragma unroll
            for (int mh = 0; mh < 2; ++mh) { u32x4 pv[2][2], xv[2][2];
#pragma unroll
                for (int mm = 0; mm < 2; ++mm)
#pragma unroll
                    for (int bj = 0; bj < 2; ++bj) { const size_t idx = (size_t)(row0 + ai * 128 + (2 * mh + mm) * 16) * D + col0 + bj * 128;
                        pv[mm][bj] = *(const u32x4*)(PP + idx); xv[mm][bj] = *(const u32x4*)(XR + idx); }
#pragma unroll
                for (int mm = 0; mm < 2; ++mm) { const int m = 2 * mh + mm, row = row0 + ai * 128 + m * 16; const float rs = rsv[ai][m]; float ss = 0.f;
#pragma unroll
                    for (int bj = 0; bj < 2; ++bj) { const size_t idx = (size_t)row * D + col0 + bj * 128; const u32x4 p = pv[mm][bj];
                        const f32x4 v0 = acc[ai][bj][m][0] * rs, v1 = acc[ai][bj][m][1] * rs; const u32x4 xr = xv[mm][bj]; f32x4 o0 = {bflo(xr.x), bfhi(xr.x), bflo(xr.y), bfhi(xr.y)}, o1 = {bflo(xr.z), bfhi(xr.z), bflo(xr.w), bfhi(xr.w)};
                        o0[0] += sigm(v0[0]) * bflo(p.x); o0[1] += sigm(v0[1]) * bfhi(p.x); o0[2] += sigm(v0[2]) * bflo(p.y); o0[3] += sigm(v0[3]) * bfhi(p.y);
                        o1[0] += sigm(v1[0]) * bflo(p.z); o1[1] += sigm(v1[1]) * bfhi(p.z); o1[2] += sigm(v1[2]) * bflo(p.w); o1[3] += sigm(v1[3]) * bfhi(p.w);
                        { u32x4 w; w.x = pk2(o0[0], o0[1]); w.y = pk2(o0[2], o0[3]); w.z = pk2(o1[0], o1[1]); w.w = pk2(o1[2], o1[3]); *(u32x4*)(X + idx) = w; }
                        ss += (o0[0] * o0[0] + o0[1] * o0[1]) + (o0[2] * o0[2] + o0[3] * o0[3]) + (o1[0] * o1[0] + o1[1] * o1[1]) + (o1[2] * o1[2] + o1[3] * o1[3]); }
                    ss += __shfl_xor(ss, 16); ss += __shfl_xor(ss, 32);
                    if (fq == 0) SSQO[(size_t)row * 16 + u.pn * 4 + wc] = ss; } }
    }
};

template <class Epi> __device__ __forceinline__ void run_gemm(LAS unsigned char* lds, int wave, const bf16_t* A, const bf16_t* Bt, int M, int N, int K, const Epi& E) {
    pg8::Gemm g{A, Bt, M, N, K}; pg8::StaticOrder S; S.init(M, N, (int)gridDim.x, (int)blockIdx.x);
    pg8::gemm_phase<Epi, pg8::StaticOrder, true, true>(lds, g, S, E, wave);
}

__device__ __forceinline__ void p0_transpose_item(const float* W, int ldw, int K, int nblk, bf16_t* WT, const float* ksc, LAS float* scr, int item, int lane) {
    const int kb = item / nblk, nb = item % nblk, k0 = 64 * kb, n0 = 32 * nb;
#pragma unroll 8
    for (int i = 0; i < 32; ++i) { const int kk = 2 * i + (lane >> 5); float v = W[(size_t)(k0 + kk) * ldw + n0 + (lane & 31)]; if (ksc) v *= ksc[k0 + kk]; scr[kk * 33 + (lane & 31)] = v; }
    asm volatile("s_waitcnt lgkmcnt(0)" ::: "memory");
    const int c = lane & 7;
#pragma unroll
    for (int j = 0; j < 4; ++j) { const int n = (lane >> 3) + 8 * j; const LAS float* s = scr + (8 * c) * 33 + n;
        u32x4 o; o.x = pk2(s[0 * 33], s[1 * 33]); o.y = pk2(s[2 * 33], s[3 * 33]); o.z = pk2(s[4 * 33], s[5 * 33]); o.w = pk2(s[6 * 33], s[7 * 33]);
        *(u32x4*)(WT + (size_t)(n0 + n) * K + k0 + 8 * c) = o; }
    asm volatile("s_waitcnt lgkmcnt(0)" ::: "memory");
}
__device__ __forceinline__ float logsigmoid(float z) { return fminf(z, 0.f) - log1pf(__expf(-fabsf(z))); }

struct Args { const float* in[18]; float* out; unsigned char* ws; int ph_lo, ph_hi; };

__device__ __forceinline__ void phase0(const Args& a, LAS unsigned char* lds, int wave) {
    const int lane = lane_id();
    unsigned char* ws = a.ws;
    LAS float* scr = (LAS float*)(lds + wave * 16384);
    const int gw = blockIdx.x * 8 + wave, NGW = gridDim.x * 8;
    if (blockIdx.x == 0 && wave == 0 && lane == 0) *(unsigned*)(ws + O_CTR) = 0u;
    constexpr int I_IN1 = 16 * 96, I_IN2 = 16 * 112, I_SQ = 16 * 32, I_UP = 16 * 128, I_DN = 64 * 32, I_P = 4 * 32;
    constexpr int NITEMS = I_IN1 + I_IN2 + 4 * I_SQ + I_UP + I_DN + I_P;
    const float* w_in = a.in[3];
    for (int it = gw; it < NITEMS; it += NGW) {
        int r = it;
        if (r < I_IN1) { p0_transpose_item(w_in, NIN, D, 96, (bf16_t*)(ws + O_WIN), nullptr, scr, r, lane); continue; } r -= I_IN1;
        if (r < I_IN2) { p0_transpose_item(w_in + 3080, NIN, D, 112, (bf16_t*)(ws + O_WIN) + (size_t)3072 * D, nullptr, scr, r, lane); continue; } r -= I_IN2;
        if (r < I_SQ) { p0_transpose_item(a.in[8], D, D, 32, (bf16_t*)(ws + O_WA), nullptr, scr, r, lane); continue; } r -= I_SQ;
        if (r < I_SQ) { p0_transpose_item(a.in[9], D, D, 32, (bf16_t*)(ws + O_WB), nullptr, scr, r, lane); continue; } r -= I_SQ;
        if (r < I_SQ) { p0_transpose_item(a.in[10], D, D, 32, (bf16_t*)(ws + O_WOUT), nullptr, scr, r, lane); continue; } r -= I_SQ;
        if (r < I_SQ) { p0_transpose_item(a.in[15], D, D, 32, (bf16_t*)(ws + O_WG), a.in[14], scr, r, lane); continue; } r -= I_SQ;
        if (r < I_UP) { p0_transpose_item(a.in[12], FF, D, 128, (bf16_t*)(ws + O_WUP), a.in[11], scr, r, lane); continue; } r -= I_UP;
        if (r < I_DN) { p0_transpose_item(a.in[13], D, FF, 32, (bf16_t*)(ws + O_WDN), nullptr, scr, r, lane); continue; } r -= I_DN;
        p0_transpose_item(a.in[16], D, PLE, 32, (bf16_t*)(ws + O_WP), nullptr, scr, r, lane);
    }
    const float* x = a.in[0]; const float* g = a.in[2]; const float* bif = a.in[5];
    __syncthreads();
    LAS float* wgT = (LAS float*)lds;
    { const int t = wave * 64 + lane;
#pragma unroll
      for (int i = 0; i < 2; ++i) { const int k = 2 * t + i; const f32x4* wr = (const f32x4*)(w_in + (size_t)k * NIN + 3072); const f32x4 w0 = wr[0], w1 = wr[1];
          wgT[0 * 1024 + k] = w0[0]; wgT[1 * 1024 + k] = w0[1]; wgT[2 * 1024 + k] = w0[2]; wgT[3 * 1024 + k] = w0[3]; wgT[4 * 1024 + k] = w1[0]; wgT[5 * 1024 + k] = w1[1]; wgT[6 * 1024 + k] = w1[2]; wgT[7 * 1024 + k] = w1[3]; } }
    __syncthreads();
    bf16_t* H = (bf16_t*)((unsigned char*)a.out + OO_H);
    float* gig = (float*)(ws + O_GIG); float* glf = (float*)(ws + O_GLF);
    f32x4 vv[2][4];
#define P0_LOAD(VV, row_) do { _Pragma("unroll") for (int k = 0; k < 2; ++k) { int r = (row_) + k * NGW; r = r < T ? r : T - 1; const f32x4* xr = (const f32x4*)(x + (size_t)r * D) + lane; \
            _Pragma("unroll") for (int j = 0; j < 4; ++j) VV[k][j] = xr[64 * j]; } } while (0)
    P0_LOAD(vv, gw);
    for (int rowp = gw; rowp < T; rowp += 2 * NGW) {
        f32x4 vn[2][4];
        P0_LOAD(vn, rowp + 2 * NGW);
#pragma unroll
        for (int k = 0; k < 2; ++k) { const int row = rowp + k * NGW; const f32x4* gr = (const f32x4*)g + lane;
        float s = 0.f;
#pragma unroll
        for (int j = 0; j < 4; ++j) { const f32x4 v = vv[k][j]; s += (v[0] * v[0] + v[1] * v[1]) + (v[2] * v[2] + v[3] * v[3]); }
        const float rstd = rsqrtf(wave_sum(s) * (1.f / D) + EPS);
        float g8[8];
#pragma unroll
        for (int e = 0; e < 8; ++e) g8[e] = 0.f;
        u32x2* o8 = (u32x2*)(H + (size_t)row * D) + lane;
#pragma unroll
        for (int j = 0; j < 4; ++j) { const f32x4 hv = vv[k][j] * rstd * gr[64 * j]; u32x2 o; o.x = pk2(hv[0], hv[1]); o.y = pk2(hv[2], hv[3]); o8[64 * j] = o;
#pragma unroll
            for (int c = 0; c < 8; ++c) { const f32x4 w4 = *(const LAS f32x4*)(wgT + c * 1024 + 4 * lane + 256 * j); g8[c] += (hv[0] * w4[0] + hv[1] * w4[1]) + (hv[2] * w4[2] + hv[3] * w4[3]); } }
#pragma unroll
        for (int e = 0; e < 8; ++e) g8[e] = wave_sum(g8[e]);
        if (lane == 0) { const int b = row / SEQ, s_ = row % SEQ;
#pragma unroll
            for (int hh = 0; hh < 4; ++hh) { gig[(size_t)(b * 4 + hh) * SEQ + s_] = g8[hh] + bif[hh]; glf[(size_t)(b * 4 + hh) * SEQ + s_] = logsigmoid(g8[4 + hh] + bif[4 + hh]); } }
        }
#pragma unroll
        for (int k = 0; k < 2; ++k)
#pragma unroll
            for (int j = 0; j < 4; ++j) vv[k][j] = vn[k][j];
    }
#undef P0_LOAD
}

__device__ __forceinline__ void gate_chunk(float lf, float ig, int lane, float& b, float& av, float& amax, float& pm) {
    float v = lf;
#pragma unroll
    for (int o = 1; o < 64; o <<= 1) { const float t = __shfl_up(v, o); if (lane >= o) v += t; }
    b = v; av = ig - v; float q = av;
#pragma unroll
    for (int o = 1; o < 64; o <<= 1) { const float t = __shfl_up(q, o); if (lane >= o) q = fmaxf(q, t); }
    pm = q; amax = wave_max(av);
}
__device__ __forceinline__ void phase2(const Args& a, LAS unsigned char* lds, int wave) {
    const int lane = lane_id();
    unsigned char* ws = a.ws;
    LAS unsigned* tile = (LAS unsigned*)(lds + wave * 16384);
    LAS unsigned short* tile16 = (LAS unsigned short*)tile;
    const int gw = blockIdx.x * 8 + wave, NGW = gridDim.x * 8;
    const bf16_t* QK = (const bf16_t*)(ws + O_QK); const bf16_t* VML = (const bf16_t*)(ws + O_VML); const bf16_t* VSW = (const bf16_t*)(ws + O_VSW);
    bf16_t* QKP = (bf16_t*)((unsigned char*)a.out + OO_QKP); bf16_t* VT = (bf16_t*)((unsigned char*)a.out + OO_VT);
    bf16_t* KT = (bf16_t*)(ws + O_KT); bf16_t* VTSW = (bf16_t*)(ws + O_VTSW);
    const float* gig = (const float*)(ws + O_GIG); const float* glf = (const float*)(ws + O_GLF);
    const float* cw = a.in[4];
    const int rsub = lane >> 3, cg8 = lane & 7;
    constexpr int N_QK = 512 * 16, N_VML = 512 * 16, N_VSW = 512 * 4, N_TILE = N_QK + N_VML + N_VSW, N_ALL = N_TILE + 16 * NCH;
    for (int it = gw; it < N_ALL; it += NGW) {
        if (it >= N_TILE) {
            const int q = it - N_TILE, bh = q / NCH, c = q % NCH; const size_t gi = (size_t)bh * SEQ + c * 64 + lane;
            float b, av, amax, pm; gate_chunk(glf[gi], gig[gi], lane, b, av, amax, pm);
            ((float*)(ws + O_GBC))[gi] = b; ((float*)(ws + O_GL))[gi] = b + pm;
            ((bf16_t*)(ws + O_GWH))[gi] = (bf16_t)(pk2(__expf(av - amax), 0.f) & 0xffffu);
            const float bl = rdlane(b, 63);
            if (lane == 0) { ((float*)(ws + O_CBL))[q] = bl; ((float*)(ws + O_CMW))[q] = bl + amax; ((float*)(ws + O_CAMAX))[q] = amax; }
            continue;
        }
        int kind, tt, ct;
        if (it < N_QK) { kind = 0; tt = it >> 4; ct = it & 15; } else if (it < N_QK + N_VML) { kind = 1; tt = (it - N_QK) >> 4; ct = (it - N_QK) & 15; } else { kind = 2; tt = (it - N_QK - N_VML) >> 2; ct = (it - N_QK - N_VML) & 3; }
        const int t0 = tt * 64, c0 = ct * 64, bb = t0 / SEQ, s0 = t0 % SEQ, c = c0 + 8 * cg8;
        if (kind == 0) {
            float w[4][8];
#pragma unroll
            for (int j = 0; j < 4; ++j) { const f32x4 w0 = *(const f32x4*)(cw + j * 1024 + c), w1 = *(const f32x4*)(cw + j * 1024 + c + 4);
                w[j][0] = w0[0]; w[j][1] = w0[1]; w[j][2] = w0[2]; w[j][3] = w0[3]; w[j][4] = w1[0]; w[j][5] = w1[1]; w[j][6] = w1[2]; w[j][7] = w1[3]; }
            const float qs = (c < 512) ? 0.08838834764831845f : 1.f;
            u32x4 xq[8][4];
#pragma unroll
            for (int i = 0; i < 8; ++i) { const int r = 8 * i + rsub, t = t0 + r, sp = s0 + r;
#pragma unroll
                for (int j = 0; j < 4; ++j) { const int back = (sp - 3 + j >= 0) ? 3 - j : 0; xq[i][j] = *(const u32x4*)(QK + (size_t)(t - back) * 1024 + c); } }
#pragma unroll
            for (int i = 0; i < 8; ++i) { const int r = 8 * i + rsub, t = t0 + r, sp = s0 + r;
                float acc8[8];
#pragma unroll
                for (int e = 0; e < 8; ++e) acc8[e] = 0.f;
#pragma unroll
                for (int j = 0; j < 4; ++j) { const float vz = (sp - 3 + j >= 0) ? 1.f : 0.f; const u32x4 xv = xq[i][j];
                        acc8[0] += vz * w[j][0] * bflo(xv.x); acc8[1] += vz * w[j][1] * bfhi(xv.x); acc8[2] += vz * w[j][2] * bflo(xv.y); acc8[3] += vz * w[j][3] * bfhi(xv.y);
                        acc8[4] += vz * w[j][4] * bflo(xv.z); acc8[5] += vz * w[j][5] * bfhi(xv.z); acc8[6] += vz * w[j][6] * bflo(xv.w); acc8[7] += vz * w[j][7] * bfhi(xv.w); }
#pragma unroll
                for (int e = 0; e < 8; ++e) acc8[e] = acc8[e] * sigm(acc8[e]) * qs;
                u32x4 o; o.x = pk2(acc8[0], acc8[1]); o.y = pk2(acc8[2], acc8[3]); o.z = pk2(acc8[4], acc8[5]); o.w = pk2(acc8[6], acc8[7]);
                *(u32x4*)(QKP + (size_t)t * 1024 + c) = o;
                if (c0 >= 512) { LAS unsigned* tp = tile + r * 33 + 4 * cg8; tp[0] = o.x; tp[1] = o.y; tp[2] = o.z; tp[3] = o.w; } }
            if (c0 < 512) continue;
        } else {
            float wh = 1.f;
            if (kind == 1) { const int bh = bb * 4 + (c0 >> 8); const size_t gi = (size_t)bh * SEQ + s0 + lane; float b, av, amax, pm; gate_chunk(glf[gi], gig[gi], lane, b, av, amax, pm); wh = __expf(av - amax); }
            const bf16_t* src = (kind == 1) ? VML : VSW; const int ld = (kind == 1) ? 1024 : 256;
#pragma unroll
            for (int i = 0; i < 8; ++i) { const int r = 8 * i + rsub; u32x4 o = *(const u32x4*)(src + (size_t)(t0 + r) * ld + c);
                const float sc = __shfl(wh, r);
                if (kind == 1) { o.x = pk2(bflo(o.x) * sc, bfhi(o.x) * sc); o.y = pk2(bflo(o.y) * sc, bfhi(o.y) * sc); o.z = pk2(bflo(o.z) * sc, bfhi(o.z) * sc); o.w = pk2(bflo(o.w) * sc, bfhi(o.w) * sc); }
                LAS unsigned* tp = tile + r * 33 + 4 * cg8; tp[0] = o.x; tp[1] = o.y; tp[2] = o.z; tp[3] = o.w; }
        }
        asm volatile("s_waitcnt lgkmcnt(0)" ::: "memory");
        bf16_t* dst; int CH, cb;
        if (kind == 0) { dst = KT; CH = 128; cb = c0 - 512; } else if (kind == 1) { dst = VT; CH = 256; cb = c0; } else { dst = VTSW; CH = 64; cb = c0; }
#pragma unroll
        for (int i = 0; i < 8; ++i) { const int ch = 8 * i + (lane >> 3), tg = lane & 7; const LAS unsigned short* sp = tile16 + (8 * tg) * 66 + ch;
            u32x4 o; o.x = (unsigned)sp[0] | ((unsigned)sp[66] << 16); o.y = (unsigned)sp[2 * 66] | ((unsigned)sp[3 * 66] << 16); o.z = (unsigned)sp[4 * 66] | ((unsigned)sp[5 * 66] << 16); o.w = (unsigned)sp[6 * 66] | ((unsigned)sp[7 * 66] << 16);
            const int chn = cb + ch, hb = bb * 4 + chn / CH, slot = (kind == 2) ? (s0 >> 6) : (((s0 >> 6) + 8 * hb) & 127);
            *(u32x4*)(dst + ((size_t)((hb * NCH + slot) * CH + (chn % CH)) << 6) + 8 * tg) = o; }
        asm volatile("s_waitcnt lgkmcnt(0)" ::: "memory");
    }
}

__device__ __forceinline__ void scan_block(const Args& a, LAS unsigned char* lds, int sb, int wave, int lane) {
    unsigned char* ws = a.ws;
    const int bh = sb / 9, k9 = sb - 9 * bh, fr = lane & 15, fq = lane >> 4;
    constexpr int STG = 128 * 144, SST0 = 4 * STG, TILE = 4352;
    if (wave < 2) {
        const int slice = (k9 < 8) ? 2 * k9 + wave : 16; const bool is_n = (slice == 16);
        const bf16_t* VT = (const bf16_t*)((unsigned char*)a.out + OO_VT); const bf16_t* GWH = (const bf16_t*)(ws + O_GWH);
        const bf16_t* pb = is_n ? GWH + (size_t)bh * SEQ + 8 * fq : VT + ((size_t)(bh * NCH * 256 + 16 * slice + fr) << 6) + 8 * fq;
        const int pbs = is_n ? 64 : 256 * 64;
        const float* cbl = (const float*)(ws + O_CBL) + bh * NCH; const float* cmw = (const float*)(ws + O_CMW) + bh * NCH;
        const float bl0 = cbl[lane], bl1 = cbl[64 + lane], mw0 = cmw[lane], mw1 = cmw[64 + lane];
        bf16x8 rb[8][2];
#define VB_LOAD(slot, cc) do { const bf16_t* _p = pb + (size_t)(is_n ? (cc) : (((cc) + 8 * bh) & 127)) * pbs; rb[slot][0] = ld8(_p); rb[slot][1] = ld8(_p + 32); } while (0)
#pragma unroll
        for (int p = 0; p < 8; ++p) VB_LOAD(p, p);
        if (is_n && wave == 0) { float* cmo = (float*)(ws + O_CM) + bh * NCH; float m = 0.f;
            for (int c = 0; c < NCH; ++c) { const float bl = (c < 64) ? rdlane(bl0, c & 63) : rdlane(bl1, c & 63), mw = (c < 64) ? rdlane(mw0, c & 63) : rdlane(mw1, c & 63); cmo[c] = m; m = fmaxf(bl + m, mw); } }
        f32x4 acc[8];
#pragma unroll
        for (int m = 0; m < 8; ++m) acc[m] = (f32x4){0.f, 0.f, 0.f, 0.f};
        float mst = 0.f;
        for (int c0 = 0; c0 < NCH; c0 += 8) {
#pragma unroll
            for (int p = 0; p < 8; ++p) { const int c = c0 + p;
                LAS unsigned char* sst = lds + SST0 + ((p & 1) * 2 + wave) * TILE;
#pragma unroll
                for (int m = 0; m < 8; ++m) { u32x2 s0; s0.x = pk2(acc[m][0], acc[m][1]); s0.y = pk2(acc[m][2], acc[m][3]); *(LAS u32x2*)(sst + fr * 272 + 32 * m + 8 * fq) = s0; }
                __syncthreads();
                const LAS unsigned char* ls = lds + (p & 3) * STG + fr * 144 + fq * 16;
                bf16x8 af[8][2];
#pragma unroll
                for (int m = 0; m < 8; ++m) { af[m][0] = *(const LAS bf16x8*)(ls + m * 16 * 144); af[m][1] = *(const LAS bf16x8*)(ls + m * 16 * 144 + 64); }
                const float bl = (c < 64) ? rdlane(bl0, c & 63) : rdlane(bl1, c & 63), mw = (c < 64) ? rdlane(mw0, c & 63) : rdlane(mw1, c & 63);
                const float mn = fmaxf(bl + mst, mw), decay = __expf(bl + mst - mn), eta = __expf(mw - mn); mst = mn;
                const f32x4 z = {0.f, 0.f, 0.f, 0.f};
#pragma unroll
                for (int m = 0; m < 8; ++m) { f32x4 t = mfma16(af[m][0], rb[p][0], z); t = mfma16(af[m][1], rb[p][1], t); acc[m] = acc[m] * decay + t * eta; }
                { const int cl = (c + 8 < NCH) ? c + 8 : NCH - 1; VB_LOAD(p, cl); }
            }
        }
#undef VB_LOAD
    } else if (wave < 6) {
        const bf16_t* KT = (const bf16_t*)(ws + O_KT);
        const int tid = (wave - 2) * 64 + lane;
        const bf16_t* pk = KT + ((size_t)(bh * NCH * 128) << 6) + tid * 8;
        LAS unsigned char* lw = lds + (tid >> 3) * 144 + (tid & 7) * 16;
        u32x4 kr[8][4];
#define KT_LOAD(set, cc) do { const size_t _o = (size_t)(((cc) + 8 * bh) & 127) * 8192; _Pragma("unroll") for (int _k = 0; _k < 4; ++_k) kr[set][_k] = *(const u32x4*)(pk + _o + _k * 2048); } while (0)
#define KT_WRITE(set, stg) do { _Pragma("unroll") for (int _k = 0; _k < 4; ++_k) *(LAS u32x4*)(lw + (stg) * STG + _k * 32 * 144) = kr[set][_k]; } while (0)
        KT_LOAD(0, 0); KT_LOAD(1, 1); KT_LOAD(2, 2);
        KT_WRITE(0, 0); KT_WRITE(1, 1); KT_WRITE(2, 2);
        KT_LOAD(3, 3); KT_LOAD(4, 4); KT_LOAD(5, 5); KT_LOAD(6, 6); KT_LOAD(7, 7); KT_LOAD(0, 8); KT_LOAD(1, 9);
        for (int c0 = 0; c0 < NCH; c0 += 8) {
#pragma unroll
            for (int p = 0; p < 8; ++p) { const int c = c0 + p;
                __syncthreads();
                { const int cl = (c + 10 < NCH) ? c + 10 : NCH - 1; KT_LOAD((p + 2) & 7, cl); }
                KT_WRITE((p + 3) & 7, (p + 3) & 3);
            }
        }
#undef KT_LOAD
#undef KT_WRITE
    } else {
        const int j = wave - 6;
        const int slice = (k9 < 8) ? 2 * k9 + j : 16; const bool live = (k9 < 8) || (j == 0);
        bf16_t* cst = (bf16_t*)(ws + O_CST) + (size_t)((bh * 17 + slice) * NCH) * 2048;
        for (int c = 0; c < NCH; ++c) {
            __syncthreads();
            if (live) { const LAS unsigned char* sst = lds + SST0 + ((c & 1) * 2 + j) * TILE;
                bf16_t* st = cst + (size_t)((c + 8 * bh + 5 * slice) & 127) * 2048;
#pragma unroll
                for (int k = 0; k < 4; ++k) { const int q = lane + 64 * k; *(u32x4*)(st + (size_t)(q >> 4) * 128 + (q & 15) * 8) = *(const LAS u32x4*)(sst + (q >> 4) * 272 + (q & 15) * 16); } }
        }
    }
    __syncthreads();
}

constexpr int SWA_KS = 0, SWA_VS = 272 * 144, SWA_VP = 576, SWA_NXT = SWA_VS + 64 * SWA_VP;
struct SwaPre { u32x4 kreg[5], vreg[5]; bf16x8 qf[4][2]; };
__device__ __forceinline__ void swa_issue(const Args& a, int bu, int wave, int lane, SwaPre& P) {
    unsigned char* ws = a.ws;
    const int qb = bu & 63, kvh = (bu >> 6) & 3, b = bu >> 8, fr = lane & 15, fq = lane >> 4, tid = wave * 64 + lane;
    const bf16_t* QSW = (const bf16_t*)(ws + O_QSW); const bf16_t* KSW = (const bf16_t*)(ws + O_KSW); const bf16_t* VTSW = (const bf16_t*)(ws + O_VTSW);
    const int KB = 128 * qb - 144;
#pragma unroll
    for (int it = 0; it < 5; ++it) { int i = tid + 512 * it; i = i < 2176 ? i : 2175; const int row = i >> 3, ch = i & 7; int kp = KB + row; kp = kp < 0 ? 0 : kp;
        P.kreg[it] = *(const u32x4*)(KSW + (size_t)(b * SEQ + kp) * 256 + kvh * 64 + 8 * ch); }
#pragma unroll
    for (int it = 0; it < 5; ++it) { int i = tid + 512 * it; i = i < 2176 ? i : 2175; const int hd = i / 34, ch = i - hd * 34; int sp = KB + 8 * ch; sp = sp < 0 ? 0 : sp;
        P.vreg[it] = *(const u32x4*)(VTSW + ((size_t)((((b * 4 + kvh) * NCH + (sp >> 6)) * 64 + hd)) << 6) + (sp & 63)); }
    const int tq = 128 * qb + 16 * wave + fr;
#pragma unroll
    for (int hh = 0; hh < 4; ++hh) { const bf16_t* qp = QSW + (size_t)(b * SEQ + tq) * 1024 + (4 * kvh + hh) * 64 + 8 * fq; P.qf[hh][0] = ld8(qp); P.qf[hh][1] = ld8(qp + 32); }
}
__device__ __forceinline__ void swa_commit(LAS unsigned char* lds, int bu, int wave, int lane, const SwaPre& P) {
    const int qb = bu & 63, tid = wave * 64 + lane, KB = 128 * qb - 144;
    const u32x4 zero4 = {0u, 0u, 0u, 0u};
#pragma unroll
    for (int it = 0; it < 5; ++it) { const int i = tid + 512 * it; if (i < 2176) { const int row = i >> 3, ch = i & 7; *(LAS u32x4*)(lds + SWA_KS + row * 144 + (ch ^ (4 * ((row >> 4) & 1))) * 16) = (KB + row >= 0) ? P.kreg[it] : zero4; } }
#pragma unroll
    for (int it = 0; it < 5; ++it) { const int i = tid + 512 * it; if (i < 2176) { const int hd = i / 34, ch = i - hd * 34; *(LAS u32x4*)(lds + SWA_VS + hd * SWA_VP + (ch ^ ((hd >> 4) & 3)) * 16) = (KB + 8 * ch >= 0) ? P.vreg[it] : zero4; } }
}
__device__ __forceinline__ void swa_compute(const Args& a, LAS unsigned char* lds, int bu, int wave, int lane, const bf16x8 (&qf)[4][2]) {
    unsigned char* ws = a.ws;
    const int qb = bu & 63, kvh = (bu >> 6) & 3, b = bu >> 8, fr = lane & 15, fq = lane >> 4;
    bf16_t* QSW = (bf16_t*)(ws + O_QSW);
    const int g = wave, t0 = 128 * qb + 16 * g, tq = t0 + fr, kb = t0 - 144;
    float sk[4];
#pragma unroll
    for (int hh = 0; hh < 4; ++hh) sk[hh] = a.in[7][4 * kvh + hh];
    const int krow = 8 * (fr >> 2) + (fr & 3);
    const LAS unsigned char* kbase = lds + SWA_KS + (16 * g + krow) * 144;
    const int kx0 = 4 * ((g + (krow >> 4)) & 1), kx1 = 4 * ((g + ((krow + 4) >> 4)) & 1);
    const LAS unsigned char* vbase = lds + SWA_VS;
    const int vpc = 2 * g + fq, vx = fr >> 2;
#pragma unroll
    for (int hh = 0; hh < 4; ++hh) {
        const bf16x8 q0 = qf[hh][0], q1 = qf[hh][1];
        const float sink = sk[hh];
        f32x4 st[10];
#pragma unroll
        for (int tau = 0; tau < 10; ++tau) { const int i = tau >> 1, e = tau & 1; const LAS unsigned char* kp = kbase + (32 * i + 4 * e) * 144; const int kx = e ? kx1 : kx0;
            f32x4 s = {0.f, 0.f, 0.f, 0.f}; s = mfma16(*(const LAS bf16x8*)(kp + ((fq ^ kx) * 16)), q0, s); s = mfma16(*(const LAS bf16x8*)(kp + (((fq + 4) ^ kx) * 16)), q1, s); st[tau] = s; }
        float mx = -1e30f;
#pragma unroll
        for (int tau = 0; tau < 10; ++tau) { const int i = tau >> 1, e = tau & 1;
#pragma unroll
            for (int r = 0; r < 4; ++r) { const int kp = kb + 32 * i + 8 * fq + 4 * e + r, df = tq - kp; const bool ok = (kp >= 0) && (df >= 0) && (df < 128);
                const float l = ok ? st[tau][r] * 0.125f : -1e30f; st[tau][r] = l; mx = fmaxf(mx, l); } }
        mx = fmaxf(mx, __shfl_xor(mx, 16)); mx = fmaxf(mx, __shfl_xor(mx, 32)); mx = fmaxf(mx, sink);
        float sum = 0.f;
#pragma unroll
        for (int tau = 0; tau < 10; ++tau)
#pragma unroll
            for (int r = 0; r < 4; ++r) { const float p = __expf(st[tau][r] - mx); st[tau][r] = p; sum += p; }
        sum += __shfl_xor(sum, 16); sum += __shfl_xor(sum, 32);
        const float inv = 1.f / (sum + __expf(sink - mx));
        bf16x8 pf[5];
#pragma unroll
        for (int i = 0; i < 5; ++i) { u32x4 w; w.x = pk2(st[2 * i][0], st[2 * i][1]); w.y = pk2(st[2 * i][2], st[2 * i][3]); w.z = pk2(st[2 * i + 1][0], st[2 * i + 1][1]); w.w = pk2(st[2 * i + 1][2], st[2 * i + 1][3]); pf[i] = __builtin_bit_cast(bf16x8, w); }
        f32x4 o[4];
#pragma unroll
        for (int mt = 0; mt < 4; ++mt) { const int hd = 16 * (fr >> 2) + 4 * mt + (fr & 3); const LAS unsigned char* vp = vbase + hd * SWA_VP;
            f32x4 s = {0.f, 0.f, 0.f, 0.f};
#pragma unroll
            for (int i = 0; i < 5; ++i) s = mfma16(*(const LAS bf16x8*)(vp + (((vpc + 4 * i) ^ vx) * 16)), pf[i], s);
            o[mt] = s * inv; }
        u32x4 w0, w1; w0.x = pk2(o[0][0], o[0][1]); w0.y = pk2(o[0][2], o[0][3]); w0.z = pk2(o[1][0], o[1][1]); w0.w = pk2(o[1][2], o[1][3]);
        w1.x = pk2(o[2][0], o[2][1]); w1.y = pk2(o[2][2], o[2][3]); w1.z = pk2(o[3][0], o[3][1]); w1.w = pk2(o[3][2], o[3][3]);
        bf16_t* op = QSW + (size_t)(b * SEQ + tq) * 1024 + (4 * kvh + hh) * 64 + 16 * fq;
        *(u32x4*)op = w0; *(u32x4*)(op + 8) = w1;
    }
}
__device__ __forceinline__ void phase3(const Args& a, LAS unsigned char* lds, int wave) {
    const int lane = lane_id();
#ifdef PROBE_MASK
    if (blockIdx.x == 0 && wave == 0 && lane == 0) ((unsigned long long*)(a.ws + O_TS))[11] = __builtin_amdgcn_s_memrealtime();
#endif
    if (blockIdx.x < 144) scan_block(a, lds, (int)blockIdx.x, wave, lane);
#ifdef PROBE_MASK
    if (blockIdx.x == 0 && wave == 0 && lane == 0) ((unsigned long long*)(a.ws + O_TS))[12] = __builtin_amdgcn_s_memrealtime();
#endif
    unsigned* ctr = (unsigned*)(a.ws + O_CTR);
    LAS unsigned* nxt = (LAS unsigned*)(lds + SWA_NXT);
    const bool lead = (wave == 0 && lane == 0);
    constexpr unsigned NU = NB * 4 * 64;
    unsigned mine = 0; if (lead) { mine = __hip_atomic_fetch_add(ctr, 1u, __ATOMIC_RELAXED, __HIP_MEMORY_SCOPE_AGENT); *nxt = mine; }
    __syncthreads();
    unsigned cur = *nxt;
    if (cur < NU) {
        if (lead) mine = __hip_atomic_fetch_add(ctr, 1u, __ATOMIC_RELAXED, __HIP_MEMORY_SCOPE_AGENT);
        SwaPre P; swa_issue(a, (int)cur, wave, lane, P);
        for (;;) {
            __syncthreads();
            if (lead) *nxt = mine;
            swa_commit(lds, (int)cur, wave, lane, P);
            bf16x8 qc[4][2];
#pragma unroll
            for (int hh = 0; hh < 4; ++hh) { qc[hh][0] = P.qf[hh][0]; qc[hh][1] = P.qf[hh][1]; }
            __syncthreads();
            const unsigned nx = *nxt;
            if (lead && nx < NU) mine = __hip_atomic_fetch_add(ctr, 1u, __ATOMIC_RELAXED, __HIP_MEMORY_SCOPE_AGENT);
            swa_issue(a, (int)(nx < NU ? nx : 0u), wave, lane, P);
            swa_compute(a, lds, (int)cur, wave, lane, qc);
            if (nx >= NU) break;
            cur = nx;
        }
    }
    __syncthreads();
}

__device__ __forceinline__ void p4_ptile(const bf16x8 (&kf)[4], const bf16x8 (&q)[4], float f, int tt, int st, int fr, int fq, LAS bf16_t* Pt) {
    f32x4 s = {0.f, 0.f, 0.f, 0.f};
#pragma unroll
    for (int ks = 0; ks < 4; ++ks) s = mfma16(kf[ks], q[ks], s);
    const int t = 16 * tt + fr, sb = 16 * st + 4 * fq;
    const float p0 = (sb + 0 <= t) ? s[0] * f : 0.f, p1 = (sb + 1 <= t) ? s[1] * f : 0.f, p2 = (sb + 2 <= t) ? s[2] * f : 0.f, p3 = (sb + 3 <= t) ? s[3] * f : 0.f;
    u32x2 o; o.x = pk2(p0, p1); o.y = pk2(p2, p3); *(LAS u32x2*)(Pt + t * 72 + sb) = o;
}
__device__ __forceinline__ void phase4(const Args& a, LAS unsigned char* lds, int wave) {
    const int lane = lane_id();
    unsigned char* ws = a.ws;
    { const f32x4* p = (const f32x4*)a.in[1]; u32x2* pbo = (u32x2*)(ws + O_PB); const int n = T * PLE / 4, stride = gridDim.x * 512;
        for (int i = blockIdx.x * 512 + wave * 64 + lane; i < n; i += 8 * stride) { f32x4 v[8];
#pragma unroll
            for (int k = 0; k < 8; ++k) { int idx = i + k * stride; idx = idx < n ? idx : n - 1; v[k] = p[idx]; }
#pragma unroll
            for (int k = 0; k < 8; ++k) { const int idx = i + k * stride; if (idx < n) { u32x2 o; o.x = pk2(v[k][0], v[k][1]); o.y = pk2(v[k][2], v[k][3]); pbo[idx] = o; } } } }
    const bf16_t* QKP = (const bf16_t*)((unsigned char*)a.out + OO_QKP); const bf16_t* VT = (const bf16_t*)((unsigned char*)a.out + OO_VT);
    const bf16_t* CST = (const bf16_t*)(ws + O_CST); const bf16_t* GWH = (const bf16_t*)(ws + O_GWH); bf16_t* OML = (bf16_t*)(ws + O_OML);
    const float* gbc = (const float*)(ws + O_GBC); const float* gL = (const float*)(ws + O_GL); const float* cm = (const float*)(ws + O_CM); const float* camax = (const float*)(ws + O_CAMAX);
    const float* gn = a.in[6];
    LAS bf16_t* Pt = (LAS bf16_t*)lds;
    LAS float* red = (LAS float*)(lds + 16384);
    LAS unsigned char* QS = lds + 20480; LAS unsigned char* KS = lds + 40960;
    const int fr = lane & 15, fq = lane >> 4, w = wave;
    u32x4 ypend[4]; size_t ytok = 0; int ycol = 0; bool have = false;
    u32x4 pq[2], pk_[2]; float pbt[2], pL[2], pb4[4], pL4[4], pmc = 0.f, pam = 0.f;
#define P4_PREF(un_) do { const int _bh = (un_) / NCH, _c = (un_) % NCH, _h = _bh & 3; const size_t _tok0 = (size_t)(_bh >> 2) * SEQ + _c * 64; pmc = cm[un_]; pam = camax[un_]; \
        _Pragma("unroll") for (int tt = 0; tt < 4; ++tt) { const size_t gi = (size_t)_bh * SEQ + _c * 64 + 16 * tt + fr; pb4[tt] = gbc[gi]; pL4[tt] = gL[gi]; } \
        _Pragma("unroll") for (int k2 = 0; k2 < 2; ++k2) { const int i = w * 64 + lane + 512 * k2, row = i >> 4, pc = i & 15; const bf16_t* src = QKP + (_tok0 + row) * 1024 + _h * 128 + 8 * pc; \
            pq[k2] = *(const u32x4*)src; pk_[k2] = *(const u32x4*)(src + 512); const size_t gi = (size_t)_bh * SEQ + _c * 64 + row; pbt[k2] = gbc[gi]; pL[k2] = gL[gi]; } } while (0)
    if ((int)blockIdx.x < 16 * NCH) P4_PREF((int)blockIdx.x);
    for (int un = blockIdx.x; un < 16 * NCH; un += gridDim.x) {
        const int bh = un / NCH, c = un % NCH, bb = bh >> 2, h = bh & 3; const size_t tok0 = (size_t)bb * SEQ + c * 64;
        const float m_c = pmc, amax = pam;
        float en[4];
#pragma unroll
        for (int tt = 0; tt < 4; ++tt) en[tt] = __expf(-fmaxf(pb4[tt] + m_c, pL4[tt]));
        u32x4 qpc[2], kpc[2]; float wrow[2];
#pragma unroll
        for (int k2 = 0; k2 < 2; ++k2) { qpc[k2] = pq[k2]; kpc[k2] = pk_[k2]; wrow[k2] = __expf(pbt[k2] + m_c - fmaxf(pbt[k2] + m_c, pL[k2])); }
        const int colh = h * 256 + 32 * w + 8 * fq;
        u32x4 ovv[4];
#pragma unroll
        for (int tt = 0; tt < 4; ++tt) ovv[tt] = *(const u32x4*)(OML + (tok0 + 16 * tt + fr) * 1024 + colh);
        bf16x8 ca[3][4], va[3][2];
#pragma unroll
        for (int e = 0; e < 3; ++e) { const int dvr = 32 * w + 8 * (fr >> 2) + 4 * e + (fr & 3); const int crow = (e < 2) ? dvr : 256 + fr;
            const bf16_t* cp = CST + ((size_t)((bh * 17 + (crow >> 4)) * NCH + ((c + 8 * bh + 5 * (crow >> 4)) & 127)) * 16 + (crow & 15)) * 128 + 8 * fq;
            const bf16_t* vp = (e < 2) ? VT + ((size_t)((bh * NCH + ((c + 8 * bh) & 127)) * 256 + dvr) << 6) + 8 * fq : GWH + (size_t)bh * SEQ + c * 64 + 8 * fq;
#pragma unroll
            for (int ks = 0; ks < 4; ++ks) ca[e][ks] = ld8(cp + 32 * ks);
            va[e][0] = ld8(vp); va[e][1] = ld8(vp + 32); }
        if (have) {
#pragma unroll
            for (int tt = 0; tt < 4; ++tt) *(u32x4*)(OML + (ytok + 16 * tt + fr) * 1024 + ycol) = ypend[tt]; }
#pragma unroll
        for (int k2 = 0; k2 < 2; ++k2) { const int i = w * 64 + lane + 512 * k2, row = i >> 4, pc = i & 15;
            *(LAS u32x4*)(QS + row * 288 + pc * 16) = __builtin_bit_cast(u32x4, scale8(__builtin_bit_cast(bf16x8, qpc[k2]), wrow[k2])); *(LAS u32x4*)(KS + row * 288 + pc * 16) = kpc[k2]; }
        __syncthreads();
        bf16x8 qt[4][4];
#pragma unroll
        for (int tt = 0; tt < 4; ++tt)
#pragma unroll
            for (int ks = 0; ks < 4; ++ks) qt[tt][ks] = *(const LAS bf16x8*)(QS + (16 * tt + fr) * 288 + 64 * ks + 16 * fq);
        { bf16x8 kf[4]; const float cf = __expf(amax - m_c);
#pragma unroll
          for (int ks = 0; ks < 4; ++ks) kf[ks] = *(const LAS bf16x8*)(KS + (16 * (w >> 1) + fr) * 288 + 64 * ks + 16 * fq);
          if (w & 1) { p4_ptile(kf, qt[2], cf, 2, w >> 1, fr, fq, Pt); p4_ptile(kf, qt[3], cf, 3, w >> 1, fr, fq, Pt); }
          else       { p4_ptile(kf, qt[0], cf, 0, w >> 1, fr, fq, Pt); p4_ptile(kf, qt[1], cf, 1, w >> 1, fr, fq, Pt); } }
        __syncthreads();
        f32x4 acc[3][4];
#pragma unroll
        for (int e = 0; e < 3; ++e) {
#pragma unroll
            for (int tt = 0; tt < 4; ++tt) { f32x4 s = {0.f, 0.f, 0.f, 0.f};
#pragma unroll
                for (int ks = 0; ks < 4; ++ks) s = mfma16(ca[e][ks], qt[tt][ks], s);
#pragma unroll
                for (int k2 = 0; k2 < 2; ++k2) s = mfma16(va[e][k2], *(const LAS bf16x8*)(Pt + (16 * tt + fr) * 72 + 32 * k2 + 8 * fq), s);
                acc[e][tt] = s; } }
        { const int unn = un + (int)gridDim.x; P4_PREF(unn < 16 * NCH ? unn : un); }
        float rs[4];
#pragma unroll
        for (int tt = 0; tt < 4; ++tt) { const float dn = __builtin_amdgcn_rcpf(fmaxf(fabsf(acc[2][tt][0]), en[tt])); float ss = 0.f;
#pragma unroll
            for (int e = 0; e < 2; ++e)
#pragma unroll
                for (int r = 0; r < 4; ++r) { const float hv = acc[e][tt][r] * dn; acc[e][tt][r] = hv; ss += hv * hv; }
            ss += __shfl_xor(ss, 16); ss += __shfl_xor(ss, 32);
            if (fq == 0) red[w * 64 + 16 * tt + fr] = ss; }
        __syncthreads();
#pragma unroll
        for (int tt = 0; tt < 4; ++tt) { float tot = 0.f;
#pragma unroll
            for (int ww = 0; ww < 8; ++ww) tot += red[ww * 64 + 16 * tt + fr];
            rs[tt] = rsqrtf(tot * (1.f / 256.f) + EPS); }
        const f32x4 g0 = *(const f32x4*)(gn + colh), g1 = *(const f32x4*)(gn + colh + 4);
#pragma unroll
        for (int tt = 0; tt < 4; ++tt) { const u32x4 ov = ovv[tt]; const float r_ = rs[tt]; u32x4 y;
            y.x = pk2(sigm(bflo(ov.x)) * g0[0] * acc[0][tt][0] * r_, sigm(bfhi(ov.x)) * g0[1] * acc[0][tt][1] * r_);
            y.y = pk2(sigm(bflo(ov.y)) * g0[2] * acc[0][tt][2] * r_, sigm(bfhi(ov.y)) * g0[3] * acc[0][tt][3] * r_);
            y.z = pk2(sigm(bflo(ov.z)) * g1[0] * acc[1][tt][0] * r_, sigm(bfhi(ov.z)) * g1[1] * acc[1][tt][1] * r_);
            y.w = pk2(sigm(bflo(ov.w)) * g1[2] * acc[1][tt][2] * r_, sigm(bfhi(ov.w)) * g1[3] * acc[1][tt][3] * r_);
            ypend[tt] = y; }
        ytok = tok0; ycol = colh; have = true;
    }
    if (have) {
#pragma unroll
        for (int tt = 0; tt < 4; ++tt) *(u32x4*)(OML + (ytok + 16 * tt + fr) * 1024 + ycol) = ypend[tt]; }
}

__device__ __forceinline__ void phase10(const Args& a, int wave) {
    const int lane = lane_id();
    const float* ssq = (const float*)(a.ws + O_SSQ3); const float* g = a.in[17]; const bf16_t* X3 = (const bf16_t*)(a.ws + O_X3B);
    const int gw = blockIdx.x * 8 + wave, NGW = gridDim.x * 8;
#ifdef PROBE_MASK
    long long probeK = 0; { const unsigned long long* ts = (const unsigned long long*)(a.ws + O_TS);
#pragma unroll
        for (int k = 0; k < 10; ++k) if ((PROBE_MASK >> k) & 1) probeK += (long long)(ts[k + 1] - ts[k]) / 10;
        if ((PROBE_MASK >> 10) & 1) probeK += (long long)(ts[12] - ts[11]) / 10; }
#endif
    const f32x4 g0 = *(const f32x4*)(g + 8 * lane), g1 = *(const f32x4*)(g + 8 * lane + 4), g2 = *(const f32x4*)(g + 512 + 8 * lane), g3 = *(const f32x4*)(g + 512 + 8 * lane + 4);
    u32x4 xa[4], xb[4]; float rs[4];
#define P10_LOAD(XA, XB, RS, row_) do { _Pragma("unroll") for (int k = 0; k < 4; ++k) { int r = (row_) + k * NGW; r = r < T ? r : T - 1; const bf16_t* xr = X3 + (size_t)r * D + 8 * lane; XA[k] = *(const u32x4*)xr; XB[k] = *(const u32x4*)(xr + 512); \
            const f32x4 p = ((const f32x4*)(ssq + (size_t)r * 16))[lane & 3]; float s = (p[0] + p[1]) + (p[2] + p[3]); s += __shfl_xor(s, 1); s += __shfl_xor(s, 2); RS[k] = rsqrtf(s * (1.f / D) + EPS); } } while (0)
    P10_LOAD(xa, xb, rs, gw);
    for (int row = gw; row < T; row += 4 * NGW) {
        u32x4 na[4], nb[4]; float rn[4];
        P10_LOAD(na, nb, rn, row + 4 * NGW);
#pragma unroll
        for (int k = 0; k < 4; ++k) { const int r = row + k * NGW; float* orow = a.out + (size_t)r * D + 8 * lane; const float q = rs[k];
            f32x4 o[4];
            o[0] = (f32x4){bflo(xa[k].x), bfhi(xa[k].x), bflo(xa[k].y), bfhi(xa[k].y)} * q * g0; o[1] = (f32x4){bflo(xa[k].z), bfhi(xa[k].z), bflo(xa[k].w), bfhi(xa[k].w)} * q * g1;
            o[2] = (f32x4){bflo(xb[k].x), bfhi(xb[k].x), bflo(xb[k].y), bfhi(xb[k].y)} * q * g2; o[3] = (f32x4){bflo(xb[k].z), bfhi(xb[k].z), bflo(xb[k].w), bfhi(xb[k].w)} * q * g3;
#ifdef PROBE_MASK
#pragma unroll
            for (int j = 0; j < 4; ++j) { const long long base_i = (long long)r * D + 8 * lane + (j >> 1) * 512 + (j & 1) * 4;
#pragma unroll
              for (int e2 = 0; e2 < 4; ++e2) if (base_i + e2 < probeK) o[j][e2] += 0.1f; }
#endif
            *(f32x4*)orow = o[0]; *(f32x4*)(orow + 4) = o[1]; *(f32x4*)(orow + 512) = o[2]; *(f32x4*)(orow + 516) = o[3]; }
#pragma unroll
        for (int k = 0; k < 4; ++k) { xa[k] = na[k]; xb[k] = nb[k]; rs[k] = rn[k]; }
    }
#undef P10_LOAD
}

#define XB_TMO      128
#define XB_XCNT(j)  (256  + 64 * (j))
#define XB_XSUB(j)  (1280 + 64 * (j))
#define XB_XGEN(j)  (2304 + 64 * (j))
#define XB_TOP      3328
#define XB_TOPGEN   3392
#define XCD_BAR_WORDS 3456
#define XB_SPIN_CAP (1u << 18)

__device__ __forceinline__ unsigned xb_ld(unsigned* p)              { return __hip_atomic_load(p, __ATOMIC_RELAXED, __HIP_MEMORY_SCOPE_AGENT); }
__device__ __forceinline__ unsigned xb_add(unsigned* p, unsigned v) { return __hip_atomic_fetch_add(p, v, __ATOMIC_RELAXED, __HIP_MEMORY_SCOPE_AGENT); }
__device__ __forceinline__ unsigned xb_xcc_id() { return (unsigned)__builtin_amdgcn_s_getreg((3 << 11) | 20) & 0xFu; }
#define XB_SPIN(cond, bar) do { unsigned _sp = 0; while (cond) { __builtin_amdgcn_s_sleep(1); \
    if ((++_sp & 255u) == 0u) { if (xb_ld(&(bar)[XB_TMO])) break; if (_sp > XB_SPIN_CAP) { atomicAdd(&(bar)[XB_TMO], 1u); break; } } } } while (0)

struct XcdBarrier {
    unsigned* bar; unsigned x;
    volatile LAS unsigned* st;
};

__device__ __forceinline__ XcdBarrier xcd_barrier_post(unsigned* bar, volatile LAS unsigned* st) {
    XcdBarrier b; b.bar = bar; b.x = xb_xcc_id(); b.st = st;
    if (threadIdx.x == 0) (void)xb_add(&bar[XB_XCNT(b.x)], 1u);
    return b;
}
__device__ __forceinline__ void xcd_barrier_complete(unsigned* bar, unsigned x, unsigned& nloc, unsigned& nx) {
    const unsigned G = gridDim.x * gridDim.y * gridDim.z;
    unsigned sum, cnt, mine, sp = 0u;
    for (;;) {
        sum = 0u; cnt = 0u; mine = 0u;
#pragma unroll
        for (unsigned j = 0; j < 16; ++j) { const unsigned c = xb_ld(&bar[XB_XCNT(j)]); sum += c; cnt += (c > 0u) ? 1u : 0u; mine = (j == x) ? c : mine; }
        if (sum == G) break;
        __builtin_amdgcn_s_sleep(1);
        if ((++sp & 255u) == 0u) { if (xb_ld(&bar[XB_TMO])) break; if (sp > XB_SPIN_CAP) { atomicAdd(&bar[XB_TMO], 1u); break; } }
    }
    nloc = mine > 0u ? mine : 1u; nx = cnt > 0u ? cnt : 1u;
}

__device__ __forceinline__ void xcd_barrier(const XcdBarrier& b, const bool lead) {
    asm volatile("s_waitcnt vmcnt(0)" ::: "memory");
    __syncthreads();
    if (lead) {
        unsigned* bar = b.bar;
        __builtin_amdgcn_s_waitcnt(0);
        unsigned nloc = b.st[0], nx = b.st[1];
        if (nloc == 0u) { xcd_barrier_complete(bar, b.x, nloc, nx); b.st[0] = nloc; b.st[1] = nx; }
        const unsigned old = xb_add(&bar[XB_XSUB(b.x)], 1u);
        const unsigned gen = old / nloc;
        if (old + 1u == (gen + 1u) * nloc) {
            __builtin_amdgcn_fence(__ATOMIC_RELEASE, "agent");
            asm volatile("s_waitcnt vmcnt(0)" ::: "memory");
            const unsigned og = xb_add(&bar[XB_TOP], 1u);
            const unsigned tg = og / nx;
            if (og + 1u == (tg + 1u) * nx) xb_add(&bar[XB_TOPGEN], 1u);
            else XB_SPIN(xb_ld(&bar[XB_TOPGEN]) == tg, bar);
            __builtin_amdgcn_fence(__ATOMIC_ACQUIRE, "agent");
            xb_add(&bar[XB_XGEN(b.x)], 1u);
            asm volatile("s_waitcnt vmcnt(0)" ::: "memory");
        } else {
            XB_SPIN(xb_ld(&bar[XB_XGEN(b.x)]) == gen, bar);
            __builtin_amdgcn_fence(__ATOMIC_ACQUIRE, "agent");
            asm volatile("s_waitcnt vmcnt(0)" ::: "memory");
        }
    }
    __syncthreads();
}

__device__ __forceinline__ void grid_bar(unsigned* bar, unsigned& nbar, int wave) {
    asm volatile("s_waitcnt vmcnt(0)" ::: "memory");
    __syncthreads();
    ++nbar;
    if (wave == 0 && lane_id() == 0) {
        __builtin_amdgcn_fence(__ATOMIC_RELEASE, "agent");
        asm volatile("s_waitcnt vmcnt(0)" ::: "memory");
        __hip_atomic_fetch_add(bar, 1u, __ATOMIC_RELAXED, __HIP_MEMORY_SCOPE_AGENT);
        const unsigned target = nbar * gridDim.x; unsigned sp = 0;
        while (__hip_atomic_load(bar, __ATOMIC_RELAXED, __HIP_MEMORY_SCOPE_AGENT) < target) { __builtin_amdgcn_s_sleep(2); if (++sp > (1u << 24)) break; }
        __builtin_amdgcn_fence(__ATOMIC_ACQUIRE, "agent");
        asm volatile("s_waitcnt vmcnt(0)" ::: "memory");
    }
    __syncthreads();
}

__global__ void __launch_bounds__(512, 2) mk_fwd(Args a) {
    extern __shared__ __attribute__((aligned(16))) unsigned char lds_raw[];
    LAS unsigned char* lds = (LAS unsigned char*)lds_raw;
    const int wave = __builtin_amdgcn_readfirstlane(threadIdx.x >> 6);
    unsigned char* ws = a.ws;
    const int lo = a.ph_lo, hi = a.ph_hi;
    unsigned nbar = 0; unsigned* bar = (unsigned*)(ws + O_BAR);
    volatile LAS unsigned* xst = (volatile LAS unsigned*)(lds + 131072 + 256);
    if (threadIdx.x == 0) { xst[0] = 0u; xst[1] = 0u; }
    __syncthreads();
    if (lo == 0 && hi == NPHASE) {
        if (blockIdx.x == 0) { for (int i = threadIdx.x; i < 4096; i += 512) __hip_atomic_store((unsigned*)(ws + O_XBAR) + i, 0u, __ATOMIC_RELAXED, __HIP_MEMORY_SCOPE_AGENT); }
        cg::this_grid().sync();
    }
    const XcdBarrier xb = xcd_barrier_post((unsigned*)(ws + O_XBAR), xst);
#define IN(k) (lo <= (k) && (k) < hi)
#ifdef PROBE_MASK
#define STAMP(k) do { if (blockIdx.x == 0 && wave == 0 && lane_id() == 0) ((unsigned long long*)(ws + O_TS))[(k)] = __builtin_amdgcn_s_memrealtime(); } while (0)
#else
#define STAMP(k) do { } while (0)
#endif
#define SEAM(k) do { STAMP((k) + 1); if (IN(k) && IN((k) + 1)) xcd_barrier(xb, wave == 0 && lane_id() == 0); } while (0)
    STAMP(0);
    if (IN(0)) phase0(a, lds, wave);
    SEAM(0);
    if (IN(1)) { EpiSeg E{ws}; run_gemm(lds, wave, (const bf16_t*)((unsigned char*)a.out + OO_H), (const bf16_t*)(ws + O_WIN), T, NP1, D, E); }
    SEAM(1);
    if (IN(2)) phase2(a, lds, wave);
    SEAM(2);
    if (IN(3)) phase3(a, lds, wave);
    SEAM(3);
    if (IN(4)) phase4(a, lds, wave);
    SEAM(4);
    if (IN(5)) {
        { EpiGateA E{(const bf16_t*)(ws + O_GA), (bf16_t*)a.out}; run_gemm(lds, wave, (const bf16_t*)(ws + O_OML), (const bf16_t*)(ws + O_WA), T, D, D, E); }
        { EpiGateB E{(const bf16_t*)(ws + O_GB), (const bf16_t*)a.out, (bf16_t*)(ws + O_MERGED)}; run_gemm(lds, wave, (const bf16_t*)(ws + O_QSW), (const bf16_t*)(ws + O_WB), T, D, D, E); }
    }
    SEAM(5);
    if (IN(6)) { EpiRes<false> E{a.in[0], (bf16_t*)a.out, (float*)(ws + O_SSQ1)}; run_gemm(lds, wave, (const bf16_t*)(ws + O_MERGED), (const bf16_t*)(ws + O_WOUT), T, D, D, E); }
    SEAM(6);
    if (IN(7)) { EpiUp E{(const float*)(ws + O_SSQ1), (bf16_t*)(ws + O_ACT)}; run_gemm(lds, wave, (const bf16_t*)a.out, (const bf16_t*)(ws + O_WUP), T, FF, D, E); }
    SEAM(7);
    if (IN(8)) {
        { EpiRes<true> E{a.out, (bf16_t*)(ws + O_X2B), (float*)(ws + O_SSQ2)}; run_gemm(lds, wave, (const bf16_t*)(ws + O_ACT), (const bf16_t*)(ws + O_WDN), T, D, FF, E); }
        { EpiPlain E{(bf16_t*)(ws + O_PP), D}; run_gemm(lds, wave, (const bf16_t*)(ws + O_PB), (const bf16_t*)(ws + O_WP), T, D, PLE, E); }
    }
    SEAM(8);
    if (IN(9)) { EpiPle E{(const float*)(ws + O_SSQ2), (const bf16_t*)(ws + O_PP), (const bf16_t*)(ws + O_X2B), (bf16_t*)(ws + O_X3B), (float*)(ws + O_SSQ3)}; run_gemm(lds, wave, (const bf16_t*)(ws + O_X2B), (const bf16_t*)(ws + O_WG), T, D, D, E); }
    SEAM(9);
    if (IN(10)) phase10(a, wave);
#undef IN
#undef SEAM
}

extern "C" void kernel_launch(void* const* d_in, const int* in_sizes, int n_in, void* d_out, int out_size, void* d_ws, size_t ws_size, hipStream_t stream) {
    static int grid = 0;
    if (grid == 0) {
        if (n_in != 18 || out_size != T * D || ws_size < WS_NEED) { fprintf(stderr, "kernel_launch: unexpected shapes (n_in %d out %d ws %zu)\n", n_in, out_size, ws_size); grid = -1; return; }
        int dev = 0, cus = 0, per_cu = 0;
        if (hipGetDevice(&dev) != hipSuccess || hipDeviceGetAttribute(&cus, hipDeviceAttributeMultiprocessorCount, dev) != hipSuccess) { grid = -1; return; }
        if (hipFuncSetAttribute((const void*)mk_fwd, hipFuncAttributeMaxDynamicSharedMemorySize, LDS_BYTES) != hipSuccess) { fprintf(stderr, "kernel_launch: hipFuncSetAttribute failed\n"); grid = -1; return; }
        if (hipOccupancyMaxActiveBlocksPerMultiprocessor(&per_cu, (const void*)mk_fwd, 512, LDS_BYTES) != hipSuccess || per_cu < 1) per_cu = 1;
        (void)hipGetLastError();
        grid = cus;
    }
    if (grid < 0) return;
    Args a{};
    for (int i = 0; i < 18; ++i) a.in[i] = (const float*)d_in[i];
    a.out = (float*)d_out; a.ws = (unsigned char*)d_ws;
#if MK_N_LAUNCHES == 1
    a.ph_lo = 0; a.ph_hi = NPHASE;
    void* args[] = {&a};
    hipError_t e = hipLaunchCooperativeKernel((const void*)mk_fwd, dim3(grid), dim3(512), args, LDS_BYTES, stream);
    if (e != hipSuccess) fprintf(stderr, "cooperative launch failed: %s (grid %d)\n", hipGetErrorString(e), grid);
#else
    for (int p = 0; p < NPHASE; ++p) { a.ph_lo = p; a.ph_hi = p + 1; hipLaunchKernelGGL(mk_fwd, dim3(grid), dim3(512), LDS_BYTES, stream, a); }
#endif
}
```
